# Optimizing an MI355X kernel written in HIP

```python
import jax
import jax.numpy as jnp
from jax import lax
import numpy as np

D_MODEL = 1024
BATCH = 8
SEQ = 4096
DEPTH = 2

HEAD_DIM = 64
FOX_HEADS = 6
NSA_HEADS = 4
MOBA_HEADS = 6
FOX_W = FOX_HEADS * HEAD_DIM
NSA_W = NSA_HEADS * HEAD_DIM
MOBA_W = MOBA_HEADS * HEAD_DIM
N_BRANCHES = 3

Q_BLOCK = 128
NSA_Q_BLOCK = 64
MOBA_Q_BLOCK = 32

NSA_CMP_LEN = 32
NSA_CMP_STRIDE = 16
NSA_CMP_HIDDEN = 256
NSA_SEL_LEN = 64
NSA_TOPN = 16
NSA_LOCAL = 2
NSA_WINDOW = 512

MOBA_BLOCK = 256
MOBA_TOPK = 3

N_GROUPS = 4
EXPERTS_PER_GROUP = 4
N_EXPERTS = N_GROUPS * EXPERTS_PER_GROUP
TOPK_IN_GROUP = 2
EXPERT_HIDDEN = 256

RMS_EPS = 1e-6
NEG_INF = -1e30
FORCE_SCORE = 1e9
FORGET_BIAS_SHIFT = 3.0

IN_SPLITS = (FOX_W, FOX_W, FOX_W, FOX_HEADS,
             NSA_W, HEAD_DIM, HEAD_DIM, HEAD_DIM, HEAD_DIM, HEAD_DIM, HEAD_DIM, N_BRANCHES * NSA_HEADS,
             MOBA_W, MOBA_W, MOBA_W,
             N_BRANCHES * D_MODEL)
IN_COLS = sum(IN_SPLITS)
FORGET_COL = 3 * FOX_W

kernel_name = 'hybrid_fox_nsa_moba_hmoe'


def _rmsnorm(x, g):
    xf = x.astype(jnp.float32)
    y = xf * lax.rsqrt(jnp.mean(xf * xf, axis=-1, keepdims=True) + RMS_EPS)
    return (y * g.astype(jnp.float32)).astype(x.dtype)


def _heads(t, n):
    b, s, _ = t.shape
    return t.reshape(b, s, n, HEAD_DIM).transpose(0, 2, 1, 3)


def _merge(o):
    b, h, s, d = o.shape
    return o.transpose(0, 2, 1, 3).reshape(b, s, h * d)


def _alibi_slopes(n):
    return jnp.asarray(2.0 ** (-8.0 * np.arange(1, n + 1) / n), dtype=jnp.float32)


def _masked_softmax(logits, mask):
    p = jax.nn.softmax(jnp.where(mask, logits, NEG_INF), axis=-1)
    return jnp.where(mask, p, 0.0)


def _fox_attention(q, k, v, forget_logit):
    b, h, s, d = q.shape
    nqb = s // Q_BLOCK
    scale = d ** -0.5
    c = jnp.cumsum(jax.nn.log_sigmoid(forget_logit.astype(jnp.float32)), axis=1).transpose(0, 2, 1)
    qb = q.reshape(b, h, nqb, Q_BLOCK, d).transpose(2, 0, 1, 3, 4)
    cb = c.reshape(b, h, nqb, Q_BLOCK).transpose(2, 0, 1, 3)
    key_pos = jnp.arange(s)

    def one_block(args):
        i, q_i, c_i = args
        t = i * Q_BLOCK + jnp.arange(Q_BLOCK)
        logits = jnp.einsum('bhqd,bhkd->bhqk', q_i, k).astype(jnp.float32) * scale
        logits = logits + c_i[..., :, None] - c[:, :, None, :]
        p = _masked_softmax(logits, key_pos[None, :] <= t[:, None])
        return jnp.einsum('bhqk,bhkd->bhqd', p.astype(v.dtype), v)

    o = lax.map(one_block, (jnp.arange(nqb), qb, cb))
    return o.transpose(1, 2, 0, 3, 4).reshape(b, h, s, d)


def _nsa_compress(kv, w1, b1, w2, pos):
    s = kv.shape[1]
    nc = (s - NSA_CMP_LEN) // NSA_CMP_STRIDE + 1
    idx = jnp.arange(nc)[:, None] * NSA_CMP_STRIDE + jnp.arange(NSA_CMP_LEN)[None, :]
    blocks = kv[:, idx, :] + pos
    hid = jax.nn.gelu(jnp.einsum('bnld,ldh->bnh', blocks, w1) + b1)
    return jnp.einsum('bnh,hd->bnd', hid, w2)


def _nsa_compressed_and_selected(q, k_cmp, v_cmp, k_sel, v_sel, slopes):
    b, h, s, d = q.shape
    scale = d ** -0.5
    nc = k_cmp.shape[1]
    n_sel = s // NSA_SEL_LEN
    topn = min(NSA_TOPN, n_sel)
    ratio = NSA_SEL_LEN // NSA_CMP_STRIDE
    span = NSA_CMP_LEN // NSA_CMP_STRIDE
    imp_len = ratio * n_sel + span - 1
    offsets = [m + n for m in range(ratio) for n in range(span)]
    cmp_end = jnp.arange(nc) * NSA_CMP_STRIDE + NSA_CMP_LEN - 1
    k_blk = k_sel.reshape(b, n_sel, NSA_SEL_LEN, d)
    v_blk = v_sel.reshape(b, n_sel, NSA_SEL_LEN, d)
    blk = jnp.arange(n_sel)
    b_idx = jnp.arange(b)[:, None, None]
    n_keys = topn * NSA_SEL_LEN
    nqb = s // NSA_Q_BLOCK
    qb = q.reshape(b, h, nqb, NSA_Q_BLOCK, d).transpose(2, 0, 1, 3, 4)

    def one_block(args):
        i, q_i = args
        t = i * NSA_Q_BLOCK + jnp.arange(NSA_Q_BLOCK)
        dist_c = t[:, None] - cmp_end[None, :]
        logits_c = (jnp.einsum('bhqd,bnd->bhqn', q_i, k_cmp).astype(jnp.float32) * scale
                    - slopes[:, None, None] * dist_c)
        p_c = _masked_softmax(logits_c, dist_c >= 0)
        o_c = jnp.einsum('bhqn,bnd->bhqd', p_c.astype(v_cmp.dtype), v_cmp)
        imp = jnp.pad(p_c.sum(axis=1), ((0, 0), (0, 0), (0, imp_len - nc)))
        imp_sel = sum(imp[..., o: o + ratio * n_sel: ratio] for o in offsets)
        cur = t // NSA_SEL_LEN
        causal = blk[None, :] <= cur[:, None]
        forced = (blk[None, :] == 0) | (blk[None, :] > cur[:, None] - NSA_LOCAL)
        score = jnp.where(causal, jnp.where(forced, FORCE_SCORE, imp_sel), -FORCE_SCORE)
        _, sel = lax.top_k(score, topn)
        k_g = k_blk[b_idx, sel].reshape(b, NSA_Q_BLOCK, n_keys, d)
        v_g = v_blk[b_idx, sel].reshape(b, NSA_Q_BLOCK, n_keys, d)
        key_pos = (sel[..., None] * NSA_SEL_LEN + jnp.arange(NSA_SEL_LEN)).reshape(b, NSA_Q_BLOCK, n_keys)
        dist_s = t[None, :, None] - key_pos
        logits_s = (jnp.einsum('bhqd,bqkd->bhqk', q_i, k_g).astype(jnp.float32) * scale
                    - slopes[None, :, None, None] * dist_s[:, None])
        p_s = _masked_softmax(logits_s, (dist_s >= 0)[:, None])
        o_s = jnp.einsum('bhqk,bqkd->bhqd', p_s.astype(v_g.dtype), v_g)
        return o_c, o_s

    o_c, o_s = lax.map(one_block, (jnp.arange(nqb), qb))
    o_c = o_c.transpose(1, 2, 0, 3, 4).reshape(b, h, s, d)
    o_s = o_s.transpose(1, 2, 0, 3, 4).reshape(b, h, s, d)
    return o_c, o_s


def _nsa_window(q, k, v, slopes):
    b, h, s, d = q.shape
    scale = d ** -0.5
    nqb = s // Q_BLOCK
    nprev = NSA_WINDOW // Q_BLOCK

    def band(t):
        tb = jnp.pad(t.reshape(b, nqb, Q_BLOCK, d), ((0, 0), (nprev, 0), (0, 0), (0, 0)))
        return jnp.concatenate([tb[:, j: j + nqb] for j in range(nprev + 1)], axis=2)

    k_band, v_band = band(k), band(v)
    q_pos = jnp.arange(nqb)[:, None] * Q_BLOCK + jnp.arange(Q_BLOCK)[None, :]
    key_pos = (jnp.arange(nqb)[:, None] - nprev) * Q_BLOCK + jnp.arange((nprev + 1) * Q_BLOCK)[None, :]
    diff = q_pos[:, :, None] - key_pos[:, None, :]
    mask = (diff >= 0) & (diff < NSA_WINDOW) & (key_pos[:, None, :] >= 0)
    qb = q.reshape(b, h, nqb, Q_BLOCK, d)
    logits = (jnp.einsum('bhnqd,bnkd->bhnqk', qb, k_band).astype(jnp.float32) * scale
              - slopes[:, None, None, None] * diff)
    p = _masked_softmax(logits, mask)
    o = jnp.einsum('bhnqk,bnkd->bhnqd', p.astype(v.dtype), v_band)
    return o.reshape(b, h, s, d)


def _moba_attention(q, k, v, slopes):
    b, h, s, d = q.shape
    scale = d ** -0.5
    nb = max(-(-s // MOBA_BLOCK), MOBA_TOPK + 1)
    pad = ((0, 0), (0, 0), (0, nb * MOBA_BLOCK - s), (0, 0))
    kp, vp = jnp.pad(k, pad), jnp.pad(v, pad)
    k_blk = kp.reshape(b, h, nb, MOBA_BLOCK, d)
    v_blk = vp.reshape(b, h, nb, MOBA_BLOCK, d)
    k_mean = k_blk.mean(axis=3)
    blk = jnp.arange(nb)
    b_idx = jnp.arange(b)[:, None, None, None]
    h_idx = jnp.arange(h)[None, :, None, None]
    n_keys = MOBA_TOPK * MOBA_BLOCK
    nqb = s // MOBA_Q_BLOCK
    qb = q.reshape(b, h, nqb, MOBA_Q_BLOCK, d).transpose(2, 0, 1, 3, 4)

    def one_block(args):
        i, q_i = args
        t = i * MOBA_Q_BLOCK + jnp.arange(MOBA_Q_BLOCK)
        cur = (i * MOBA_Q_BLOCK) // MOBA_BLOCK
        gate = jnp.einsum('bhqd,bhnd->bhqn', q_i, k_mean).astype(jnp.float32)
        gate = jnp.where(blk < cur, gate, -FORCE_SCORE)
        _, sel = lax.top_k(gate, MOBA_TOPK)
        k_g = k_blk[b_idx, h_idx, sel].reshape(b, h, MOBA_Q_BLOCK, n_keys, d)
        v_g = v_blk[b_idx, h_idx, sel].reshape(b, h, MOBA_Q_BLOCK, n_keys, d)
        key_pos = (sel[..., None] * MOBA_BLOCK + jnp.arange(MOBA_BLOCK)).reshape(b, h, MOBA_Q_BLOCK, n_keys)
        mask_past = jnp.repeat(sel < cur, MOBA_BLOCK, axis=-1)
        logits_past = (jnp.einsum('bhqd,bhqkd->bhqk', q_i, k_g).astype(jnp.float32) * scale
                       - slopes[None, :, None, None] * (t[None, None, :, None] - key_pos))
        own_k = lax.dynamic_slice_in_dim(kp, cur * MOBA_BLOCK, MOBA_BLOCK, axis=2)
        own_v = lax.dynamic_slice_in_dim(vp, cur * MOBA_BLOCK, MOBA_BLOCK, axis=2)
        dist_own = t[:, None] - (cur * MOBA_BLOCK + jnp.arange(MOBA_BLOCK))[None, :]
        logits_own = (jnp.einsum('bhqd,bhkd->bhqk', q_i, own_k).astype(jnp.float32) * scale
                      - slopes[:, None, None] * dist_own)
        mask_own = jnp.broadcast_to(dist_own >= 0, logits_own.shape)
        p = _masked_softmax(jnp.concatenate([logits_past, logits_own], axis=-1),
                            jnp.concatenate([mask_past, mask_own], axis=-1)).astype(v.dtype)
        return (jnp.einsum('bhqk,bhqkd->bhqd', p[..., :n_keys], v_g)
                + jnp.einsum('bhqk,bhkd->bhqd', p[..., n_keys:], own_v))

    o = lax.map(one_block, (jnp.arange(nqb), qb))
    return o.transpose(1, 2, 0, 3, 4).reshape(b, h, s, d)


def _token_mixers(h, w_in, b_in, cmp_w1, cmp_b1, cmp_w2, cmp_pos, w_br_fox, w_br_nsa, w_br_moba, w_out):
    b, s, _ = h.shape
    proj = jnp.einsum('bsd,dc->bsc', h, w_in) + b_in
    split_points = np.cumsum(IN_SPLITS)[:-1].tolist()
    (fq, fk, fv, f_forget, nq, kc, vc, ks, vs, kw, vw, n_gate,
     mq, mk, mv, merge_logit) = jnp.split(proj, split_points, axis=-1)
    o_fox = _fox_attention(_heads(fq, FOX_HEADS), _heads(fk, FOX_HEADS), _heads(fv, FOX_HEADS), f_forget)
    slopes_nsa = _alibi_slopes(NSA_HEADS)
    q_nsa = _heads(nq, NSA_HEADS)
    k_cmp = _nsa_compress(kc, cmp_w1[0], cmp_b1[0], cmp_w2[0], cmp_pos[0])
    v_cmp = _nsa_compress(vc, cmp_w1[1], cmp_b1[1], cmp_w2[1], cmp_pos[1])
    o_c, o_s = _nsa_compressed_and_selected(q_nsa, k_cmp, v_cmp, ks, vs, slopes_nsa)
    o_w = _nsa_window(q_nsa, kw, vw, slopes_nsa)
    g_nsa = jax.nn.sigmoid(n_gate.astype(jnp.float32)).reshape(b, s, N_BRANCHES, NSA_HEADS).transpose(2, 0, 3, 1)[..., None]
    o_nsa = (g_nsa[0] * o_c + g_nsa[1] * o_s + g_nsa[2] * o_w).astype(h.dtype)
    o_moba = _moba_attention(_heads(mq, MOBA_HEADS), _heads(mk, MOBA_HEADS), _heads(mv, MOBA_HEADS),
                             _alibi_slopes(MOBA_HEADS))
    y_fox = jnp.einsum('bsk,kd->bsd', _merge(o_fox), w_br_fox)
    y_nsa = jnp.einsum('bsk,kd->bsd', _merge(o_nsa), w_br_nsa)
    y_moba = jnp.einsum('bsk,kd->bsd', _merge(o_moba), w_br_moba)
    gate = jax.nn.sigmoid(merge_logit.astype(jnp.float32)).reshape(b, s, N_BRANCHES, D_MODEL)
    merged = (gate[:, :, 0] * y_fox + gate[:, :, 1] * y_nsa + gate[:, :, 2] * y_moba).astype(h.dtype)
    return jnp.einsum('bsd,de->bse', merged, w_out)


def _hier_moe(h, w_route_grp, b_route_grp, w_route_exp, b_route_exp, w_exp_gate, w_exp_up, w_exp_down):
    b, s, d = h.shape
    xt = h.reshape(b * s, d)
    grp_logits = (xt @ w_route_grp + b_route_grp).astype(jnp.float32)
    grp_prob = jax.nn.softmax(grp_logits, axis=-1)
    grp_weight = jax.nn.one_hot(jnp.argmax(grp_logits, axis=-1), N_GROUPS, dtype=jnp.float32) * grp_prob
    exp_logits = (xt @ w_route_exp + b_route_exp).astype(jnp.float32).reshape(-1, N_GROUPS, EXPERTS_PER_GROUP)
    exp_prob = jax.nn.softmax(exp_logits, axis=-1)
    top_p, top_i = lax.top_k(exp_prob, TOPK_IN_GROUP)
    top_p = top_p / top_p.sum(axis=-1, keepdims=True)
    within = jnp.sum(jax.nn.one_hot(top_i, EXPERTS_PER_GROUP, dtype=jnp.float32) * top_p[..., None], axis=-2)
    combine = grp_weight[:, :, None] * within
    out = jnp.zeros_like(xt)
    for g in range(N_GROUPS):
        e = slice(g * EXPERTS_PER_GROUP, (g + 1) * EXPERTS_PER_GROUP)
        a = jnp.einsum('td,edh->teh', xt, w_exp_gate[e])
        u = jnp.einsum('td,edh->teh', xt, w_exp_up[e])
        hid = (jax.nn.silu(a) * u * combine[:, g, :, None]).astype(xt.dtype)
        out = out + jnp.einsum('teh,ehd->td', hid, w_exp_down[e])
    return out.reshape(b, s, d)


def setup_inputs(seed: int = 0) -> dict:
    key = jax.random.key(seed)
    ks = jax.random.split(key, 21)
    f32 = jnp.float32
    L = DEPTH

    def nrm(k, shape, scale):
        return jax.random.normal(k, shape, f32) * scale

    b_in = nrm(ks[5], (L, IN_COLS), 0.02)
    b_in = b_in.at[:, FORGET_COL:FORGET_COL + FOX_HEADS].add(FORGET_BIAS_SHIFT)
    return {
        'x': nrm(ks[0], (BATCH, SEQ, D_MODEL), 1.0),
        'norm_mix_g': 1.0 + nrm(ks[1], (L, D_MODEL), 0.02),
        'norm_ffn_g': 1.0 + nrm(ks[2], (L, D_MODEL), 0.02),
        'final_norm_g': 1.0 + nrm(ks[3], (D_MODEL,), 0.02),
        'w_in': nrm(ks[4], (L, D_MODEL, IN_COLS), D_MODEL ** -0.5),
        'b_in': b_in,
        'cmp_w1': nrm(ks[6], (L, 2, NSA_CMP_LEN, HEAD_DIM, NSA_CMP_HIDDEN), (NSA_CMP_LEN * HEAD_DIM) ** -0.5),
        'cmp_b1': nrm(ks[7], (L, 2, NSA_CMP_HIDDEN), 0.02),
        'cmp_w2': nrm(ks[8], (L, 2, NSA_CMP_HIDDEN, HEAD_DIM), NSA_CMP_HIDDEN ** -0.5),
        'cmp_pos': nrm(ks[9], (L, 2, NSA_CMP_LEN, HEAD_DIM), 0.02),
        'w_br_fox': nrm(ks[10], (L, FOX_W, D_MODEL), FOX_W ** -0.5),
        'w_br_nsa': nrm(ks[11], (L, NSA_W, D_MODEL), NSA_W ** -0.5),
        'w_br_moba': nrm(ks[12], (L, MOBA_W, D_MODEL), MOBA_W ** -0.5),
        'w_out': nrm(ks[13], (L, D_MODEL, D_MODEL), D_MODEL ** -0.5),
        'w_route_grp': nrm(ks[14], (L, D_MODEL, N_GROUPS), D_MODEL ** -0.5),
        'b_route_grp': nrm(ks[15], (L, N_GROUPS), 0.01),
        'w_route_exp': nrm(ks[16], (L, D_MODEL, N_EXPERTS), D_MODEL ** -0.5),
        'b_route_exp': nrm(ks[17], (L, N_EXPERTS), 0.01),
        'w_exp_gate': nrm(ks[18], (L, N_EXPERTS, D_MODEL, EXPERT_HIDDEN), D_MODEL ** -0.5),
        'w_exp_up': nrm(ks[19], (L, N_EXPERTS, D_MODEL, EXPERT_HIDDEN), D_MODEL ** -0.5),
        'w_exp_down': nrm(ks[20], (L, N_EXPERTS, EXPERT_HIDDEN, D_MODEL), EXPERT_HIDDEN ** -0.5),
    }


def reference(x, norm_mix_g, norm_ffn_g, final_norm_g, w_in, b_in, cmp_w1, cmp_b1, cmp_w2, cmp_pos,
              w_br_fox, w_br_nsa, w_br_moba, w_out, w_route_grp, b_route_grp, w_route_exp, b_route_exp,
              w_exp_gate, w_exp_up, w_exp_down):
    for l in range(DEPTH):
        h = _rmsnorm(x, norm_mix_g[l])
        x = x + _token_mixers(h, w_in[l], b_in[l], cmp_w1[l], cmp_b1[l], cmp_w2[l], cmp_pos[l],
                              w_br_fox[l], w_br_nsa[l], w_br_moba[l], w_out[l])
        h = _rmsnorm(x, norm_ffn_g[l])
        x = x + _hier_moe(h, w_route_grp[l], b_route_grp[l], w_route_exp[l], b_route_exp[l],
                          w_exp_gate[l], w_exp_up[l], w_exp_down[l])
    return _rmsnorm(x, final_norm_g)
```

```cpp
#include <hip/hip_runtime.h>
#include <stdint.h>
#include <math.h>
#include <stdio.h>

#define LAS __attribute__((address_space(3)))
#define GAS __attribute__((address_space(1)))
typedef unsigned short bf16_t;
typedef short bf16x8 __attribute__((ext_vector_type(8)));
typedef short s16x4 __attribute__((ext_vector_type(4)));
typedef float f32x2 __attribute__((ext_vector_type(2)));
typedef float f32x4 __attribute__((ext_vector_type(4)));
typedef float f32x16 __attribute__((ext_vector_type(16)));
typedef unsigned u32x2 __attribute__((ext_vector_type(2)));
typedef unsigned u32x4 __attribute__((ext_vector_type(4)));
typedef GAS unsigned gu32;

constexpr int NB = 8, S_ = 4096, T_ = NB * S_, D_ = 1024, PP = 3072, INC = 6034, NWIN = 6144;
constexpr int PC_FQ = 0, PC_FK = 384, PC_FV = 768, PC_NQ = 1152, PC_KC = 1408, PC_VC = 1472, PC_KS = 1536, PC_VS = 1600, PC_KW = 1664, PC_VW = 1728,
              PC_MQ = 1792, PC_MK = 2176, PC_MV = 2560, PC_FF = 2944, PC_NG = 2950;
constexpr float LOG2E = 1.4426950408889634f;
constexpr float C2 = 0.125f * LOG2E;
constexpr float THR = 6.0f;

constexpr size_t MiB = 1u << 20;
constexpr size_t WS_CTL = 0, CTL_ZERO_BYTES = 1 * MiB;
constexpr size_t WS_WIN = 2 * MiB;
constexpr size_t WS_WBR = 26 * MiB;
constexpr size_t WS_WOUT = 30 * MiB;
constexpr size_t WS_WGU = 34 * MiB;
constexpr size_t WS_WD = 66 * MiB;
constexpr size_t WS_WC1 = 82 * MiB;
constexpr size_t WS_BIAS = 86 * MiB;
constexpr size_t WS_WRT = 87 * MiB + 512 * 1024;
constexpr size_t WS_BC1P = 87 * MiB;
constexpr size_t WS_H = 88 * MiB;
constexpr size_t WS_P = 152 * MiB;
constexpr size_t WS_O = 344 * MiB;
constexpr size_t WS_FB = 408 * MiB;
constexpr size_t WS_KCMP = 409 * MiB;
constexpr size_t WS_KMEAN = 410 * MiB;
constexpr size_t WS_TOKW = 411 * MiB;
constexpr size_t WS_LIST = 412 * MiB;
constexpr size_t WS_MERGED = WS_P;
constexpr size_t WS_YSCR = WS_P + 64 * MiB;
constexpr size_t WS_PSCR = WS_P + 96 * MiB;
constexpr size_t WS_HID = WS_P + 160 * MiB;
constexpr size_t WS_D1 = WS_P + 64 * MiB;
constexpr size_t WS_D2 = WS_P;
constexpr size_t WS_END = 416 * MiB;
constexpr int CW_TMO = 0, CW_BAR = 4096, CW_Q = 8192, CW_CNT = 8448, CW_KN = 16384;

constexpr int LDS_BYTES = 147456;
constexpr int MISC_OFF = 146944;
constexpr int SLOTB = 8192, NSLOT = 4, L_K = 0, L_V = NSLOT * SLOTB, L_WSF = 2 * NSLOT * SLOTB, L_OST = 0  , L_AUX = L_WSF + 4096;
constexpr int L_IMP = L_AUX, IMP_LD = 260, L_SELM = L_IMP + 64 * IMP_LD * 4, L_UNION = L_SELM + 1024, L_VOTE = L_UNION + 64;
static_assert(L_VOTE + 256 <= MISC_OFF, "lds");

#define RLX_AGENT __ATOMIC_RELAXED, __HIP_MEMORY_SCOPE_AGENT
__device__ __forceinline__ unsigned f2bf(float f) { unsigned u = __builtin_bit_cast(unsigned, f); return (u + 0x7fffu + ((u >> 16) & 1u)) >> 16; }
__device__ __forceinline__ unsigned pk2(float lo, float hi) { return f2bf(lo) | (f2bf(hi) << 16); }
__device__ __forceinline__ float bf2f(unsigned short v) { return __builtin_bit_cast(float, (unsigned)v << 16); }
__device__ __forceinline__ unsigned cvt_pk_bf16(float lo, float hi) { unsigned r; asm volatile("v_cvt_pk_bf16_f32 %0, %1, %2" : "=v"(r) : "v"(lo), "v"(hi)); return r; }
__device__ __forceinline__ int opaque_tid() { int t = threadIdx.x; asm volatile("" : "+v"(t)); return t; }
__device__ __forceinline__ float fast_sigmoid(float x) { return __builtin_amdgcn_rcpf(1.0f + __builtin_amdgcn_exp2f(-x * LOG2E)); }

#define XB_TMO      128
#define XB_XCNT(j)  (256  + 64 * (j))
#define XB_XSUB(j)  (1280 + 64 * (j))
#define XB_XGEN(j)  (2304 + 64 * (j))
#define XB_TOP      3328
#define XB_TOPGEN   3392
#define XCD_BAR_WORDS 3456
#define XB_SPIN_CAP (1u << 20)
__device__ __forceinline__ unsigned xb_ld(unsigned* p)              { return __hip_atomic_load(p, __ATOMIC_RELAXED, __HIP_MEMORY_SCOPE_AGENT); }
__device__ __forceinline__ unsigned xb_add(unsigned* p, unsigned v) { return __hip_atomic_fetch_add(p, v, __ATOMIC_RELAXED, __HIP_MEMORY_SCOPE_AGENT); }
__device__ __forceinline__ unsigned xb_xcc_id() { return (unsigned)__builtin_amdgcn_s_getreg((3 << 11) | 20) & 0xFu; }
#define XB_SPIN(cond, bar) do { unsigned _sp = 0; while (cond) { __builtin_amdgcn_s_sleep(1); \
    if ((++_sp & 255u) == 0u) { if (xb_ld(&(bar)[XB_TMO])) break; if (_sp > XB_SPIN_CAP) { atomicAdd(&(bar)[XB_TMO], 1u); break; } } } } while (0)
struct XcdBarrier { unsigned* bar; unsigned x; volatile LAS unsigned* st; };
__device__ __forceinline__ XcdBarrier xcd_barrier_post(unsigned* bar, volatile LAS unsigned* st) {
    XcdBarrier b; b.bar = bar; b.x = xb_xcc_id(); b.st = st;
    if (threadIdx.x == 0) (void)xb_add(&bar[XB_XCNT(b.x)], 1u);
    return b;
}
__device__ __forceinline__ void xcd_barrier_complete(unsigned* bar, unsigned x, unsigned& nloc, unsigned& nx) {
    const unsigned G = gridDim.x * gridDim.y * gridDim.z;
    unsigned sum, cnt, mine, sp = 0u;
    for (;;) {
        sum = 0u; cnt = 0u; mine = 0u;
#pragma unroll
        for (unsigned j = 0; j < 16; ++j) { const unsigned c = xb_ld(&bar[XB_XCNT(j)]); sum += c; cnt += (c > 0u) ? 1u : 0u; mine = (j == x) ? c : mine; }
        if (sum == G) break;
        __builtin_amdgcn_s_sleep(1);
        if ((++sp & 255u) == 0u) { if (xb_ld(&bar[XB_TMO])) break; if (sp > XB_SPIN_CAP) { atomicAdd(&bar[XB_TMO], 1u); break; } }
    }
    nloc = mine > 0u ? mine : 1u; nx = cnt > 0u ? cnt : 1u;
}
__device__ __forceinline__ void xcd_barrier(const XcdBarrier& b) {
    asm volatile("s_waitcnt vmcnt(0)" ::: "memory");
    __syncthreads();
    if (threadIdx.x == 0) {
        unsigned* bar = b.bar;
        __builtin_amdgcn_s_waitcnt(0);
        unsigned nloc = b.st[0], nx = b.st[1];
        if (nloc == 0u) { xcd_barrier_complete(bar, b.x, nloc, nx); b.st[0] = nloc; b.st[1] = nx; }
        const unsigned old = xb_add(&bar[XB_XSUB(b.x)], 1u);
        const unsigned gen = old / nloc;
        if (old + 1u == (gen + 1u) * nloc) {
            __builtin_amdgcn_fence(__ATOMIC_RELEASE, "agent");
            asm volatile("s_waitcnt vmcnt(0)" ::: "memory");
            const unsigned og = xb_add(&bar[XB_TOP], 1u);
            const unsigned tg = og / nx;
            if (og + 1u == (tg + 1u) * nx) xb_add(&bar[XB_TOPGEN], 1u);
            else XB_SPIN(xb_ld(&bar[XB_TOPGEN]) == tg, bar);
            __builtin_amdgcn_fence(__ATOMIC_ACQUIRE, "agent");
            xb_add(&bar[XB_XGEN(b.x)], 1u);
            asm volatile("s_waitcnt vmcnt(0)" ::: "memory");
        } else {
            XB_SPIN(xb_ld(&bar[XB_XGEN(b.x)]) == gen, bar);
            __builtin_amdgcn_fence(__ATOMIC_ACQUIRE, "agent");
            asm volatile("s_waitcnt vmcnt(0)" ::: "memory");
        }
    }
    __syncthreads();
}

namespace pg8 {
constexpr int BM = 256, BK = 64, HALF = 128, HTB = HALF * BK * 2, STAGE_BYTES = 8 * HTB, NXCD = 8, WGM = 8;
__host__ __device__ __forceinline__ int lds_byte(int r, int c) { const int st = (r >> 4) * 2 + (c >> 5), rr = r & 15, cc = c & 31, ob = rr * 64 + cc * 2; return st * 1024 + (ob ^ (((ob >> 9) & 1) << 5)); }
__host__ __device__ __forceinline__ void stage_rc(int b, int& R, int& C) { const int st = b / 1024, sb = b % 1024, swz = sb ^ (((sb >> 9) & 1) << 5); R = (st >> 1) * 16 + swz / 64; C = (st & 1) * 32 + (swz % 64) / 2; }
__host__ __device__ __forceinline__ int perm32(int rho) { const int n = rho >> 4, i = rho & 15; return 8 * (i >> 2) + 4 * n + (i & 3); }

struct Seg { const char* A; const char* B; const char* B2; int nt, ntb, epi, pm, pn, aux; };
typedef f32x4 Acc[2][2][4][2];

struct TileOrder {
    int nM, nN, nwg, G, c;
    __device__ void init(int M, int N, int G_, int c_) { nM = M / BM; nN = N / BM; nwg = nM * nN; G = G_; c = c_; }
    __device__ bool tile(int i, int& pm, int& pn) const {
        const long L = (long)i * G + c; if (L >= nwg) return false;
        int wgid = (int)L; { const int q = nwg / NXCD, r = nwg % NXCD, xcd = wgid % NXCD, off = wgid / NXCD; wgid = (xcd < r ? xcd * (q + 1) : r * (q + 1) + (xcd - r) * q) + off; }
        const int nig = WGM * nN, gid = wgid / nig, fm = gid * WGM, gsz = (nM - fm) < WGM ? (nM - fm) : WGM;
        pm = fm + ((wgid % nig) % gsz); pn = (wgid % nig) / gsz; return true;
    }
};

template <class Pol>
__device__ __forceinline__ void gemm_stream(LAS unsigned char* lds, const Pol& S) {
    constexpr bool GA = Pol::GATHER;
    const int tid = opaque_tid(), wid = __builtin_amdgcn_readfirstlane(tid >> 6), lane = tid & 63, wr = wid >> 2, wc = wid & 3, fr = lane & 15, fq = lane >> 4;
    int Rr[2]; unsigned voffA[2], voffB[2];
#pragma unroll
    for (int i = 0; i < 2; ++i) { int R, C; stage_rc(tid * 16 + i * 8192, R, C); Rr[i] = R; voffA[i] = GA ? (unsigned)(C * 2) : (unsigned)(R * S.lda2 + C * 2); const int Rb = (R & ~31) + perm32(R & 31); voffB[i] = (unsigned)(Rb * S.ldb2 + C * 2); }
    const unsigned hstepB = (unsigned)(HALF * S.ldb2), hstepA = (unsigned)(HALF * S.lda2);
    const size_t kA = (size_t)S.kA;
    const unsigned ldsw = (unsigned)wid * 1024u;
    const int aoff = lds_byte(wr * 64 + fr, fq * 8), boff = lds_byte(wc * 32 + fr, fq * 8);
#define PG8_SA(b, h) (((b) * 2 + (h)) * HTB)
#define PG8_SB(b, h) ((4 + (b) * 2 + (h)) * HTB)
#define PG8_STAGE_A(bufoff, gbase, tsel, h) do { _Pragma("unroll") for (int _i = 0; _i < 2; ++_i) \
        __builtin_amdgcn_global_load_lds((const unsigned*)((gbase) + (GA ? (tab[(tsel) * 256 + (h) * HALF + Rr[_i]] + voffA[_i]) : ((h) * hstepA + voffA[_i]))), (LAS unsigned*)(lds + (bufoff) + ldsw + _i * 8192), 16, 0, 0); } while (0)
#define PG8_STAGE_B(bufoff, gbase, h) do { _Pragma("unroll") for (int _i = 0; _i < 2; ++_i) \
        __builtin_amdgcn_global_load_lds((const unsigned*)((gbase) + (h) * hstepB + voffB[_i]), (LAS unsigned*)(lds + (bufoff) + ldsw + _i * 8192), 16, 0, 0); } while (0)
#define PG8_LDA(dst, b, h) do { _Pragma("unroll") for (int m = 0; m < 4; ++m) _Pragma("unroll") for (int k = 0; k < 2; ++k) dst[m][k] = *(const LAS bf16x8*)(lds + PG8_SA(b, h) + aoff + m * 2048 + k * 1024); } while (0)
#define PG8_LDB(dst, b, h) do { _Pragma("unroll") for (int n = 0; n < 2; ++n) _Pragma("unroll") for (int k = 0; k < 2; ++k) dst[n][k] = *(const LAS bf16x8*)(lds + PG8_SB(b, h) + boff + n * 2048 + k * 1024); } while (0)
#define PG8_MMA(ai, bj, At, Bt) do { __builtin_amdgcn_s_setprio(1); _Pragma("unroll") for (int m = 0; m < 4; ++m) _Pragma("unroll") for (int n = 0; n < 2; ++n) _Pragma("unroll") for (int k = 0; k < 2; ++k) \
        acc[ai][bj][m][n] = __builtin_amdgcn_mfma_f32_16x16x32_bf16(Bt[n][k], At[m][k], acc[ai][bj][m][n], 0, 0, 0); __builtin_amdgcn_s_setprio(0); } while (0)
#define PG8_WAIT_V(n) asm volatile("s_waitcnt vmcnt(" #n ")" ::: "memory")
#define PG8_WAIT_L(n) asm volatile("s_waitcnt lgkmcnt(" #n ")" ::: "memory")
#define PG8_BAR __builtin_amdgcn_s_barrier()
#define PG8_SCHED __builtin_amdgcn_sched_barrier(0)
#define PG8_ZERO_ACC() do { _Pragma("unroll") for (int a = 0; a < 2; ++a) _Pragma("unroll") for (int b = 0; b < 2; ++b) _Pragma("unroll") for (int m = 0; m < 4; ++m) _Pragma("unroll") for (int n = 0; n < 2; ++n) acc[a][b][m][n] = (f32x4){0.f, 0.f, 0.f, 0.f}; } while (0)
    Seg cur, nxt; int ui = 0;
    if (!S.next(0, cur)) return;
    const LAS unsigned* tab = (const LAS unsigned*)(lds + STAGE_BYTES);
    int par = 0;
    if (GA) { if (tid < 256) ((LAS unsigned*)(lds + STAGE_BYTES))[tid] = S.arow(cur, tid); asm volatile("s_waitcnt lgkmcnt(0)" ::: "memory"); PG8_BAR; }
    Acc acc; PG8_ZERO_ACC();
    bf16x8 At[4][2], B0[2][2], B1[2][2];
    {
        const char* cA = cur.A + S.arow0(cur); const char* cB = cur.B;
        PG8_STAGE_B(PG8_SB(0, 0), cB, 0); PG8_STAGE_B(PG8_SB(0, 1), cB, 1); PG8_STAGE_A(PG8_SA(0, 0), cA, par, 0); PG8_STAGE_A(PG8_SA(0, 1), cA, par, 1);
        if (wr == 1) PG8_BAR;
        PG8_WAIT_V(2); PG8_BAR;
        PG8_STAGE_B(PG8_SB(1, 0), cB + 128, 0); PG8_STAGE_A(PG8_SA(1, 0), cA + kA, par, 0); PG8_STAGE_B(PG8_SB(1, 1), cB + 128, 1);
        PG8_WAIT_V(6); PG8_BAR;
    }
    for (;;) {
        const bool has_next = S.next(ui + 1, nxt);
        if (!has_next) nxt = cur;
        const char* cA = cur.A + S.arow0(cur); const char* cB = cur.B; const char* nA = nxt.A + S.arow0(nxt); const char* nB = nxt.B;
        const int nt = cur.nt;
        if (GA) { if (has_next && tid < 256) ((LAS unsigned*)(lds + STAGE_BYTES))[(par ^ 1) * 256 + tid] = S.arow(nxt, tid); }
        for (int t = 0; t < nt; t += 2) {
            const bool last = (t == nt - 2);
            const char* a1 = cA + (size_t)(t + 1) * kA;
            const char* a2 = last ? nA : cA + (size_t)(t + 2) * kA; const char* a3 = a2 + kA;
            const char* b2 = last ? nB : ((t + 2 < cur.ntb) ? cB + (size_t)(t + 2) * 128 : cur.B2 + (size_t)(t + 2 - cur.ntb) * 128);
            const char* b3 = last ? ((1 < nxt.ntb) ? nB + 128 : nxt.B2 + (size_t)(1 - nxt.ntb) * 128) : ((t + 3 < cur.ntb) ? cB + (size_t)(t + 3) * 128 : cur.B2 + (size_t)(t + 3 - cur.ntb) * 128);
            const int o2 = (last && has_next) ? (par ^ 1) : par;
            PG8_LDB(B0, 0, 0); PG8_LDB(B1, 0, 1); PG8_SCHED; PG8_LDA(At, 0, 0); PG8_STAGE_A(PG8_SA(1, 1), a1, par, 1);
            PG8_WAIT_V(8); PG8_WAIT_L(0); PG8_BAR; PG8_MMA(0, 0, At, B0); PG8_MMA(0, 1, At, B1); PG8_BAR; PG8_SCHED;
            PG8_LDA(At, 0, 1); PG8_STAGE_B(PG8_SB(0, 0), b2, 0); PG8_STAGE_B(PG8_SB(0, 1), b2, 1); PG8_STAGE_A(PG8_SA(0, 0), a2, o2, 0);
            PG8_WAIT_V(8); PG8_WAIT_L(0); PG8_BAR; PG8_MMA(1, 0, At, B0); PG8_MMA(1, 1, At, B1); PG8_BAR; PG8_SCHED;
            PG8_LDB(B0, 1, 0); PG8_LDB(B1, 1, 1); PG8_SCHED; PG8_LDA(At, 1, 0); PG8_STAGE_A(PG8_SA(0, 1), a2, o2, 1);
            PG8_WAIT_V(8); PG8_WAIT_L(0); PG8_BAR; PG8_MMA(0, 0, At, B0); PG8_MMA(0, 1, At, B1); PG8_BAR; PG8_SCHED;
            PG8_LDA(At, 1, 1); PG8_STAGE_B(PG8_SB(1, 0), b3, 0); PG8_STAGE_B(PG8_SB(1, 1), b3, 1); PG8_STAGE_A(PG8_SA(1, 0), a3, o2, 0);
            PG8_WAIT_V(8); PG8_WAIT_L(0); PG8_BAR; PG8_MMA(1, 0, At, B0); PG8_MMA(1, 1, At, B1); PG8_BAR; PG8_SCHED;
        }
        const int did_epi = cur.epi;
        if (did_epi) { if (wr == 0) PG8_BAR; S.epilogue(acc, cur, wr, wc, fr, fq); }
        if (!has_next) break;
        if (did_epi) PG8_ZERO_ACC();
        cur = nxt; ++ui;
        par ^= 1;
        if (did_epi) { if (wr == 1) PG8_BAR; }
    }
    PG8_WAIT_V(0);
    PG8_BAR;
#undef PG8_SA
#undef PG8_SB
#undef PG8_STAGE_A
#undef PG8_STAGE_B
#undef PG8_LDA
#undef PG8_LDB
#undef PG8_MMA
#undef PG8_WAIT_V
#undef PG8_WAIT_L
#undef PG8_BAR
#undef PG8_SCHED
#undef PG8_ZERO_ACC
}
}

using pg8::Seg; using pg8::Acc;
#define EPI_ROWCOL() const int row0 = wr * 64 + fr, col0 = wc * 32 + 8 * fq

struct PolInProj {
    static constexpr bool GATHER = false;
    const char* A; const char* B; int lda2, ldb2, kA, nt; pg8::TileOrder ord;
    bf16_t* P; const float* bias;
    __device__ __forceinline__ bool next(int i, Seg& s) const { int pm, pn; if (!ord.tile(i, pm, pn)) return false; s.A = A; s.B = B + (size_t)pn * 256 * ldb2; s.B2 = s.B; s.nt = nt; s.ntb = nt; s.epi = 1; s.pm = pm; s.pn = pn; s.aux = 0; return true; }
    __device__ __forceinline__ unsigned arow(const Seg&, int) const { return 0u; }
    __device__ __forceinline__ size_t arow0(const Seg& s) const { return (size_t)s.pm * 256 * lda2; }
    __device__ __forceinline__ void epilogue(Acc& acc, const Seg& s, int wr, int wc, int fr, int fq) const {
        EPI_ROWCOL();
        f32x4 bv[2][2];
#pragma unroll
        for (int bj = 0; bj < 2; ++bj)
#pragma unroll
            for (int n = 0; n < 2; ++n) bv[bj][n] = *(const f32x4*)(bias + s.pn * 256 + col0 + bj * 128 + 4 * n);
#pragma unroll
        for (int ai = 0; ai < 2; ++ai)
#pragma unroll
            for (int m = 0; m < 4; ++m) {
                bf16_t* rowp = P + (size_t)(s.pm * 256 + row0 + ai * 128 + m * 16) * PP + s.pn * 256 + col0;
#pragma unroll
                for (int bj = 0; bj < 2; ++bj) { const f32x4 v0 = acc[ai][bj][m][0] + bv[bj][0], v1 = acc[ai][bj][m][1] + bv[bj][1];
                    u32x4 w; w.x = cvt_pk_bf16(v0[0], v0[1]); w.y = cvt_pk_bf16(v0[2], v0[3]); w.z = cvt_pk_bf16(v1[0], v1[1]); w.w = cvt_pk_bf16(v1[2], v1[3]);
                    *(u32x4*)(rowp + bj * 128) = w; }
            }
    }
};
struct PolOutProj {
    static constexpr bool GATHER = false;
    const char* A; const char* B; int lda2, ldb2, kA, nt; pg8::TileOrder ord;
    bf16_t* d1;
    __device__ __forceinline__ bool next(int i, Seg& s) const { int pm, pn; if (!ord.tile(i, pm, pn)) return false; s.A = A; s.B = B + (size_t)pn * 256 * ldb2; s.B2 = s.B; s.nt = nt; s.ntb = nt; s.epi = 1; s.pm = pm; s.pn = pn; s.aux = 0; return true; }
    __device__ __forceinline__ unsigned arow(const Seg&, int) const { return 0u; }
    __device__ __forceinline__ size_t arow0(const Seg& s) const { return (size_t)s.pm * 256 * lda2; }
    __device__ __forceinline__ void epilogue(Acc& acc, const Seg& s, int wr, int wc, int fr, int fq) const {
        EPI_ROWCOL();
#pragma unroll
        for (int ai = 0; ai < 2; ++ai)
#pragma unroll
            for (int m = 0; m < 4; ++m) {
                bf16_t* rowp = d1 + (size_t)(s.pm * 256 + row0 + ai * 128 + m * 16) * D_ + s.pn * 256 + col0;
#pragma unroll
                for (int bj = 0; bj < 2; ++bj) { const f32x4 v0 = acc[ai][bj][m][0], v1 = acc[ai][bj][m][1];
                    u32x4 w; w.x = cvt_pk_bf16(v0[0], v0[1]); w.y = cvt_pk_bf16(v0[2], v0[3]); w.z = cvt_pk_bf16(v1[0], v1[1]); w.w = cvt_pk_bf16(v1[2], v1[3]);
                    *(u32x4*)(rowp + bj * 128) = w; }
            }
    }
};
struct PolMerge {
    static constexpr bool GATHER = false;
    const char* O; const char* H; const char* WBR; const char* WG;
    int lda2, ldb2, kA; int vcu, G;
    bf16_t* merged; const float* biasg; char* ys; char* ps;
    __device__ __forceinline__ bool next(int i, Seg& s) const {
        const int combo = vcu + G * (i / 6), j = i % 6; if (combo >= 512) return false;
        const int pm = combo >> 2, c = combo & 3, br = j >> 1;
        const int kofs = (br == 0) ? 0 : (br == 1 ? 384 : 640);
        if (!(j & 1)) { s.A = O + kofs * 2; s.B = WBR + (size_t)(c * 256) * 2048 + kofs * 2; s.nt = (br == 1) ? 4 : 6; }
        else { s.A = H; s.B = WG + (size_t)(br * 1024 + c * 256) * 2048; s.nt = 16; }
        s.B2 = s.B; s.ntb = s.nt; s.epi = 1; s.pm = pm; s.pn = c; s.aux = j; return true;
    }
    __device__ __forceinline__ unsigned arow(const Seg&, int) const { return 0u; }
    __device__ __forceinline__ size_t arow0(const Seg& s) const { return (size_t)s.pm * 256 * 2048; }
    template <int BR>
    __device__ __forceinline__ void gate_epi(Acc& acc, const Seg& s, int row0, int col0, unsigned tofs0) const {
        constexpr int DEPTH = 4;
        f32x4 b0[2], b1[2];
#pragma unroll
        for (int bj = 0; bj < 2; ++bj) { b0[bj] = *(const f32x4*)(biasg + BR * 1024 + s.pn * 256 + col0 + bj * 128); b1[bj] = *(const f32x4*)(biasg + BR * 1024 + s.pn * 256 + col0 + bj * 128 + 4); }
        u32x4 yq[DEPTH], pq[DEPTH];
#pragma unroll
        for (int e = 0; e < DEPTH; ++e) { unsigned tofs = tofs0; asm volatile("" : "+v"(tofs)); yq[e] = *(const u32x4*)((ys + e * 8192) + tofs); if (BR > 0) pq[e] = *(const u32x4*)((ps + e * 8192) + tofs); else pq[e] = (u32x4){0u, 0u, 0u, 0u}; }
#pragma unroll
        for (int e = 0; e < 16; ++e) {
            const int ai = e >> 3, bj = (e >> 2) & 1, m = e & 3;
            const u32x4 yw = yq[e % DEPTH], pw = pq[e % DEPTH];
            asm volatile("" ::: "memory");
            if (e + DEPTH < 16) { unsigned tofs = tofs0; asm volatile("" : "+v"(tofs)); yq[e % DEPTH] = *(const u32x4*)((ys + (e + DEPTH) * 8192) + tofs); if (BR > 0) pq[e % DEPTH] = *(const u32x4*)((ps + (e + DEPTH) * 8192) + tofs); }
            asm volatile("" ::: "memory");
            const f32x4 g0 = acc[ai][bj][m][0] + b0[bj], g1 = acc[ai][bj][m][1] + b1[bj];
            float z[8];
            z[0] = fast_sigmoid(g0[0]) * __builtin_bit_cast(float, yw.x << 16); z[1] = fast_sigmoid(g0[1]) * __builtin_bit_cast(float, yw.x & 0xffff0000u);
            z[2] = fast_sigmoid(g0[2]) * __builtin_bit_cast(float, yw.y << 16); z[3] = fast_sigmoid(g0[3]) * __builtin_bit_cast(float, yw.y & 0xffff0000u);
            z[4] = fast_sigmoid(g1[0]) * __builtin_bit_cast(float, yw.z << 16); z[5] = fast_sigmoid(g1[1]) * __builtin_bit_cast(float, yw.z & 0xffff0000u);
            z[6] = fast_sigmoid(g1[2]) * __builtin_bit_cast(float, yw.w << 16); z[7] = fast_sigmoid(g1[3]) * __builtin_bit_cast(float, yw.w & 0xffff0000u);
            if (BR > 0) {
                z[0] += __builtin_bit_cast(float, pw.x << 16); z[1] += __builtin_bit_cast(float, pw.x & 0xffff0000u); z[2] += __builtin_bit_cast(float, pw.y << 16); z[3] += __builtin_bit_cast(float, pw.y & 0xffff0000u);
                z[4] += __builtin_bit_cast(float, pw.z << 16); z[5] += __builtin_bit_cast(float, pw.z & 0xffff0000u); z[6] += __builtin_bit_cast(float, pw.w << 16); z[7] += __builtin_bit_cast(float, pw.w & 0xffff0000u);
            }
            u32x4 w; w.x = cvt_pk_bf16(z[0], z[1]); w.y = cvt_pk_bf16(z[2], z[3]); w.z = cvt_pk_bf16(z[4], z[5]); w.w = cvt_pk_bf16(z[6], z[7]);
            if (BR < 2) { unsigned tofs = tofs0; asm volatile("" : "+v"(tofs)); *(u32x4*)((ps + e * 8192) + tofs) = w; }
            else *(u32x4*)(merged + (size_t)(s.pm * 256 + row0 + ai * 128 + m * 16) * D_ + s.pn * 256 + col0 + bj * 128) = w;
        }
    }
    __device__ __forceinline__ void epilogue(Acc& acc, const Seg& s, int wr, int wc, int fr, int fq) const {
        EPI_ROWCOL(); const int j = s.aux; const unsigned tofs0 = (unsigned)((((wr << 2) | wc) << 6) | (fq << 4) | fr) * 16u;
        if (!(j & 1)) {
#pragma unroll
            for (int e = 0; e < 16; ++e) { const int ai = e >> 3, bj = (e >> 2) & 1, m = e & 3; const f32x4 v0 = acc[ai][bj][m][0], v1 = acc[ai][bj][m][1]; unsigned tofs = tofs0; asm volatile("" : "+v"(tofs));
                u32x4 w; w.x = cvt_pk_bf16(v0[0], v0[1]); w.y = cvt_pk_bf16(v0[2], v0[3]); w.z = cvt_pk_bf16(v1[0], v1[1]); w.w = cvt_pk_bf16(v1[2], v1[3]);
                *(u32x4*)((ys + e * 8192) + tofs) = w; }
        } else if (j == 1) gate_epi<0>(acc, s, row0, col0, tofs0);
        else if (j == 3) gate_epi<1>(acc, s, row0, col0, tofs0);
        else gate_epi<2>(acc, s, row0, col0, tofs0);
    }
};
__device__ __forceinline__ bool moe_find(const LAS unsigned* cnt, int rt, int& bucket, int& local, int& count) {
    int accn = 0;
    for (int b = 0; b < 24; ++b) { const int c = (int)cnt[b]; const int n = (c + 255) >> 8; if (rt < accn + n) { bucket = b; local = rt - accn; count = c; return true; } accn += n; }
    return false;
}
__device__ __forceinline__ void pair_of(int pidx, int& a, int& b) { a = (pidx < 3) ? 0 : (pidx < 5 ? 1 : 2); b = (pidx < 3) ? pidx + 1 : (pidx < 5 ? pidx - 1 : 3); }
struct PolMoeUp {
    static constexpr bool GATHER = true;
    __device__ __forceinline__ size_t arow0(const Seg&) const { return 0; }
    const char* H; const char* WGU; int lda2, ldb2, kA; int c, G;
    const LAS unsigned* cnt; const int* list; const float* tokw; bf16_t* hid;
    __device__ __forceinline__ bool next(int i, Seg& s) const {
        const int u = i * G + c, rt = u >> 2, pn = u & 3; int bucket, local, count; if (!moe_find(cnt, rt, bucket, local, count)) return false;
        int a, b; pair_of(bucket % 6, a, b); const int e = (bucket / 6) * 4 + (pn < 2 ? a : b);
        s.A = H; s.B = WGU + ((size_t)e * 512 + (pn & 1) * 256) * 2048; s.B2 = s.B; s.nt = 16; s.ntb = 16; s.epi = 1; s.pm = bucket | (local << 8); s.pn = pn; s.aux = count; return true;
    }
    __device__ __forceinline__ unsigned arow(const Seg& s, int r) const { int idx = (s.pm >> 8) * 256 + r; idx = idx < s.aux ? idx : s.aux - 1; return (unsigned)list[(size_t)(s.pm & 255) * T_ + idx] * 2048u; }
    __device__ __forceinline__ void epilogue(Acc& acc, const Seg& s, int wr, int wc, int fr, int fq) const {
        EPI_ROWCOL(); const int bucket = s.pm & 255, local = s.pm >> 8, slot = s.pn >> 1;
        int tok[8]; float w[8];
#pragma unroll
        for (int e = 0; e < 8; ++e) { const int idx = local * 256 + row0 + (e >> 2) * 128 + (e & 3) * 16; tok[e] = list[(size_t)bucket * T_ + (idx < s.aux ? idx : s.aux - 1)]; }
#pragma unroll
        for (int e = 0; e < 8; ++e) w[e] = tokw[tok[e] * 2 + slot];
#pragma unroll
        for (int e = 0; e < 8; ++e) { const int ai = e >> 2, m = e & 3; const bool valid = (local * 256 + row0 + ai * 128 + m * 16) < s.aux;
            float hv[8];
#pragma unroll
            for (int n = 0; n < 2; ++n)
#pragma unroll
                for (int k = 0; k < 4; ++k) { const float g = acc[ai][0][m][n][k], u = acc[ai][1][m][n][k]; hv[n * 4 + k] = g * fast_sigmoid(g) * u * w[e]; }
            u32x4 o; o.x = cvt_pk_bf16(hv[0], hv[1]); o.y = cvt_pk_bf16(hv[2], hv[3]); o.z = cvt_pk_bf16(hv[4], hv[5]); o.w = cvt_pk_bf16(hv[6], hv[7]);
            if (valid) *(u32x4*)(hid + (size_t)tok[e] * 512 + slot * 256 + (s.pn & 1) * 128 + col0) = o;
        }
    }
};
struct PolMoeDown {
    static constexpr bool GATHER = true;
    __device__ __forceinline__ size_t arow0(const Seg&) const { return 0; }
    const char* HID; const char* WD; int lda2, ldb2, kA; int c, G;
    const LAS unsigned* cnt; const int* list; bf16_t* d2;
    __device__ __forceinline__ bool next(int i, Seg& s) const {
        const int u = i * G + c, rt = u >> 2, pn = u & 3; int bucket, local, count; if (!moe_find(cnt, rt, bucket, local, count)) return false;
        int a, b; pair_of(bucket % 6, a, b); const int g4 = (bucket / 6) * 4;
        s.A = HID; s.B = WD + ((size_t)(g4 + a) * 1024 + pn * 256) * 512; s.B2 = WD + ((size_t)(g4 + b) * 1024 + pn * 256) * 512; s.nt = 8; s.ntb = 4; s.epi = 1; s.pm = bucket | (local << 8); s.pn = pn; s.aux = count; return true;
    }
    __device__ __forceinline__ unsigned arow(const Seg& s, int r) const { int idx = (s.pm >> 8) * 256 + r; idx = idx < s.aux ? idx : s.aux - 1; return (unsigned)list[(size_t)(s.pm & 255) * T_ + idx] * 1024u; }
    __device__ __forceinline__ void epilogue(Acc& acc, const Seg& s, int wr, int wc, int fr, int fq) const {
        EPI_ROWCOL(); const int bucket = s.pm & 255, local = s.pm >> 8;
        int tok[8];
#pragma unroll
        for (int e = 0; e < 8; ++e) { const int idx = local * 256 + row0 + (e >> 2) * 128 + (e & 3) * 16; tok[e] = list[(size_t)bucket * T_ + (idx < s.aux ? idx : s.aux - 1)]; }
#pragma unroll
        for (int e = 0; e < 8; ++e) { const int ai = e >> 2, m = e & 3; const bool valid = (local * 256 + row0 + ai * 128 + m * 16) < s.aux;
            bf16_t* dp = d2 + (size_t)tok[e] * D_ + s.pn * 256 + col0;
#pragma unroll
            for (int bj = 0; bj < 2; ++bj) { const f32x4 v0 = acc[ai][bj][m][0], v1 = acc[ai][bj][m][1];
                u32x4 w; w.x = cvt_pk_bf16(v0[0], v0[1]); w.y = cvt_pk_bf16(v0[2], v0[3]); w.z = cvt_pk_bf16(v1[0], v1[1]); w.w = cvt_pk_bf16(v1[2], v1[3]);
                if (valid) *(u32x4*)(dp + bj * 128) = w; }
        }
    }
};

namespace att {
typedef LAS const char* lds_cptr;
typedef short v4i16_t __attribute__((ext_vector_type(4)));
__device__ __forceinline__ int crow(int r, int hi) { return (r & 3) + 8 * (r >> 2) + 4 * hi; }
#define SBAR() __builtin_amdgcn_sched_barrier(0)
__device__ __forceinline__ void glds16(const void* gsrc, unsigned lds_dst) { unsigned keep;
    asm volatile("s_mov_b32 %0, m0\n\ts_mov_b32 m0, %2\n\ts_nop 0\n\tglobal_load_lds_dwordx4 %1, off\n\ts_mov_b32 m0, %0" : "=&s"(keep) : "v"(gsrc), "s"(lds_dst) : "memory"); }
#define WAIT_BAR0() asm volatile("s_waitcnt vmcnt(0) lgkmcnt(0)\n\ts_barrier" ::: "memory")
__device__ __forceinline__ void kload8(bf16x8* kf, lds_cptr kp) {
    kf[0] = *(const LAS bf16x8*)(kp);        kf[1] = *(const LAS bf16x8*)(kp + 512);
    kf[2] = *(const LAS bf16x8*)(kp + 2048); kf[3] = *(const LAS bf16x8*)(kp + 2560);
    kf[4] = *(const LAS bf16x8*)(kp + 4096); kf[5] = *(const LAS bf16x8*)(kp + 4608);
    kf[6] = *(const LAS bf16x8*)(kp + 6144); kf[7] = *(const LAS bf16x8*)(kp + 6656);
}
#define MX3(a, b, c) __builtin_fmaxf(__builtin_fmaxf((a), (b)), (c))
__device__ __forceinline__ float rowmax(const f32x16& p0, const f32x16& p1) {
    float a = MX3(p0[0], p0[1], p1[0]), b = MX3(p0[2], p0[3], p1[1]); a = MX3(a, p1[2], p1[3]);
#pragma unroll
    for (int r = 4; r < 16; r += 4) { a = MX3(a, p0[r], p0[r + 1]); b = MX3(b, p0[r + 2], p0[r + 3]); a = MX3(a, p1[r], p1[r + 1]); b = MX3(b, p1[r + 2], p1[r + 3]); }
    const float m = __builtin_fmaxf(a, b); auto rr = __builtin_amdgcn_permlane32_swap(__float_as_uint(m), __float_as_uint(m), false, false);
    return __builtin_fmaxf(__uint_as_float(rr[0]), __uint_as_float(rr[1]));
}
__device__ __forceinline__ float halfsum(float v) { auto rr = __builtin_amdgcn_permlane32_swap(__float_as_uint(v), __float_as_uint(v), false, false); return __uint_as_float(rr[0]) + __uint_as_float(rr[1]); }
__device__ __forceinline__ s16x4 vtr(lds_cptr p) { return __builtin_bit_cast(s16x4, __builtin_amdgcn_ds_read_tr16_b64_v4i16((LAS v4i16_t*)p)); }
__device__ __forceinline__ void pv(f32x16* o, lds_cptr vp, bf16x8 pa0, bf16x8 pa1, bf16x8 pa2, bf16x8 pa3) {
#pragma unroll
    for (int d0 = 0; d0 < 2; ++d0) { s16x4 lo[4], hi[4];
#pragma unroll
        for (int ks = 0; ks < 4; ++ks) { lo[ks] = vtr(vp + d0 * 4096 + ks * 1024); hi[ks] = vtr(vp + d0 * 4096 + ks * 1024 + 512); }
#define PK(k) (bf16x8){lo[k][0], lo[k][1], lo[k][2], lo[k][3], hi[k][0], hi[k][1], hi[k][2], hi[k][3]}
        o[d0] = __builtin_amdgcn_mfma_f32_32x32x16_bf16(pa0, PK(0), o[d0], 0, 0, 0);
        o[d0] = __builtin_amdgcn_mfma_f32_32x32x16_bf16(pa1, PK(1), o[d0], 0, 0, 0);
        o[d0] = __builtin_amdgcn_mfma_f32_32x32x16_bf16(pa2, PK(2), o[d0], 0, 0, 0);
        o[d0] = __builtin_amdgcn_mfma_f32_32x32x16_bf16(pa3, PK(3), o[d0], 0, 0, 0);
#undef PK
    }
}
typedef float f32x2_t __attribute__((ext_vector_type(2))); typedef __bf16 bf16x2_t __attribute__((ext_vector_type(2)));
__device__ __forceinline__ unsigned cvtpk_s(float lo, float hi) { f32x2_t v = {lo, hi}; bf16x2_t b = __builtin_convertvector(v, bf16x2_t); return __builtin_bit_cast(unsigned, b); }
__device__ __forceinline__ int wave_min_i(int v) {
#pragma unroll
    for (int o = 1; o < 64; o <<= 1) v = min(v, __shfl_xor(v, o));
    return __builtin_amdgcn_readfirstlane(v); }
__device__ __forceinline__ int wave_max_i(int v) {
#pragma unroll
    for (int o = 1; o < 64; o <<= 1) v = max(v, __shfl_xor(v, o));
    return __builtin_amdgcn_readfirstlane(v); }

template <int MODE, bool EXIT>
__device__ __forceinline__ void flash_pass(LAS char* shm, const bf16_t* kbase, const bf16_t* vbase, int pitch, int t_lo, int t_hi, unsigned long long tmask, int tshift, int kref,
                                           const bf16x8* qr, int khi, int klo, float slope2, unsigned long long rmask, float& m, float& l, f32x16* o, float invl, float knmax = 0.f) {
    const int tid = opaque_tid(), lane = tid & 63, r32 = lane & 31, hi = lane >> 5; const int wid = __builtin_amdgcn_readfirstlane(tid >> 6);
    const unsigned lds0 = (unsigned)(uintptr_t)shm;
    const bf16_t* ksrc = kbase + (long)lane * pitch + wid * 8;
    const bf16_t* vsrc = vbase + (long)(16 * (wid & 3) + (lane >> 2)) * pitch + (wid >> 2) * 32 + (lane & 3) * 8;
    const unsigned kdst = lds0 + L_K + wid * 1024, vdst = lds0 + L_V + wid * 1024;
    const lds_cptr kp0 = (lds_cptr)shm + L_K + hi * 1024 + r32 * 16;
    const lds_cptr vp0 = (lds_cptr)shm + L_V + ((lane >> 4) & 1) * 32 + (lane & 3) * 8 + (4 * hi + ((lane & 15) >> 2)) * 64;
    LAS float* wsf = (LAS float*)(shm + L_WSF) + wid * 128;
    const int wmin_khi = wave_min_i(khi), wmax_klo = wave_max_i(klo);
#define ACTIVE(t) (((tmask) >> ((t) >> tshift)) & 1ull)
#define DMA_KV(t, slot) do { glds16(ksrc + (long)(t) * 64 * pitch, (unsigned)__builtin_amdgcn_readfirstlane(kdst + (slot) * SLOTB)); \
                             if (MODE != 2) glds16(vsrc + (long)(t) * 64 * pitch, (unsigned)__builtin_amdgcn_readfirstlane(vdst + (slot) * SLOTB)); } while (0)
    int t = t_hi - 1; while (t >= t_lo && !ACTIVE(t)) --t;
    if (t < t_lo) return;
    float qb = 0.f, mt = -INFINITY; LAS unsigned* votes = (LAS unsigned*)(shm + L_VOTE);
    if (EXIT) {
        float ss = 0.f;
#pragma unroll
        for (int d0 = 0; d0 < 4; ++d0)
#pragma unroll
            for (int e = 0; e < 8; ++e) { const float v = bf2f((unsigned short)qr[d0][e]); ss += v * v; }
        qb = sqrtf(halfsum(ss)) * knmax * 1.01f;
        if (tid < 64) votes[tid] = 0u;
    }
    int slot = 0;
    int tn = t - 1; while (tn >= t_lo && !ACTIVE(tn)) --tn;
    int tnn = tn - 1; while (tnn >= t_lo && !ACTIVE(tnn)) --tnn;
    constexpr int NDMA = (MODE != 2) ? 2 : 1;
    DMA_KV(t, 0);
    if (tn >= t_lo) DMA_KV(tn, 1);
    if (tnn >= t_lo) DMA_KV(tnn, 2);
    if (tnn >= t_lo) { if (NDMA == 2) asm volatile("s_waitcnt vmcnt(2) lgkmcnt(0)\n\ts_barrier" ::: "memory"); else asm volatile("s_waitcnt vmcnt(1) lgkmcnt(0)\n\ts_barrier" ::: "memory"); }
    else WAIT_BAR0();
    constexpr bool KE = EXIT;
    bf16x8 kf[8]; if (KE) kload8(kf, kp0);
    for (;;) {
        int tnnn = tnn - 1; while (tnnn >= t_lo && !ACTIVE(tnnn)) --tnnn;
        const int slot1 = (slot + 1) & 3, slot3 = (slot + 3) & 3;
        if (tnn >= t_lo && tnnn >= t_lo) DMA_KV(tnnn, slot3);
        if (!KE) kload8(kf, kp0 + slot * SLOTB);
        f32x16 p0, p1;
        if (MODE == 1) { const LAS float* fb = (const LAS float*)(shm + L_AUX) + 64 * t + 4 * hi;
#pragma unroll
            for (int g = 0; g < 4; ++g) { const f32x4 a_ = *(const LAS f32x4*)(fb + 8 * g), b_ = *(const LAS f32x4*)(fb + 32 + 8 * g);
#pragma unroll
                for (int k = 0; k < 4; ++k) { p0[4 * g + k] = a_[k] - m; p1[4 * g + k] = b_[k] - m; } }
        } else { const bool rowok = (rmask >> (t >> tshift)) & 1ull;
            const float base = rowok ? (slope2 * (float)(64 * t + 4 * hi - kref) - m) : -INFINITY, base1 = base + 32.f * slope2;
#pragma unroll
            for (int r = 0; r < 16; ++r) { const float cr = (float)((r & 3) + 8 * (r >> 2)); p0[r] = __builtin_fmaf(slope2, cr, base); p1[r] = __builtin_fmaf(slope2, cr, base1); } }
#pragma unroll
        for (int d0 = 0; d0 < 4; ++d0) { p0 = __builtin_amdgcn_mfma_f32_32x32x16_bf16(kf[2 * d0], qr[d0], p0, 0, 0, 0); p1 = __builtin_amdgcn_mfma_f32_32x32x16_bf16(kf[2 * d0 + 1], qr[d0], p1, 0, 0, 0); }
        if (KE) { if (tn >= t_lo) kload8(kf, kp0 + slot1 * SLOTB); }
        if (64 * t + 63 > wmin_khi || 64 * t < wmax_klo) {
            const int kb = 64 * t + 4 * hi;
#pragma unroll
            for (int r = 0; r < 16; ++r) { const int kv = kb + (r & 3) + 8 * (r >> 2); if (kv > khi || kv < klo) p0[r] = -INFINITY; if (kv + 32 > khi || kv + 32 < klo) p1[r] = -INFINITY; }
        }
        if (MODE == 2) {
            LAS float* imp = (LAS float*)(shm + L_IMP) + (wid * 8 + (r32 >> 2)) * IMP_LD + 64 * t + 4 * hi;
#pragma unroll
            for (int r = 0; r < 16; ++r) {
                float a = __builtin_amdgcn_exp2f(p0[r]) * invl, b = __builtin_amdgcn_exp2f(p1[r]) * invl;
                a += __shfl_xor(a, 1); a += __shfl_xor(a, 2); b += __shfl_xor(b, 1); b += __shfl_xor(b, 2);
                if ((r32 & 3) == 0) { imp[(r & 3) + 8 * (r >> 2)] = a; imp[32 + (r & 3) + 8 * (r >> 2)] = b; }
            }
        } else {
            const float rm = rowmax(p0, p1);
            if (EXIT) mt = __builtin_fmaxf(mt, rm + m);
            if (__any(rm > THR)) {
                const float dl = __builtin_fmaxf(rm, 0.f); m += dl;
#pragma unroll
                for (int r = 0; r < 16; ++r) { p0[r] -= dl; p1[r] -= dl; }
                const float f = __builtin_amdgcn_exp2f(-dl); l *= f;
                if (hi == 0) wsf[r32] = f;
                asm volatile("s_waitcnt lgkmcnt(0)" ::: "memory");
#pragma unroll
                for (int r = 0; r < 16; ++r) { const float fr_ = wsf[crow(r, hi)]; o[0][r] *= fr_; o[1][r] *= fr_; }
            }
            const lds_cptr vp = vp0 + slot * SLOTB;
            s16x4 vlo[4][2], vhi[4][2];
#pragma unroll
            for (int ks = 0; ks < 4; ++ks)
#pragma unroll
                for (int d0 = 0; d0 < 2; ++d0) { vlo[ks][d0] = vtr(vp + d0 * 4096 + ks * 1024); vhi[ks][d0] = vtr(vp + d0 * 4096 + ks * 1024 + 512); }
            float sacc = 0.f;
#pragma unroll
            for (int ks = 0; ks < 4; ++ks) {
                float e[8];
#pragma unroll
                for (int i = 0; i < 8; ++i) { e[i] = __builtin_amdgcn_exp2f((ks < 2) ? p0[(ks & 1) * 8 + i] : p1[(ks & 1) * 8 + i]); sacc += e[i]; }
                const u32x4 pw = (u32x4){cvtpk_s(e[0], e[1]), cvtpk_s(e[2], e[3]), cvtpk_s(e[4], e[5]), cvtpk_s(e[6], e[7])};
                const bf16x8 pa = __builtin_bit_cast(bf16x8, pw);
#pragma unroll
                for (int d0 = 0; d0 < 2; ++d0) { const bf16x8 vf = (bf16x8){vlo[ks][d0][0], vlo[ks][d0][1], vlo[ks][d0][2], vlo[ks][d0][3], vhi[ks][d0][0], vhi[ks][d0][1], vhi[ks][d0][2], vhi[ks][d0][3]};
                    o[d0] = __builtin_amdgcn_mfma_f32_32x32x16_bf16(pa, vf, o[d0], 0, 0, 0); }
            }
            l += sacc;
        }
        if (tn < t_lo) { WAIT_BAR0(); break; }
        if (EXIT) {
            const float bmax = (MODE == 1) ? ((const LAS float*)(shm + L_AUX))[64 * tn + 63] : slope2 * (float)(64 * tn + 63 - kref);
            const bool rowdone = (khi < 0) || (klo > 64 * tn + 63) || ((rmask & ((2ull << (tn >> tshift)) - 1ull)) == 0ull);
            const bool sat = rowdone || (qb + bmax < mt - 50.f);
            if (__all(sat) && lane == 0) __hip_atomic_fetch_add(&votes[tn], 1u, __ATOMIC_RELAXED, __HIP_MEMORY_SCOPE_WORKGROUP);
        }
        if (tnn >= t_lo && tnnn >= t_lo) { if (NDMA == 2) asm volatile("s_waitcnt vmcnt(2) lgkmcnt(0)\n\ts_barrier" ::: "memory"); else asm volatile("s_waitcnt vmcnt(1) lgkmcnt(0)\n\ts_barrier" ::: "memory"); }
        else WAIT_BAR0();
        if (EXIT) { if (votes[tn] == 8u) { WAIT_BAR0(); break; } }
        t = tn; tn = tnn; tnn = tnnn; slot = slot1;
    }
#undef ACTIVE
#undef DMA_KV
}
__device__ __forceinline__ float inv_l(float l) { const float lt = halfsum(l); return lt > 0.f ? 1.0f / lt : 0.f; }
__device__ __forceinline__ void scale_rows(LAS char* shm, f32x16* o, float fac, f32x16* dst, bool accumulate) {
    const int tid_ = opaque_tid(), lane = tid_ & 63, r32 = lane & 31, hi = lane >> 5; const int wid = __builtin_amdgcn_readfirstlane(tid_ >> 6);
    LAS float* wsf = (LAS float*)(shm + L_WSF) + wid * 128 + 64;
    if (hi == 0) wsf[r32] = fac;
    asm volatile("s_waitcnt lgkmcnt(0)" ::: "memory");
#pragma unroll
    for (int r = 0; r < 16; ++r) { const float f = wsf[crow(r, hi)];
        if (accumulate) { dst[0][r] += o[0][r] * f; dst[1][r] += o[1][r] * f; } else { dst[0][r] = o[0][r] * f; dst[1][r] = o[1][r] * f; } }
    asm volatile("s_waitcnt lgkmcnt(0)" ::: "memory");
}
template <class RowPtr>
__device__ __forceinline__ void store_o(LAS char* shm, const f32x16* o, const RowPtr& rowptr) {
    const int tid_ = opaque_tid(), lane = tid_ & 63, r32 = lane & 31, hi = lane >> 5; const int wid = __builtin_amdgcn_readfirstlane(tid_ >> 6);
    LAS bf16_t* stg = (LAS bf16_t*)(shm + L_OST) + wid * 2048;
#pragma unroll
    for (int r = 0; r < 16; ++r) { const int orow = crow(r, hi);
#pragma unroll
        for (int d0 = 0; d0 < 2; ++d0) stg[orow * 64 + d0 * 32 + r32] = (bf16_t)f2bf(o[d0][r]); }
    asm volatile("s_waitcnt lgkmcnt(0)" ::: "memory");
#pragma unroll
    for (int i = 0; i < 4; ++i) { const int row = i * 8 + (lane >> 3), ch = lane & 7; const u32x4 v = *(const LAS u32x4*)(stg + row * 64 + ch * 8); *(u32x4*)(rowptr(row) + ch * 8) = v; }
    asm volatile("s_waitcnt lgkmcnt(0)" ::: "memory");
}
__device__ __forceinline__ void load_q(bf16x8* qr, const bf16_t* qrow, int hi) {
#pragma unroll
    for (int d0 = 0; d0 < 4; ++d0) qr[d0] = *(const bf16x8*)(qrow + d0 * 16 + hi * 8);
}

__device__ __forceinline__ void fox_unit(LAS char* shm, const bf16_t* P, const float* FB, bf16_t* O, int b, int h, int qb, float knmax) {
    const int tid = opaque_tid(), lane = tid & 63, r32 = lane & 31, hi = lane >> 5; const int wid = __builtin_amdgcn_readfirstlane(tid >> 6);
    const int q0 = qb * 256, qpos = q0 + wid * 32 + r32;
    const float* fbs = FB + (size_t)(b * 6 + h) * S_; const float ref = fbs[q0];
    LAS float* fbl = (LAS float*)(shm + L_AUX);
    for (int i = tid; i < q0 + 256; i += 512) fbl[i] = fbs[i] - ref;
    bf16x8 qr[4]; load_q(qr, P + (size_t)(b * S_ + qpos) * PP + PC_FQ + h * 64, hi);
    float m = 0.f, l = 0.f; f32x16 o[2]; o[0] = f32x16{}; o[1] = f32x16{};
    flash_pass<1, true>(shm, P + (size_t)(b * S_) * PP + PC_FK + h * 64, P + (size_t)(b * S_) * PP + PC_FV + h * 64, PP, 0, 4 * (qb + 1), ~0ull, 0, 0, qr, qpos, -(1 << 30), 0.f, ~0ull, m, l, o, 0.f, knmax);
    scale_rows(shm, o, inv_l(l), o, false);
    bf16_t* obase = O + (size_t)(b * S_ + q0 + wid * 32) * D_ + h * 64;
    store_o(shm, o, [&](int row) { return obase + (size_t)row * D_; });
}
__device__ __forceinline__ void moba_unit(LAS char* shm, const bf16_t* P, const float* KMEAN, bf16_t* O, int b, int h, int qb, float knmax) {
    const int tid = opaque_tid(), lane = tid & 63, r32 = lane & 31, hi = lane >> 5; const int wid = __builtin_amdgcn_readfirstlane(tid >> 6);
    const int q0 = qb * 256, cur = qb;
    LAS unsigned* mb = (LAS unsigned*)(shm + L_SELM);
    LAS unsigned* un = (LAS unsigned*)(shm + L_UNION);
    LAS float* kml = (LAS float*)(shm + L_AUX);
    if (tid == 0) un[0] = 0u;
    if (tid < 256) ((LAS f32x4*)kml)[tid] = ((const f32x4*)(KMEAN + (size_t)(b * 6 + h) * 16 * 64))[tid];
    __syncthreads();
    {
        const int qi = tid & 255, hf = tid >> 8;
        const bf16_t* qrow = P + (size_t)(b * S_ + q0 + qi) * PP + PC_MQ + h * 64;
        float q[64];
#pragma unroll
        for (int c = 0; c < 8; ++c) { const u32x4 v = *(const u32x4*)(qrow + c * 8);
            q[c * 8 + 0] = __builtin_bit_cast(float, v.x << 16); q[c * 8 + 1] = __builtin_bit_cast(float, v.x & 0xffff0000u); q[c * 8 + 2] = __builtin_bit_cast(float, v.y << 16); q[c * 8 + 3] = __builtin_bit_cast(float, v.y & 0xffff0000u);
            q[c * 8 + 4] = __builtin_bit_cast(float, v.z << 16); q[c * 8 + 5] = __builtin_bit_cast(float, v.z & 0xffff0000u); q[c * 8 + 6] = __builtin_bit_cast(float, v.w << 16); q[c * 8 + 7] = __builtin_bit_cast(float, v.w & 0xffff0000u); }
        int s0 = -1, s1 = -1, s2 = -1; float g0 = -INFINITY, g1 = -INFINITY, g2 = -INFINITY;
        for (int n = hf; n < cur; n += 2) {
            float g = 0.f;
#pragma unroll
            for (int d4 = 0; d4 < 16; ++d4) { const f32x4 kv = *(const LAS f32x4*)(kml + n * 64 + d4 * 4); g += (q[d4 * 4] * kv.x + q[d4 * 4 + 1] * kv.y) + (q[d4 * 4 + 2] * kv.z + q[d4 * 4 + 3] * kv.w); }
            if (g > g0) { s2 = s1; g2 = g1; s1 = s0; g1 = g0; s0 = n; g0 = g; }
            else if (g > g1) { s2 = s1; g2 = g1; s1 = n; g1 = g; }
            else if (g > g2) { s2 = n; g2 = g; }
        }
        LAS float* xg = (LAS float*)(shm + L_AUX + 4096); LAS int* xs = (LAS int*)(shm + L_AUX + 4096 + 3072);
        if (hf == 1) { xg[qi * 3] = g0; xg[qi * 3 + 1] = g1; xg[qi * 3 + 2] = g2; xs[qi * 3] = s0; xs[qi * 3 + 1] = s1; xs[qi * 3 + 2] = s2; }
        __syncthreads();
        if (hf == 0) {
#pragma unroll
            for (int k = 0; k < 3; ++k) { const float g = xg[qi * 3 + k]; const int n = xs[qi * 3 + k];
                if (n >= 0) {
                    if (g > g0 || (g == g0 && n < s0)) { s2 = s1; g2 = g1; s1 = s0; g1 = g0; s0 = n; g0 = g; }
                    else if (g > g1 || (g == g1 && n < s1)) { s2 = s1; g2 = g1; s1 = n; g1 = g; }
                    else if (g > g2 || (g == g2 && n < s2)) { s2 = n; g2 = g; }
                } }
            unsigned mask = 1u << cur;
            if (s0 >= 0) mask |= 1u << s0; if (s1 >= 0) mask |= 1u << s1; if (s2 >= 0) mask |= 1u << s2;
            mb[qi] = mask;
            __hip_atomic_fetch_or(&un[0], mask, __ATOMIC_RELAXED, __HIP_MEMORY_SCOPE_WORKGROUP);
        }
    }
    __syncthreads();
    const unsigned uni = un[0];
    const unsigned long long rmask = mb[wid * 32 + r32];
    const int qpos = q0 + wid * 32 + r32;
    const float slope2 = exp2f(-8.0f * (float)(h + 1) / 6.0f) * LOG2E;
    bf16x8 qr[4]; load_q(qr, P + (size_t)(b * S_ + qpos) * PP + PC_MQ + h * 64, hi);
    float m = 0.f, l = 0.f; f32x16 o[2]; o[0] = f32x16{}; o[1] = f32x16{};
    flash_pass<0, true>(shm, P + (size_t)(b * S_) * PP + PC_MK + h * 64, P + (size_t)(b * S_) * PP + PC_MV + h * 64, PP, 0, 4 * (qb + 1), (unsigned long long)uni, 2, q0, qr, qpos, -(1 << 30), slope2, rmask, m, l, o, 0.f, knmax);
    scale_rows(shm, o, inv_l(l), o, false);
    bf16_t* obase = O + (size_t)(b * S_ + q0 + wid * 32) * D_ + 640 + h * 64;
    store_o(shm, o, [&](int row) { return obase + (size_t)row * D_; });
}
__device__ __forceinline__ void nsa_unit(LAS char* shm, const bf16_t* P, const bf16_t* KCMP, bf16_t* O, int b, int qb) {
    const int tid = opaque_tid(), lane = tid & 63, r32 = lane & 31, hi = lane >> 5; const int wid = __builtin_amdgcn_readfirstlane(tid >> 6);
    const int q0 = qb * 64, ql = wid * 8 + (r32 >> 2), head = r32 & 3, qpos = q0 + ql, cur = qb;
    const float slope2 = exp2f(-2.0f * (float)(head + 1)) * LOG2E;
    const bf16_t* prow = P + (size_t)(b * S_ + qpos) * PP;
    bf16x8 qr[4]; load_q(qr, prow + PC_NQ + head * 64, hi);
    const float gc = fast_sigmoid(bf2f(prow[PC_NG + 0 + head])), gs = fast_sigmoid(bf2f(prow[PC_NG + 4 + head])), gw = fast_sigmoid(bf2f(prow[PC_NG + 8 + head]));
    LAS float* impz = (LAS float*)(shm + L_IMP);
    for (int i = tid; i < 64 * IMP_LD; i += 512) impz[i] = 0.f;
    LAS unsigned long long* selm = (LAS unsigned long long*)(shm + L_SELM);
    LAS unsigned long long* un = (LAS unsigned long long*)(shm + L_UNION);
    if (tid == 0) un[0] = 0ull;
    f32x16 oacc[2]; f32x16 o[2];
    {
        const int nmax = (q0 + 63 - 31) >> 4;
        const int ntile = (q0 + 63 >= 31) ? (nmax >> 6) + 1 : 0;
        const int khi = (qpos >= 31) ? ((qpos - 31) >> 4) : -1;
        const bf16_t* kc = KCMP + (size_t)(b * 2 + 0) * 256 * 64; const bf16_t* vc = KCMP + (size_t)(b * 2 + 1) * 256 * 64;
        float m = 0.f, l = 0.f; o[0] = f32x16{}; o[1] = f32x16{};
        const int kref = q0 >> 4;
        flash_pass<0, false>(shm, kc, vc, 64, 0, ntile, ~0ull, 0, kref, qr, khi, -(1 << 30), slope2 * 16.f, ~0ull, m, l, o, 0.f);
        const float il = inv_l(l);
        scale_rows(shm, o, il * gc, oacc, false);
        float m2 = m, l2 = l;
        flash_pass<2, false>(shm, kc, vc, 64, 0, ntile, ~0ull, 0, kref, qr, khi, -(1 << 30), slope2 * 16.f, ~0ull, m2, l2, o, il);
    }
    __syncthreads();
    for (int qi = 0; qi < 8; ++qi) {
        const int q = wid * 8 + qi, j = lane;
        const LAS float* ip = (const LAS float*)(shm + L_IMP) + q * IMP_LD + 4 * j;
        const float is = ip[0] + 2.f * (ip[1] + ip[2] + ip[3]) + ip[4];
        const bool causal = j <= cur, forced = (j == 0) || (j > cur - 2);
        const float sc = causal ? (forced ? 1e9f : is) : -1e9f;
        bool sel;
        if (cur < 16) sel = causal;
        else {
            int cnt = 0;
#pragma unroll
            for (int jj = 0; jj < 64; ++jj) { const float v = __builtin_bit_cast(float, __builtin_amdgcn_readlane(__builtin_bit_cast(int, sc), jj)); cnt += (v > sc || (v == sc && jj < j)) ? 1 : 0; }
            sel = (cnt < 16) && causal;
        }
        const unsigned long long msk = __ballot(sel);
        if (lane == 0) { selm[q] = msk; __hip_atomic_fetch_or(&un[0], msk, __ATOMIC_RELAXED, __HIP_MEMORY_SCOPE_WORKGROUP); }
    }
    __syncthreads();
    const unsigned long long uni = un[0], rmask = selm[ql];
    {
        float m = 0.f, l = 0.f; o[0] = f32x16{}; o[1] = f32x16{};
        flash_pass<0, false>(shm, P + (size_t)(b * S_) * PP + PC_KS, P + (size_t)(b * S_) * PP + PC_VS, PP, 0, qb + 1, uni, 0, q0, qr, qpos, -(1 << 30), slope2, rmask, m, l, o, 0.f);
        scale_rows(shm, o, inv_l(l) * gs, oacc, true);
    }
    {
        float m = 0.f, l = 0.f; o[0] = f32x16{}; o[1] = f32x16{};
        const int tlo = qb >= 8 ? qb - 8 : 0;
        flash_pass<0, false>(shm, P + (size_t)(b * S_) * PP + PC_KW, P + (size_t)(b * S_) * PP + PC_VW, PP, tlo, qb + 1, ~0ull, 0, q0, qr, qpos, qpos - 511, slope2, ~0ull, m, l, o, 0.f);
        scale_rows(shm, o, inv_l(l) * gw, oacc, true);
    }
    bf16_t* obase = O + (size_t)(b * S_ + q0 + wid * 8) * D_ + 384;
    store_o(shm, oacc, [&](int row) { return obase + (size_t)(row >> 2) * D_ + (row & 3) * 64; });
}
#undef SBAR
}

struct Frame {
    LAS unsigned char* lds; volatile LAS unsigned* MISC; gu32* ctl;
    int tid, lane, wave, vcu, G;
    unsigned char* ws;
};
__device__ __forceinline__ float wave_sum(float v) {
#pragma unroll
    for (int o = 1; o < 64; o <<= 1) v += __shfl_xor(v, o);
    return v;
}
__device__ __forceinline__ int win_dst(int c) {
    if (c < 1152) return c; if (c < 1158) return 2944 + (c - 1152); if (c < 1798) return c - 6; if (c < 1810) return 2950 + (c - 1798); if (c < 2962) return c - 18; return c + 110;
}
__device__ __forceinline__ bool win_isq(int p) { return p < 384 || (p >= PC_NQ && p < PC_NQ + 256) || (p >= PC_MQ && p < PC_MQ + 384); }
__device__ __forceinline__ int rowmap(int kind, int n) { return kind == 1 ? win_dst(n) : (kind == 2 ? ((n >> 7) * 256 + (n & 127)) : (kind == 3 ? ((n >> 7) * 256 + 128 + (n & 127)) : n)); }
__device__ __forceinline__ void tr_item(const float* W, int N, bf16_t* WT, int dld, int dcol, int kind, LAS float* scr, int kb, int nb, int lane) {
    const int k0 = 64 * kb, n0 = 32 * nb;
    const int nn = n0 + (lane & 31);
#pragma unroll
    for (int i = 0; i < 32; ++i) { const int kk = 2 * i + (lane >> 5); scr[kk * 33 + (lane & 31)] = (nn < N) ? W[(size_t)(k0 + kk) * N + nn] : 0.f; }
    asm volatile("s_waitcnt lgkmcnt(0)" ::: "memory");
    const int c = lane & 7;
#pragma unroll
    for (int j = 0; j < 4; ++j) { const int n = (lane >> 3) + 8 * j; const LAS float* s = scr + (8 * c) * 33 + n;
        if (n0 + n < N) {
            const int dr = rowmap(kind, n0 + n); const float sc = (kind == 1 && win_isq(dr)) ? C2 : 1.0f;
            u32x4 o; o.x = pk2(s[0 * 33] * sc, s[1 * 33] * sc); o.y = pk2(s[2 * 33] * sc, s[3 * 33] * sc); o.z = pk2(s[4 * 33] * sc, s[5 * 33] * sc); o.w = pk2(s[6 * 33] * sc, s[7 * 33] * sc);
            *(u32x4*)(WT + (size_t)dr * dld + dcol + k0 + 8 * c) = o; } }
    asm volatile("s_waitcnt lgkmcnt(0)" ::: "memory");
}
struct CvtJob { const float* W; int K, N; bf16_t* WT; int dld, dcol, kind; };
__device__ __forceinline__ void convert_weights(Frame& F, const float* const* in) {
    LAS float* scr = (LAS float*)(F.lds + F.wave * 16384);
    const int gw = F.vcu * 8 + F.wave, NGW = F.G * 8;
    unsigned char* ws = F.ws;
    for (int g = gw; g < 2 * 10704; g += NGW) {
        const int l = g / 10704, r = g % 10704; int it; CvtJob J;
        if (r < 3024) { it = r; J.W = in[4] + (size_t)l * D_ * INC; J.K = D_; J.N = INC; J.WT = (bf16_t*)(ws + WS_WIN) + (size_t)l * NWIN * D_; J.dld = D_; J.dcol = 0; J.kind = 1; }
        else if (r < 3536) { const int br = (r < 3216) ? 0 : (r < 3344 ? 1 : 2); it = r - ((br == 0) ? 3024 : (br == 1 ? 3216 : 3344)); const int Kb = (br == 1) ? 256 : 384; const int kofs = (br == 0) ? 0 : (br == 1 ? 384 : 640);
            J.W = in[10 + br] + (size_t)l * Kb * D_; J.K = Kb; J.N = D_; J.WT = (bf16_t*)(ws + WS_WBR) + (size_t)l * D_ * D_; J.dld = D_; J.dcol = kofs; J.kind = 0; }
        else if (r < 4048) { it = r - 3536; J.W = in[13] + (size_t)l * D_ * D_; J.K = D_; J.N = D_; J.WT = (bf16_t*)(ws + WS_WOUT) + (size_t)l * D_ * D_; J.dld = D_; J.dcol = 0; J.kind = 0; }
        else if (r < 6096) { const int e = (r - 4048) >> 7; it = (r - 4048) & 127; J.W = in[18] + ((size_t)l * 16 + e) * D_ * 256; J.K = D_; J.N = 256; J.WT = (bf16_t*)(ws + WS_WGU) + ((size_t)l * 16 + e) * 512 * D_; J.dld = D_; J.dcol = 0; J.kind = 2; }
        else if (r < 8144) { const int e = (r - 6096) >> 7; it = (r - 6096) & 127; J.W = in[19] + ((size_t)l * 16 + e) * D_ * 256; J.K = D_; J.N = 256; J.WT = (bf16_t*)(ws + WS_WGU) + ((size_t)l * 16 + e) * 512 * D_; J.dld = D_; J.dcol = 0; J.kind = 3; }
        else if (r < 10192) { const int e = (r - 8144) >> 7; it = (r - 8144) & 127; J.W = in[20] + ((size_t)l * 16 + e) * 256 * D_; J.K = 256; J.N = D_; J.WT = (bf16_t*)(ws + WS_WD) + ((size_t)l * 16 + e) * D_ * 256; J.dld = 256; J.dcol = 0; J.kind = 0; }
        else { const int wh = (r - 10192) >> 8; it = (r - 10192) & 255; J.W = in[6] + ((size_t)l * 2 + wh) * 2048 * 256; J.K = 2048; J.N = 256; J.WT = (bf16_t*)(ws + WS_WC1) + ((size_t)l * 2 + wh) * 256 * 2048; J.dld = 2048; J.dcol = 0; J.kind = 0; }
        const int nnb = (J.N + 31) / 32;
        tr_item(J.W, J.N, J.WT, J.dld, J.dcol, J.kind, scr, it / nnb, it % nnb, F.lane);
    }
    const int gt = F.vcu * 512 + F.tid, NGT = F.G * 512;
    for (int i = gt; i < 2 * NWIN; i += NGT) { const int l = i / NWIN, p = i % NWIN; int c = -1;
        if (p < 1152) c = p; else if (p < 1792) c = p + 6; else if (p < 2944) c = p + 18; else if (p < 2950) c = 1152 + (p - 2944); else if (p < 2962) c = 1798 + (p - 2950); else if (p >= 3072) c = p - 110;
        ((float*)(ws + WS_BIAS))[i] = (c >= 0) ? in[5][l * INC + c] * (win_isq(p) ? C2 : 1.0f) : 0.f; }
    for (int i = gt; i < 2 * 110 * D_; i += NGT) { const int l = i / (110 * D_), r = (i % (110 * D_)) / D_, k = i % D_; ((bf16_t*)(ws + WS_WIN))[((size_t)l * NWIN + 2962 + r) * D_ + k] = 0; }
    for (int i = gt; i < 2 * 32 * 1024; i += NGT) { const int l = i >> 15, c = (i >> 10) & 31, k = i & 1023;
        const float w = (c < 4) ? in[14][((size_t)l * D_ + k) * 4 + c] : ((c < 20) ? in[16][((size_t)l * D_ + k) * 16 + (c - 4)] : 0.f);
        const unsigned hb = f2bf(w); const float lo = w - bf2f((unsigned short)hb);
        bf16_t* wrt = (bf16_t*)(ws + WS_WRT) + (size_t)l * 2 * 32 * 1024; wrt[c * 1024 + k] = (bf16_t)hb; wrt[32 * 1024 + c * 1024 + k] = (bf16_t)f2bf(lo); }
    for (int it = gw; it < 4 * 4 * 64; it += NGW) {
        const int m = it >> 8, hg = (it >> 6) & 3, kc = it & 63, h = hg * 64 + F.lane;
        const float* w1 = in[6] + (size_t)m * 2048 * 256 + h; const float* pos = in[9] + (size_t)m * 2048;
        float a = 0.f;
#pragma unroll
        for (int k = kc * 32; k < kc * 32 + 32; ++k) a += pos[k] * w1[(size_t)k * 256];
        ((float*)(ws + WS_BC1P))[(m * 64 + kc) * 256 + h] = a;
    }
}
__device__ __forceinline__ void load_row(f32x4* v, u32x2* a, u32x2* b, const float* x, const bf16_t* d1, const bf16_t* d2, size_t m, int lane) {
    const f32x4* xr = (const f32x4*)(x + m * D_) + lane;
#pragma unroll
    for (int j = 0; j < 4; ++j) v[j] = xr[64 * j];
    if (d1) { const u32x2* p = (const u32x2*)(d1 + m * D_) + lane;
#pragma unroll
        for (int j = 0; j < 4; ++j) a[j] = p[64 * j]; }
    if (d2) { const u32x2* p = (const u32x2*)(d2 + m * D_) + lane;
#pragma unroll
        for (int j = 0; j < 4; ++j) b[j] = p[64 * j]; }
}
__device__ __forceinline__ f32x4 add_bf4(f32x4 v, u32x2 w) { v.x += __builtin_bit_cast(float, w.x << 16); v.y += __builtin_bit_cast(float, w.x & 0xffff0000u); v.z += __builtin_bit_cast(float, w.y << 16); v.w += __builtin_bit_cast(float, w.y & 0xffff0000u); return v; }
__device__ __forceinline__ void norm_rows(Frame& F, const float* x, const bf16_t* d1, const bf16_t* d2, float* xout, const float* g, bf16_t* out) {
    const int gw = F.vcu * 8 + F.wave, NGW = F.G * 8;
    f32x4 gv[4];
#pragma unroll
    for (int j = 0; j < 4; ++j) gv[j] = ((const f32x4*)g)[F.lane + 64 * j];
    f32x4 vn[4]; u32x2 an[4], bn[4];
    if (gw < T_) load_row(vn, an, bn, x, d1, d2, (size_t)gw, F.lane);
    for (int m = gw; m < T_; m += NGW) {
        f32x4 v[4]; float s = 0.f;
#pragma unroll
        for (int j = 0; j < 4; ++j) { v[j] = vn[j]; if (d1) v[j] = add_bf4(v[j], an[j]); if (d2) v[j] = add_bf4(v[j], bn[j]); }
        if (m + NGW < T_) load_row(vn, an, bn, x, d1, d2, (size_t)(m + NGW), F.lane);
#pragma unroll
        for (int j = 0; j < 4; ++j) s += (v[j].x * v[j].x + v[j].y * v[j].y) + (v[j].z * v[j].z + v[j].w * v[j].w);
        const float r = 1.0f / sqrtf(wave_sum(s) * (1.0f / D_) + 1e-6f);
        if (xout) { f32x4* xo = (f32x4*)(xout + (size_t)m * D_) + F.lane;
#pragma unroll
            for (int j = 0; j < 4; ++j) xo[64 * j] = v[j]; }
        u32x2* o8 = (u32x2*)(out + (size_t)m * D_) + F.lane;
#pragma unroll
        for (int j = 0; j < 4; ++j) { u32x2 w; w.x = pk2(v[j].x * r * gv[j].x, v[j].y * r * gv[j].y); w.y = pk2(v[j].z * r * gv[j].z, v[j].w * r * gv[j].w); o8[64 * j] = w; }
    }
}
__device__ __forceinline__ void final_norm(Frame& F, const float* x, const bf16_t* d1, const bf16_t* d2, float* outp, const float* g) {
    const int gw = F.vcu * 8 + F.wave, NGW = F.G * 8;
    f32x4 gv[4];
#pragma unroll
    for (int j = 0; j < 4; ++j) gv[j] = ((const f32x4*)g)[F.lane + 64 * j];
    f32x4 vn[4]; u32x2 an[4], bn[4];
    if (gw < T_) load_row(vn, an, bn, x, d1, d2, (size_t)gw, F.lane);
    for (int m = gw; m < T_; m += NGW) {
        f32x4 v[4]; float s = 0.f;
#pragma unroll
        for (int j = 0; j < 4; ++j) { v[j] = add_bf4(add_bf4(vn[j], an[j]), bn[j]); }
        if (m + NGW < T_) load_row(vn, an, bn, x, d1, d2, (size_t)(m + NGW), F.lane);
#pragma unroll
        for (int j = 0; j < 4; ++j) s += (v[j].x * v[j].x + v[j].y * v[j].y) + (v[j].z * v[j].z + v[j].w * v[j].w);
        const float r = 1.0f / sqrtf(wave_sum(s) * (1.0f / D_) + 1e-6f);
        f32x4* xo = (f32x4*)(outp + (size_t)m * D_) + F.lane;
#pragma unroll
        for (int j = 0; j < 4; ++j) xo[64 * j] = v[j] * r * gv[j];
    }
}
__device__ __forceinline__ void norm2_route(Frame& F, const float* x, const bf16_t* d1, const float* g, bf16_t* out, const bf16_t* wrt, const float* bg, const float* be,
                                            unsigned* cnt, int* list, float* tokw) {
    constexpr int YLD = 1032;
    LAS bf16_t* yh = (LAS bf16_t*)F.lds; LAS bf16_t* yl = yh + 16 * YLD;
    LAS float* part = (LAS float*)(F.lds + 2 * 16 * YLD * 2);
    LAS float* lgt = part + 8 * 512;
    const int lane = F.lane, w = F.wave;
    bf16x8 bh[2][4], bl[2][4];
#pragma unroll
    for (int cb = 0; cb < 2; ++cb)
#pragma unroll
        for (int ks = 0; ks < 4; ++ks) { const size_t o = (size_t)(cb * 16 + (lane & 15)) * 1024 + 128 * w + 32 * ks + 8 * (lane >> 4);
            bh[cb][ks] = *(const bf16x8*)(wrt + o); bl[cb][ks] = *(const bf16x8*)(wrt + 32 * 1024 + o); }
    f32x4 gv[4];
#pragma unroll
    for (int j = 0; j < 4; ++j) gv[j] = ((const f32x4*)g)[lane + 64 * j];
    const int nblk = T_ / 16;
    f32x4 vn[2][4]; u32x2 an[2][4], bn_[4];
    { const int blk0 = F.vcu; if (blk0 < nblk) { load_row(vn[0], an[0], bn_, x, d1, nullptr, (size_t)blk0 * 16 + 2 * w, lane); load_row(vn[1], an[1], bn_, x, d1, nullptr, (size_t)blk0 * 16 + 2 * w + 1, lane); } }
    for (int blk = F.vcu; blk < nblk; blk += F.G) {
#pragma unroll
        for (int rr = 0; rr < 2; ++rr) {
            const int rl = 2 * w + rr; const size_t m = (size_t)blk * 16 + rl;
            f32x4 v[4]; float s = 0.f;
#pragma unroll
            for (int j = 0; j < 4; ++j) { v[j] = add_bf4(vn[rr][j], an[rr][j]); s += (v[j].x * v[j].x + v[j].y * v[j].y) + (v[j].z * v[j].z + v[j].w * v[j].w); }
            const float r = 1.0f / sqrtf(wave_sum(s) * (1.0f / D_) + 1e-6f);
            u32x2* o8 = (u32x2*)(out + m * D_) + lane;
#pragma unroll
            for (int j = 0; j < 4; ++j) { v[j] = v[j] * r * gv[j];
                const unsigned h0 = f2bf(v[j].x), h1 = f2bf(v[j].y), h2 = f2bf(v[j].z), h3 = f2bf(v[j].w);
                u32x2 hw; hw.x = h0 | (h1 << 16); hw.y = h2 | (h3 << 16); o8[64 * j] = hw;
                u32x2 lw; lw.x = pk2(v[j].x - bf2f((unsigned short)h0), v[j].y - bf2f((unsigned short)h1)); lw.y = pk2(v[j].z - bf2f((unsigned short)h2), v[j].w - bf2f((unsigned short)h3));
                *(LAS u32x2*)(yh + rl * YLD + 4 * lane + 256 * j) = hw; *(LAS u32x2*)(yl + rl * YLD + 4 * lane + 256 * j) = lw; }
        }
        { const int nb = blk + F.G; if (nb < nblk) { load_row(vn[0], an[0], bn_, x, d1, nullptr, (size_t)nb * 16 + 2 * w, lane); load_row(vn[1], an[1], bn_, x, d1, nullptr, (size_t)nb * 16 + 2 * w + 1, lane); } }
        __syncthreads();
        f32x4 acc0 = (f32x4){0.f, 0.f, 0.f, 0.f}, acc1 = acc0;
#pragma unroll
        for (int ks = 0; ks < 4; ++ks) {
            const int ko = (lane & 15) * YLD + 128 * w + 32 * ks + 8 * (lane >> 4);
            const bf16x8 ah = *(const LAS bf16x8*)(yh + ko), al = *(const LAS bf16x8*)(yl + ko);
            acc0 = __builtin_amdgcn_mfma_f32_16x16x32_bf16(ah, bh[0][ks], acc0, 0, 0, 0); acc0 = __builtin_amdgcn_mfma_f32_16x16x32_bf16(ah, bl[0][ks], acc0, 0, 0, 0); acc0 = __builtin_amdgcn_mfma_f32_16x16x32_bf16(al, bh[0][ks], acc0, 0, 0, 0);
            acc1 = __builtin_amdgcn_mfma_f32_16x16x32_bf16(ah, bh[1][ks], acc1, 0, 0, 0); acc1 = __builtin_amdgcn_mfma_f32_16x16x32_bf16(ah, bl[1][ks], acc1, 0, 0, 0); acc1 = __builtin_amdgcn_mfma_f32_16x16x32_bf16(al, bh[1][ks], acc1, 0, 0, 0);
        }
#pragma unroll
        for (int i = 0; i < 4; ++i) { part[w * 512 + (4 * (lane >> 4) + i) * 32 + (lane & 15)] = acc0[i]; part[w * 512 + (4 * (lane >> 4) + i) * 32 + 16 + (lane & 15)] = acc1[i]; }
        __syncthreads();
        { const int t = F.tid; float sacc = 0.f;
#pragma unroll
            for (int q = 0; q < 8; ++q) sacc += part[q * 512 + t];
            const int c = t & 31; lgt[t] = sacc + ((c < 4) ? bg[c & 3] : ((c < 20) ? be[(c - 4) & 15] : 0.f)); }
        __syncthreads();
        if (F.tid < 16) {
            const int rl = F.tid; const size_t m = (size_t)blk * 16 + rl;
            const f32x4 lgg = *(const LAS f32x4*)(lgt + rl * 32), le0 = *(const LAS f32x4*)(lgt + rl * 32 + 4), le1 = *(const LAS f32x4*)(lgt + rl * 32 + 8), le2 = *(const LAS f32x4*)(lgt + rl * 32 + 12), le3 = *(const LAS f32x4*)(lgt + rl * 32 + 16);
            int gi = 0; float mg = lgg[0];
#pragma unroll
            for (int c = 1; c < 4; ++c) if (lgg[c] > mg) { mg = lgg[c]; gi = c; }
            float sg = 0.f;
#pragma unroll
            for (int c = 0; c < 4; ++c) sg += expf(lgg[c] - mg);
            const float gp = 1.0f / sg;
            const f32x4 l4 = (gi == 0) ? le0 : ((gi == 1) ? le1 : ((gi == 2) ? le2 : le3));
            int a1 = 0; float va = l4[0];
#pragma unroll
            for (int c = 1; c < 4; ++c) if (l4[c] > va) { va = l4[c]; a1 = c; }
            int b1 = -1; float vb = 0.f;
#pragma unroll
            for (int c = 0; c < 4; ++c) if (c != a1 && (b1 < 0 || l4[c] > vb)) { vb = l4[c]; b1 = c; }
            const float eb = expf(vb - va), w_hi = gp / (1.0f + eb), w_lo = gp * eb / (1.0f + eb);
            const int ea = a1 < b1 ? a1 : b1, ebx = a1 < b1 ? b1 : a1;
            const int pidx = (ea == 0) ? (ebx - 1) : (ea == 1 ? ebx + 1 : 5);
            const float wa = (a1 < b1) ? w_hi : w_lo, wb = (a1 < b1) ? w_lo : w_hi;
            const int bucket = gi * 6 + pidx;
            const unsigned pos = __hip_atomic_fetch_add(cnt + bucket * 64, 1u, RLX_AGENT);
            list[(size_t)bucket * T_ + pos] = (int)m; tokw[m * 2] = wa; tokw[m * 2 + 1] = wb;
        }
    }
    __syncthreads();
}
__device__ __forceinline__ float logsig(float x) { return fminf(x, 0.f) - log1pf(expf(-fabsf(x))); }
__device__ __forceinline__ void knorm_max(Frame& F, const bf16_t* P, int b, int col, gu32* dst) {
    float mx = 0.f;
#pragma unroll 2
    for (int r = F.tid; r < S_; r += 512) { const bf16_t* kp = P + (size_t)(b * S_ + r) * PP + col; float ss = 0.f;
#pragma unroll
        for (int c = 0; c < 8; ++c) { const u32x4 v = *(const u32x4*)(kp + c * 8);
            const float a0 = __builtin_bit_cast(float, v.x << 16), a1 = __builtin_bit_cast(float, v.x & 0xffff0000u), a2 = __builtin_bit_cast(float, v.y << 16), a3 = __builtin_bit_cast(float, v.y & 0xffff0000u);
            const float a4 = __builtin_bit_cast(float, v.z << 16), a5 = __builtin_bit_cast(float, v.z & 0xffff0000u), a6 = __builtin_bit_cast(float, v.w << 16), a7 = __builtin_bit_cast(float, v.w & 0xffff0000u);
            ss += (a0 * a0 + a1 * a1) + (a2 * a2 + a3 * a3) + (a4 * a4 + a5 * a5) + (a6 * a6 + a7 * a7); }
        mx = fmaxf(mx, ss); }
#pragma unroll
    for (int o = 1; o < 64; o <<= 1) mx = fmaxf(mx, __shfl_xor(mx, o));
    if (F.lane == 0) __hip_atomic_fetch_max(dst, __float_as_uint(sqrtf(mx)), RLX_AGENT);
}
__device__ __forceinline__ void fox_cumsum_unit(Frame& F, const bf16_t* P, float* FB, int b, int h) {
    LAS float* tot = (LAS float*)F.lds;
    float v[8]; float run = 0.f;
#pragma unroll
    for (int i = 0; i < 8; ++i) { const int t = F.tid * 8 + i; run += logsig(bf2f(P[(size_t)(b * S_ + t) * PP + PC_FF + h])); v[i] = run; }
    float sc = run;
#pragma unroll
    for (int o = 1; o < 64; o <<= 1) { const float u = __shfl_up(sc, o); if (F.lane >= o) sc += u; }
    if (F.lane == 63) tot[F.wave] = sc;
    __syncthreads();
    float base = sc - run;
    for (int w = 0; w < F.wave; ++w) base += tot[w];
#pragma unroll
    for (int i = 0; i < 8; ++i) FB[(size_t)(b * 6 + h) * S_ + F.tid * 8 + i] = -(base + v[i]) * LOG2E;
    __syncthreads();
}
__device__ __forceinline__ void kmean_unit(Frame& F, const bf16_t* P, float* KMEAN, int b, int h) {
    for (int blk = F.wave * 2; blk < F.wave * 2 + 2; ++blk) {
        const int rg = F.lane >> 3, ch = F.lane & 7; float s8[8];
#pragma unroll
        for (int k = 0; k < 8; ++k) s8[k] = 0.f;
#pragma unroll 16
        for (int i = 0; i < 32; ++i) { const u32x4 v = *(const u32x4*)(P + (size_t)(b * S_ + blk * 256 + i * 8 + rg) * PP + PC_MK + h * 64 + ch * 8);
            s8[0] += __builtin_bit_cast(float, v.x << 16); s8[1] += __builtin_bit_cast(float, v.x & 0xffff0000u); s8[2] += __builtin_bit_cast(float, v.y << 16); s8[3] += __builtin_bit_cast(float, v.y & 0xffff0000u);
            s8[4] += __builtin_bit_cast(float, v.z << 16); s8[5] += __builtin_bit_cast(float, v.z & 0xffff0000u); s8[6] += __builtin_bit_cast(float, v.w << 16); s8[7] += __builtin_bit_cast(float, v.w & 0xffff0000u); }
#pragma unroll
        for (int k = 0; k < 8; ++k) { s8[k] += __shfl_xor(s8[k], 8); s8[k] += __shfl_xor(s8[k], 16); s8[k] += __shfl_xor(s8[k], 32); }
        if (rg == 0) { float* kp = KMEAN + ((size_t)(b * 6 + h) * 16 + blk) * 64 + ch * 8;
            *(f32x4*)kp = (f32x4){s8[0], s8[1], s8[2], s8[3]} * (1.0f / 256.0f); *(f32x4*)(kp + 4) = (f32x4){s8[4], s8[5], s8[6], s8[7]} * (1.0f / 256.0f); }
    }
}
__device__ __forceinline__ void cmp_unit(Frame& F, const bf16_t* P, const bf16_t* WC1, const float* BC1P, const float* B1, const float* W2, bf16_t* KCMP, int b, int which, int ntile) {
    const int lane = F.lane, r32 = lane & 31, hi = lane >> 5, wid = F.wave;
    const int n = ntile * 32 + r32, nn = n < 254 ? n : 254;
    const bf16_t* Arow = P + (size_t)(b * S_ + 16 * nn) * PP + (which ? PC_VC : PC_KC) + hi * 8;
    const bf16_t* Brow = WC1 + (size_t)(wid * 32 + r32) * 2048 + hi * 8;
    f32x16 acc = f32x16{};
#pragma unroll 16
    for (int kk = 0; kk < 128; ++kk) {
        const bf16x8 a = *(const bf16x8*)(Arow + (size_t)(kk >> 2) * PP + (kk & 3) * 16);
        const bf16x8 bb = *(const bf16x8*)(Brow + kk * 16);
        acc = __builtin_amdgcn_mfma_f32_32x32x16_bf16(a, bb, acc, 0, 0, 0);
    }
    LAS float* hs = (LAS float*)F.lds;
    LAS float* w2s = (LAS float*)(F.lds + 40960);
    for (int i = F.tid; i < 256 * 16; i += 512) ((LAS f32x4*)w2s)[i] = ((const f32x4*)W2)[i];
    float bias = B1[wid * 32 + r32];
#pragma unroll 16
    for (int kc = 0; kc < 64; ++kc) bias += BC1P[kc * 256 + wid * 32 + r32];
#pragma unroll
    for (int r = 0; r < 16; ++r) { const float a = acc[r] + bias; const float z = 0.7978845608028654f * (a + 0.044715f * a * a * a);
        hs[att::crow(r, hi) * 260 + wid * 32 + r32] = a * fast_sigmoid(2.0f * z); }
    __syncthreads();
    const int nl = F.tid >> 4, d4 = (F.tid & 15) * 4;
    f32x4 o = (f32x4){0.f, 0.f, 0.f, 0.f};
#pragma unroll 16
    for (int hd = 0; hd < 256; ++hd) { const f32x4 w = *(const LAS f32x4*)(w2s + hd * 64 + d4); o += hs[nl * 260 + hd] * w; }
    const int no = ntile * 32 + nl;
    u32x2 w2; w2.x = (no < 255) ? pk2(o[0], o[1]) : 0u; w2.y = (no < 255) ? pk2(o[2], o[3]) : 0u;
    *(u32x2*)(KCMP + ((size_t)(b * 2 + which) * 256 + no) * 64 + d4) = w2;
    __syncthreads();
}

struct Args { const float* in[21]; float* out; unsigned char* ws; int ph_lo, ph_hi; };
constexpr int NPH = 19;


__device__ __forceinline__ LAS unsigned char* opaque_lds(LAS unsigned char* p) { unsigned v = (unsigned)(uintptr_t)p; asm volatile("" : "+s"(v)); return (LAS unsigned char*)(uintptr_t)v; }
#ifndef PROBE_DUP
#define PROBE_DUP -1
#endif
#define NREP(k) ((PROBE_DUP == (k)) ? 2 : 1)
#define IN(k) (lo <= (k) && (k) < hi)
#define SEAM(k) do { if (IN(k) && IN((k) + 1)) { XcdBarrier bar_; bar_.bar = (unsigned*)((gu32*)(args.ws + WS_CTL) + CW_BAR); bar_.x = xb_xcc_id(); bar_.st = (volatile LAS unsigned*)((LAS unsigned char*)lds + MISC_OFF) + 8; xcd_barrier(bar_); } } while (0)
#define PHASE_ENTRY() const int t_ = opaque_tid(); F.tid = t_; F.lane = t_ & 63; F.wave = __builtin_amdgcn_readfirstlane(t_ >> 6); F.lds = opaque_lds((LAS unsigned char*)lds); \
    unsigned zofs_; asm volatile("s_mov_b32 %0, 0" : "=s"(zofs_)); \
    unsigned char* ws = args.ws + zofs_; F.ws = ws; F.ctl = (gu32*)(ws + WS_CTL); \
    bf16_t* H = (bf16_t*)(ws + WS_H); bf16_t* P = (bf16_t*)(ws + WS_P); bf16_t* O = (bf16_t*)(ws + WS_O); (void)H; (void)P; (void)O
template <int l>
__device__ __forceinline__ void layer_body(Frame& F, const Args& args, const int lo, const int hi) {
    extern __shared__ __attribute__((aligned(16))) unsigned char lds[];
    const float* const* in = args.in; float* X = args.out;
    const int p0 = l * 9;
        const float* xin = (l == 0) ? in[0] : X;
        if (IN(p0 + 0)) {
            PHASE_ENTRY();
            for (int rep = 0; rep < NREP(0); ++rep) {
            if (l == 0) { convert_weights(F, in); }
            norm_rows(F, (l == 0) ? in[0] : in[0], (l == 0) ? nullptr : (const bf16_t*)(ws + WS_D1), (l == 0) ? nullptr : (const bf16_t*)(ws + WS_D2), (l == 0) ? nullptr : X, in[1] + l * D_, H);
            }
        }
        SEAM(p0 + 0);
        if (IN(p0 + 1)) {
            PHASE_ENTRY();
            for (int rep = 0; rep < NREP(1); ++rep) {
            PolInProj pol; pol.A = (const char*)H; pol.B = (const char*)(ws + WS_WIN) + (size_t)l * NWIN * D_ * 2; pol.lda2 = 2048; pol.ldb2 = 2048; pol.kA = 128; pol.nt = 16;
            pol.ord.init(T_, PP, F.G, (int)blockIdx.x); pol.P = P; pol.bias = (const float*)(ws + WS_BIAS) + l * NWIN;
            pg8::gemm_stream(F.lds, pol);
            }
        }
        SEAM(p0 + 1);
        if (IN(p0 + 2)) {
            PHASE_ENTRY();
            for (int rep = 0; rep < NREP(2); ++rep) {
            for (int u = F.vcu; u < 224; u += F.G) {
                if (u < 128) { const int b = u >> 4, which = (u >> 3) & 1, nt = u & 7;
                    cmp_unit(F, P, (const bf16_t*)(ws + WS_WC1) + ((size_t)l * 2 + which) * 256 * 2048, (const float*)(ws + WS_BC1P) + (size_t)(l * 2 + which) * 64 * 256, in[7] + (l * 2 + which) * 256,
                             in[8] + ((size_t)l * 2 + which) * 256 * 64, (bf16_t*)(ws + WS_KCMP), b, which, nt); }
                else if (u < 176) { const int k = u - 128; fox_cumsum_unit(F, P, (float*)(ws + WS_FB), k / 6, k % 6); knorm_max(F, P, k / 6, PC_FK + (k % 6) * 64, F.ctl + CW_KN + l * 128 + k); }
                else { const int k = u - 176; kmean_unit(F, P, (float*)(ws + WS_KMEAN), k / 6, k % 6); knorm_max(F, P, k / 6, PC_MK + (k % 6) * 64, F.ctl + CW_KN + l * 128 + 48 + k); }
            }
            }
        }
        SEAM(p0 + 2);
        if (IN(p0 + 3)) {
            PHASE_ENTRY();
            for (int rep = 0; rep < NREP(3); ++rep) {
            LAS char* shm = (LAS char*)F.lds;
            for (;;) {
                if (F.tid == 0) F.MISC[0] = __hip_atomic_fetch_add(F.ctl + CW_Q + (l * 2 + rep) * 64, 1u, RLX_AGENT);
                __syncthreads();
                const int u = (int)F.MISC[0];
                __syncthreads();
                if (u >= 2048) break;
                const int s = 15 - (u >> 7), k = u & 127;
#ifdef PROBE_ATT_MASK
                if (rep == 1 && !((PROBE_ATT_MASK >> (k < 48 ? 0 : (k < 96 ? 1 : 2))) & 1)) continue;
#endif
                if (k < 48) att::fox_unit(shm, P, (const float*)(ws + WS_FB), O, k / 6, k % 6, s, __uint_as_float(__hip_atomic_load(F.ctl + CW_KN + l * 128 + k, RLX_AGENT)));
                else if (k < 96) att::moba_unit(shm, P, (const float*)(ws + WS_KMEAN), O, (k - 48) / 6, (k - 48) % 6, s, __uint_as_float(__hip_atomic_load(F.ctl + CW_KN + l * 128 + k, RLX_AGENT)));
                else { const int j = k - 96; att::nsa_unit(shm, P, (const bf16_t*)(ws + WS_KCMP), O, j >> 2, 4 * s + (j & 3)); }
            }
            }
        }
        SEAM(p0 + 3);
        if (IN(p0 + 4)) {
            PHASE_ENTRY();
            for (int rep = 0; rep < NREP(4); ++rep) {
            PolMerge pol; pol.O = (const char*)O; pol.H = (const char*)H; pol.WBR = (const char*)(ws + WS_WBR) + (size_t)l * D_ * D_ * 2;
            pol.WG = (const char*)(ws + WS_WIN) + ((size_t)l * NWIN + 3072) * D_ * 2; pol.lda2 = 2048; pol.ldb2 = 2048; pol.kA = 128; pol.vcu = F.vcu; pol.G = F.G;
            pol.merged = (bf16_t*)(ws + WS_MERGED); pol.biasg = (const float*)(ws + WS_BIAS) + l * NWIN + 3072;
            pol.ys = (char*)(ws + WS_YSCR) + (size_t)blockIdx.x * 131072; pol.ps = (char*)(ws + WS_PSCR) + (size_t)blockIdx.x * 131072;
            pg8::gemm_stream(F.lds, pol);
            }
        }
        SEAM(p0 + 4);
        if (IN(p0 + 5)) {
            PHASE_ENTRY();
            for (int rep = 0; rep < NREP(5); ++rep) {
            PolOutProj pol; pol.A = (const char*)(ws + WS_MERGED); pol.B = (const char*)(ws + WS_WOUT) + (size_t)l * D_ * D_ * 2; pol.lda2 = 2048; pol.ldb2 = 2048; pol.kA = 128; pol.nt = 16;
            pol.ord.init(T_, D_, F.G, (int)blockIdx.x); pol.d1 = (bf16_t*)(ws + WS_D1);
            pg8::gemm_stream(F.lds, pol);
            }
        }
        SEAM(p0 + 5);
        if (IN(p0 + 6)) {
            PHASE_ENTRY();
            for (int rep = 0; rep < NREP(6); ++rep) {
            norm2_route(F, xin, (const bf16_t*)(ws + WS_D1), in[2] + l * D_, H, (const bf16_t*)(ws + WS_WRT) + (size_t)l * 2 * 32 * 1024, in[15] + l * 4, in[17] + l * 16, (unsigned*)(F.ctl + CW_CNT + (l + 2 * rep) * 24 * 64), (int*)(ws + WS_LIST + rep * 8 * MiB), (float*)(ws + WS_TOKW + rep * 20 * MiB));
            }
        }
        SEAM(p0 + 6);
        if (IN(p0 + 7)) {
            PHASE_ENTRY();
            for (int rep = 0; rep < NREP(7); ++rep) {
            if (F.tid < 24) F.MISC[32 + F.tid] = __hip_atomic_load(F.ctl + CW_CNT + (l * 24 + F.tid) * 64, RLX_AGENT);
            __syncthreads();
            PolMoeUp pol; pol.H = (const char*)H; pol.WGU = (const char*)(ws + WS_WGU) + (size_t)l * 16 * 512 * D_ * 2; pol.lda2 = 2048; pol.ldb2 = 2048; pol.kA = 128; pol.c = (int)blockIdx.x; pol.G = F.G;
            pol.cnt = (const LAS unsigned*)(F.lds + MISC_OFF) + 32; pol.list = (const int*)(ws + WS_LIST); pol.tokw = (const float*)(ws + WS_TOKW); pol.hid = (bf16_t*)(ws + WS_HID);
            pg8::gemm_stream(F.lds, pol);
            }
        }
        SEAM(p0 + 7);
        if (IN(p0 + 8)) {
            PHASE_ENTRY();
            for (int rep = 0; rep < NREP(8); ++rep) {
            if (F.tid < 24) F.MISC[32 + F.tid] = __hip_atomic_load(F.ctl + CW_CNT + (l * 24 + F.tid) * 64, RLX_AGENT);
            __syncthreads();
            PolMoeDown pol; pol.HID = (const char*)(ws + WS_HID); pol.WD = (const char*)(ws + WS_WD) + (size_t)l * 16 * D_ * 256 * 2; pol.lda2 = 1024; pol.ldb2 = 512; pol.kA = 128; pol.c = (int)blockIdx.x; pol.G = F.G;
            pol.cnt = (const LAS unsigned*)(F.lds + MISC_OFF) + 32; pol.list = (const int*)(ws + WS_LIST); pol.d2 = (bf16_t*)(ws + WS_D2);
            pg8::gemm_stream(F.lds, pol);
            }
        }
        SEAM(p0 + 8);
    }
__global__ void __launch_bounds__(512, 2) mega(Args args) {
    extern __shared__ __attribute__((aligned(16))) unsigned char lds[];
    Frame F;
    F.lds = (LAS unsigned char*)lds; F.MISC = (volatile LAS unsigned*)(F.lds + MISC_OFF);
    F.tid = threadIdx.x; F.lane = F.tid & 63; F.wave = __builtin_amdgcn_readfirstlane(F.tid >> 6);
    F.G = gridDim.x; { const int bx = blockIdx.x; F.vcu = (F.G % 8 == 0) ? (bx % 8) * (F.G / 8) + bx / 8 : bx; }
    F.ws = args.ws; F.ctl = (gu32*)(args.ws + WS_CTL);
    for (int u = F.tid; u < (LDS_BYTES - MISC_OFF) / 4; u += 512) ((LAS unsigned*)(F.lds + MISC_OFF))[u] = 0u;
    __syncthreads();
    const int lo = args.ph_lo, hi = args.ph_hi;
    if (hi - lo > 1) (void)xcd_barrier_post((unsigned*)(F.ctl + CW_BAR), F.MISC + 8);
    const float* const* in = args.in;
    float* X = args.out;
    layer_body<0>(F, args, lo, hi);
    layer_body<1>(F, args, lo, hi);
    if (IN(18)) { PHASE_ENTRY(); final_norm(F, X, (const bf16_t*)(ws + WS_D1), (const bf16_t*)(ws + WS_D2), X, in[3]); }
#undef IN
#undef SEAM
}

#ifndef MK_PER_PHASE
#define MK_PER_PHASE 0
#endif
extern "C" void kernel_launch(void* const* d_in, const int* in_sizes, int n_in, void* d_out, int out_size, void* d_ws, size_t ws_size, hipStream_t stream) {
    static int grid = 0;
    if (grid == 0) {
        if (n_in != 21 || out_size != T_ * D_ || ws_size < WS_END) { fprintf(stderr, "kernel_launch: unexpected shapes (n_in %d out %d ws %zu)\n", n_in, out_size, ws_size); grid = -1; return; }
        int dev = 0, cus = 0;
        if (hipGetDevice(&dev) != hipSuccess || hipDeviceGetAttribute(&cus, hipDeviceAttributeMultiprocessorCount, dev) != hipSuccess) { grid = -1; return; }
        if (hipFuncSetAttribute((const void*)mega, hipFuncAttributeMaxDynamicSharedMemorySize, LDS_BYTES) != hipSuccess) { fprintf(stderr, "kernel_launch: hipFuncSetAttribute failed\n"); grid = -1; return; }
        int per_cu = 0;
        if (hipOccupancyMaxActiveBlocksPerMultiprocessor(&per_cu, (const void*)mega, 512, LDS_BYTES) != hipSuccess || per_cu < 1) fprintf(stderr, "kernel_launch: occupancy query says %d\n", per_cu);
        (void)hipGetLastError();
        grid = cus;
    }
    if (grid < 0) return;
    (void)hipMemsetAsync((char*)d_ws + WS_CTL, 0, CTL_ZERO_BYTES, stream);
    Args a{};
    for (int i = 0; i < 21; ++i) a.in[i] = (const float*)d_in[i];
    a.out = (float*)d_out; a.ws = (unsigned char*)d_ws;
#if MK_PER_PHASE
    for (int p = 0; p < NPH; ++p) { a.ph_lo = p; a.ph_hi = p + 1; hipLaunchKernelGGL(mega, dim3(grid), dim3(512), LDS_BYTES, stream, a); }
#else
    a.ph_lo = 0; a.ph_hi = NPH;
    hipLaunchKernelGGL(mega, dim3(grid), dim3(512), LDS_BYTES, stream, a);
#endif
}
```

```cpp
#include <hip/hip_runtime.h>
#include <stdint.h>
#include <math.h>
#include <stdio.h>

#define LAS __attribute__((address_space(3)))
#define GAS __attribute__((address_space(1)))
typedef unsigned short bf16_t;
typedef short bf16x8 __attribute__((ext_vector_type(8)));
typedef short s16x4 __attribute__((ext_vector_type(4)));
typedef float f32x2 __attribute__((ext_vector_type(2)));
typedef float f32x4 __attribute__((ext_vector_type(4)));
typedef float f32x16 __attribute__((ext_vector_type(16)));
typedef unsigned u32x2 __attribute__((ext_vector_type(2)));
typedef unsigned u32x4 __attribute__((ext_vector_type(4)));
typedef GAS unsigned gu32;

constexpr int NB = 8, S_ = 4096, T_ = NB * S_, D_ = 1024, PP = 3072, INC = 6034, NWIN = 6144;
constexpr int PC_FQ = 0, PC_FK = 384, PC_FV = 768, PC_NQ = 1152, PC_KC = 1408, PC_VC = 1472, PC_KS = 1536, PC_VS = 1600, PC_KW = 1664, PC_VW = 1728,
              PC_MQ = 1792, PC_MK = 2176, PC_MV = 2560, PC_FF = 2944, PC_NG = 2950;
constexpr float LOG2E = 1.4426950408889634f;
constexpr float C2 = 0.125f * LOG2E;
constexpr float THR = 6.0f;

constexpr size_t MiB = 1u << 20;
constexpr size_t WS_CTL = 0, CTL_ZERO_BYTES = 1 * MiB;
constexpr size_t WS_WIN = 2 * MiB;
constexpr size_t WS_WBR = 26 * MiB;
constexpr size_t WS_WOUT = 30 * MiB;
constexpr size_t WS_WGU = 34 * MiB;
constexpr size_t WS_WD = 66 * MiB;
constexpr size_t WS_WC1 = 82 * MiB;
constexpr size_t WS_BIAS = 86 * MiB;
constexpr size_t WS_WRT = 87 * MiB + 512 * 1024;
constexpr size_t WS_BC1P = 87 * MiB;
constexpr size_t WS_H = 88 * MiB;
constexpr size_t WS_P = 152 * MiB;
constexpr size_t WS_O = 344 * MiB;
constexpr size_t WS_FB = 408 * MiB;
constexpr size_t WS_KCMP = 409 * MiB;
constexpr size_t WS_KMEAN = 410 * MiB;
constexpr size_t WS_TOKW = 411 * MiB;
constexpr size_t WS_LIST = 412 * MiB;
constexpr size_t WS_MERGED = WS_P;
constexpr size_t WS_YSCR = WS_P + 64 * MiB;
constexpr size_t WS_PSCR = WS_P + 96 * MiB;
constexpr size_t WS_HID = WS_P + 160 * MiB;
constexpr size_t WS_D1 = WS_P + 64 * MiB;
constexpr size_t WS_D2 = WS_P;
constexpr size_t WS_END = 416 * MiB;
constexpr size_t WS_H8 = 416 * MiB;
constexpr size_t WS_WG8 = 480 * MiB;
constexpr size_t WS_END2 = 492 * MiB;
constexpr int CW_TMO = 0, CW_BAR = 4096, CW_Q = 8192, CW_CNT = 8448, CW_KN = 16384;

constexpr int LDS_BYTES = 147456;
constexpr int MISC_OFF = 146944;
constexpr int SLOTB = 8192, NSLOT = 4, L_K = 0, L_V = NSLOT * SLOTB, L_WSF = 2 * NSLOT * SLOTB, L_OST = 0  , L_AUX = L_WSF + 4096;
constexpr int L_IMP = L_AUX, IMP_LD = 260, L_SELM = L_IMP + 64 * IMP_LD * 4, L_UNION = L_SELM + 1024, L_VOTE = L_UNION + 64;
static_assert(L_VOTE + 256 <= MISC_OFF, "lds");

#define RLX_AGENT __ATOMIC_RELAXED, __HIP_MEMORY_SCOPE_AGENT
__device__ __forceinline__ unsigned f2bf(float f) { unsigned u = __builtin_bit_cast(unsigned, f); return (u + 0x7fffu + ((u >> 16) & 1u)) >> 16; }
__device__ __forceinline__ unsigned pk2(float lo, float hi) { return f2bf(lo) | (f2bf(hi) << 16); }
__device__ __forceinline__ float bf2f(unsigned short v) { return __builtin_bit_cast(float, (unsigned)v << 16); }
__device__ __forceinline__ unsigned cvt_pk_bf16(float lo, float hi) { unsigned r; asm volatile("v_cvt_pk_bf16_f32 %0, %1, %2" : "=v"(r) : "v"(lo), "v"(hi)); return r; }
__device__ __forceinline__ unsigned hw_slot() { return (unsigned)__builtin_amdgcn_s_getreg((5 << 11) | (0 << 6) | 4) & 63u; }
__device__ __forceinline__ int opaque_tid() { extern __shared__ __attribute__((aligned(16))) unsigned char lds_ot[];
    const unsigned w = ((volatile LAS unsigned*)((LAS unsigned char*)lds_ot + MISC_OFF))[64 + hw_slot()];
    int t = (int)(w * 64u + __builtin_amdgcn_mbcnt_hi(~0u, __builtin_amdgcn_mbcnt_lo(~0u, 0u))); asm volatile("" : "+v"(t)); return t; }
__device__ __forceinline__ float fast_sigmoid(float x) { return __builtin_amdgcn_rcpf(1.0f + __builtin_amdgcn_exp2f(-x * LOG2E)); }

#define XB_TMO      128
#define XB_XCNT(j)  (256  + 64 * (j))
#define XB_XSUB(j)  (1280 + 64 * (j))
#define XB_XGEN(j)  (2304 + 64 * (j))
#define XB_TOP      3328
#define XB_TOPGEN   3392
#define XCD_BAR_WORDS 3456
#define XB_SPIN_CAP (1u << 20)
__device__ __forceinline__ unsigned xb_ld(unsigned* p)              { return __hip_atomic_load(p, __ATOMIC_RELAXED, __HIP_MEMORY_SCOPE_AGENT); }
__device__ __forceinline__ unsigned xb_add(unsigned* p, unsigned v) { return __hip_atomic_fetch_add(p, v, __ATOMIC_RELAXED, __HIP_MEMORY_SCOPE_AGENT); }
__device__ __forceinline__ unsigned xb_xcc_id() { return (unsigned)__builtin_amdgcn_s_getreg((3 << 11) | 20) & 0xFu; }
#define XB_SPIN(cond, bar) do { unsigned _sp = 0; while (cond) { __builtin_amdgcn_s_sleep(1); \
    if ((++_sp & 255u) == 0u) { if (xb_ld(&(bar)[XB_TMO])) break; if (_sp > XB_SPIN_CAP) { atomicAdd(&(bar)[XB_TMO], 1u); break; } } } } while (0)
struct XcdBarrier { unsigned* bar; unsigned x; volatile LAS unsigned* st; };
__device__ __forceinline__ XcdBarrier xcd_barrier_post(unsigned* bar, volatile LAS unsigned* st) {
    XcdBarrier b; b.bar = bar; b.x = xb_xcc_id(); b.st = st;
    if (threadIdx.x == 0) (void)xb_add(&bar[XB_XCNT(b.x)], 1u);
    return b;
}
__device__ __forceinline__ void xcd_barrier_complete(unsigned* bar, unsigned x, unsigned& nloc, unsigned& nx) {
    const unsigned G = gridDim.x * gridDim.y * gridDim.z;
    unsigned sum, cnt, mine, sp = 0u;
    for (;;) {
        sum = 0u; cnt = 0u; mine = 0u;
#pragma unroll
        for (unsigned j = 0; j < 16; ++j) { const unsigned c = xb_ld(&bar[XB_XCNT(j)]); sum += c; cnt += (c > 0u) ? 1u : 0u; mine = (j == x) ? c : mine; }
        if (sum == G) break;
        __builtin_amdgcn_s_sleep(1);
        if ((++sp & 255u) == 0u) { if (xb_ld(&bar[XB_TMO])) break; if (sp > XB_SPIN_CAP) { atomicAdd(&bar[XB_TMO], 1u); break; } }
    }
    nloc = mine > 0u ? mine : 1u; nx = cnt > 0u ? cnt : 1u;
}
__device__ __forceinline__ void xcd_barrier(const XcdBarrier& b) {
    asm volatile("s_waitcnt vmcnt(0)" ::: "memory");
    __syncthreads();
    if (opaque_tid() == 0) {
        unsigned* bar = b.bar;
        __builtin_amdgcn_s_waitcnt(0);
        unsigned nloc = b.st[0], nx = b.st[1];
        if (nloc == 0u) { xcd_barrier_complete(bar, b.x, nloc, nx); b.st[0] = nloc; b.st[1] = nx; }
        const unsigned old = xb_add(&bar[XB_XSUB(b.x)], 1u);
        const unsigned gen = old / nloc;
        if (old + 1u == (gen + 1u) * nloc) {
            __builtin_amdgcn_fence(__ATOMIC_RELEASE, "agent");
            asm volatile("s_waitcnt vmcnt(0)" ::: "memory");
            const unsigned og = xb_add(&bar[XB_TOP], 1u);
            const unsigned tg = og / nx;
            if (og + 1u == (tg + 1u) * nx) xb_add(&bar[XB_TOPGEN], 1u);
            else XB_SPIN(xb_ld(&bar[XB_TOPGEN]) == tg, bar);
            __builtin_amdgcn_fence(__ATOMIC_ACQUIRE, "agent");
            xb_add(&bar[XB_XGEN(b.x)], 1u);
            asm volatile("s_waitcnt vmcnt(0)" ::: "memory");
        } else {
            XB_SPIN(xb_ld(&bar[XB_XGEN(b.x)]) == gen, bar);
            __builtin_amdgcn_fence(__ATOMIC_ACQUIRE, "agent");
            asm volatile("s_waitcnt vmcnt(0)" ::: "memory");
        }
    }
    __syncthreads();
}

namespace pg8 {
constexpr int BM = 256, BK = 64, HALF = 128, HTB = HALF * BK * 2, STAGE_BYTES = 8 * HTB, NXCD = 8, WGM = 8;
__host__ __device__ __forceinline__ int lds_byte(int r, int c) { const int st = (r >> 4) * 2 + (c >> 5), rr = r & 15, cc = c & 31, ob = rr * 64 + cc * 2; return st * 1024 + (ob ^ (((ob >> 9) & 1) << 5)); }
__host__ __device__ __forceinline__ void stage_rc(int b, int& R, int& C) { const int st = b / 1024, sb = b % 1024, swz = sb ^ (((sb >> 9) & 1) << 5); R = (st >> 1) * 16 + swz / 64; C = (st & 1) * 32 + (swz % 64) / 2; }
__host__ __device__ __forceinline__ int perm32(int rho) { const int n = rho >> 4, i = rho & 15; return 8 * (i >> 2) + 4 * n + (i & 3); }

struct Seg { const char* A; const char* B; const char* B2; int nt, ntb, epi, pm, pn, aux, f8; };
typedef f32x4 Acc[2][2][4][2];
typedef int v8i __attribute__((ext_vector_type(8)));

struct TileOrder {
    int nM, nN, nwg, G, c;
    __device__ void init(int M, int N, int G_, int c_) { nM = M / BM; nN = N / BM; nwg = nM * nN; G = G_; c = c_; }
    __device__ bool tile(int i, int& pm, int& pn) const {
        const long L = (long)i * G + c; if (L >= nwg) return false;
        int wgid = (int)L; { const int q = nwg / NXCD, r = nwg % NXCD, xcd = wgid % NXCD, off = wgid / NXCD; wgid = (xcd < r ? xcd * (q + 1) : r * (q + 1) + (xcd - r) * q) + off; }
        const int nig = WGM * nN, gid = wgid / nig, fm = gid * WGM, gsz = (nM - fm) < WGM ? (nM - fm) : WGM;
        pm = fm + ((wgid % nig) % gsz); pn = (wgid % nig) / gsz; return true;
    }
};

template <class Pol>
__device__ __forceinline__ void gemm_stream(LAS unsigned char* lds, const Pol& S) {
    constexpr bool GA = Pol::GATHER; constexpr int F8M = Pol::FP8;
    const int tid = opaque_tid(), wid = __builtin_amdgcn_readfirstlane(tid >> 6), lane = tid & 63, wr = wid >> 2, wc = wid & 3, fr = lane & 15, fq = lane >> 4;
    int Rr[2]; unsigned voffA[2], voffB[2];
#pragma unroll
    for (int i = 0; i < 2; ++i) { int R, C; stage_rc(tid * 16 + i * 8192, R, C); Rr[i] = R; voffA[i] = GA ? (unsigned)(C * 2) : (unsigned)(R * S.lda2 + C * 2); const int Rb = (R & ~31) + perm32(R & 31); voffB[i] = (unsigned)(Rb * S.ldb2 + C * 2); }
    const unsigned hstepB = (unsigned)(HALF * S.ldb2), hstepA = (unsigned)(HALF * S.lda2);
    const size_t kA = (size_t)S.kA;
    const unsigned ldsw = (unsigned)wid * 1024u;
    const int aoff = lds_byte(wr * 64 + fr, fq * 8), boff = lds_byte(wc * 32 + fr, fq * 8);
    const int sw8 = (fr * 64 + (fq & 1) * 32) ^ ((fr >> 3) << 5);
    const int aoff8 = (wr * 8 + (fq >> 1)) * 1024 + sw8, boff8 = (wc * 4 + (fq >> 1)) * 1024 + sw8;
#define PG8_SA(b, h) (((b) * 2 + (h)) * HTB)
#define PG8_SB(b, h) ((4 + (b) * 2 + (h)) * HTB)
#define PG8_STAGE_A(bufoff, gbase, tsel, h) do { _Pragma("unroll") for (int _i = 0; _i < 2; ++_i) \
        __builtin_amdgcn_global_load_lds((const unsigned*)((gbase) + (GA ? (tab[(tsel) * 256 + (h) * HALF + Rr[_i]] + voffA[_i]) : ((h) * hstepA + voffA[_i]))), (LAS unsigned*)(lds + (bufoff) + ldsw + _i * 8192), 16, 0, 0); } while (0)
#define PG8_STAGE_B(bufoff, gbase, h) do { _Pragma("unroll") for (int _i = 0; _i < 2; ++_i) \
        __builtin_amdgcn_global_load_lds((const unsigned*)((gbase) + (h) * hstepB + voffB[_i]), (LAS unsigned*)(lds + (bufoff) + ldsw + _i * 8192), 16, 0, 0); } while (0)
#define PG8_LDA(dst, b, h) do { _Pragma("unroll") for (int m = 0; m < 4; ++m) _Pragma("unroll") for (int k = 0; k < 2; ++k) dst[m][k] = *(const LAS bf16x8*)(lds + PG8_SA(b, h) + aoff + m * 2048 + k * 1024); } while (0)
#define PG8_LDB(dst, b, h) do { _Pragma("unroll") for (int n = 0; n < 2; ++n) _Pragma("unroll") for (int k = 0; k < 2; ++k) dst[n][k] = *(const LAS bf16x8*)(lds + PG8_SB(b, h) + boff + n * 2048 + k * 1024); } while (0)
#define PG8_MMA(ai, bj, At, Bt) do { __builtin_amdgcn_s_setprio(1); _Pragma("unroll") for (int m = 0; m < 4; ++m) _Pragma("unroll") for (int n = 0; n < 2; ++n) _Pragma("unroll") for (int k = 0; k < 2; ++k) \
        acc[ai][bj][m][n] = __builtin_amdgcn_mfma_f32_16x16x32_bf16(Bt[n][k], At[m][k], acc[ai][bj][m][n], 0, 0, 0); __builtin_amdgcn_s_setprio(0); } while (0)
#define PG8_LDA8(dst, b, h) do { _Pragma("unroll") for (int m = 0; m < 4; ++m) { const u32x4 lo_ = *(const LAS u32x4*)(lds + PG8_SA(b, h) + aoff8 + m * 2048), hi_ = *(const LAS u32x4*)(lds + PG8_SA(b, h) + aoff8 + m * 2048 + 16); dst[m] = (v8i){(int)lo_.x, (int)lo_.y, (int)lo_.z, (int)lo_.w, (int)hi_.x, (int)hi_.y, (int)hi_.z, (int)hi_.w}; } } while (0)
#define PG8_LDB8(dst, b, h) do { _Pragma("unroll") for (int n = 0; n < 2; ++n) { const u32x4 lo_ = *(const LAS u32x4*)(lds + PG8_SB(b, h) + boff8 + n * 2048), hi_ = *(const LAS u32x4*)(lds + PG8_SB(b, h) + boff8 + n * 2048 + 16); dst[n] = (v8i){(int)lo_.x, (int)lo_.y, (int)lo_.z, (int)lo_.w, (int)hi_.x, (int)hi_.y, (int)hi_.z, (int)hi_.w}; } } while (0)
#define PG8_MMA8(ai, bj, At, Bt) do { __builtin_amdgcn_s_setprio(1); _Pragma("unroll") for (int m = 0; m < 4; ++m) _Pragma("unroll") for (int n = 0; n < 2; ++n) \
        asm volatile("v_mfma_scale_f32_16x16x128_f8f6f4 %0, %1, %2, %0, %3, %3 op_sel_hi:[0,0,0]" : "+v"(acc[ai][bj][m][n]) : "v"(Bt[n]), "v"(At[m]), "v"(sc8)); __builtin_amdgcn_s_setprio(0); } while (0)
#define PG8_WAIT_V(n) asm volatile("s_waitcnt vmcnt(" #n ")" ::: "memory")
#define PG8_WAIT_L(n) asm volatile("s_waitcnt lgkmcnt(" #n ")" ::: "memory")
#define PG8_BAR __builtin_amdgcn_s_barrier()
#define PG8_SCHED __builtin_amdgcn_sched_barrier(0)
#define PG8_ZERO_ACC() do { _Pragma("unroll") for (int a = 0; a < 2; ++a) _Pragma("unroll") for (int b = 0; b < 2; ++b) _Pragma("unroll") for (int m = 0; m < 4; ++m) _Pragma("unroll") for (int n = 0; n < 2; ++n) acc[a][b][m][n] = (f32x4){0.f, 0.f, 0.f, 0.f}; } while (0)
    Seg cur, nxt; int ui = 0;
    if (!S.next(0, cur)) return;
    const LAS unsigned* tab = (const LAS unsigned*)(lds + STAGE_BYTES);
    int par = 0;
    if (GA) { if (tid < 256) ((LAS unsigned*)(lds + STAGE_BYTES))[tid] = S.arow(cur, tid); asm volatile("s_waitcnt lgkmcnt(0)" ::: "memory"); PG8_BAR; }
    Acc acc; PG8_ZERO_ACC();
    bf16x8 At[4][2], B0[2][2], B1[2][2]; v8i Et[4], E0[2], E1[2]; const int sc8 = 0x7f7f7f7f;
    {
        const char* cA = cur.A + S.arow0(cur); const char* cB = cur.B;
        PG8_STAGE_B(PG8_SB(0, 0), cB, 0); PG8_STAGE_B(PG8_SB(0, 1), cB, 1); PG8_STAGE_A(PG8_SA(0, 0), cA, par, 0); PG8_STAGE_A(PG8_SA(0, 1), cA, par, 1);
        if (wr == 1) PG8_BAR;
        PG8_WAIT_V(2); PG8_BAR;
        PG8_STAGE_B(PG8_SB(1, 0), cB + 128, 0); PG8_STAGE_A(PG8_SA(1, 0), cA + kA, par, 0); PG8_STAGE_B(PG8_SB(1, 1), cB + 128, 1);
        PG8_WAIT_V(6); PG8_BAR;
    }
    for (;;) {
        const bool has_next = S.next(ui + 1, nxt);
        if (!has_next) nxt = cur;
        const char* cA = cur.A + S.arow0(cur); const char* cB = cur.B; const char* nA = nxt.A + S.arow0(nxt); const char* nB = nxt.B;
        const int nt = cur.nt;
        if (GA) { if (has_next && tid < 256) ((LAS unsigned*)(lds + STAGE_BYTES))[(par ^ 1) * 256 + tid] = S.arow(nxt, tid); }
        const bool use8 = (F8M == 2) && (cur.f8 != 0);
        if (!use8) {
        for (int t = 0; t < nt; t += 2) {
            const bool last = (t == nt - 2);
            const char* a1 = cA + (size_t)(t + 1) * kA;
            const char* a2 = last ? nA : cA + (size_t)(t + 2) * kA; const char* a3 = a2 + kA;
            const char* b2 = last ? nB : ((t + 2 < cur.ntb) ? cB + (size_t)(t + 2) * 128 : cur.B2 + (size_t)(t + 2 - cur.ntb) * 128);
            const char* b3 = last ? ((1 < nxt.ntb) ? nB + 128 : nxt.B2 + (size_t)(1 - nxt.ntb) * 128) : ((t + 3 < cur.ntb) ? cB + (size_t)(t + 3) * 128 : cur.B2 + (size_t)(t + 3 - cur.ntb) * 128);
            const int o2 = (last && has_next) ? (par ^ 1) : par;
            PG8_LDB(B0, 0, 0); PG8_LDB(B1, 0, 1); PG8_SCHED; PG8_LDA(At, 0, 0); PG8_STAGE_A(PG8_SA(1, 1), a1, par, 1);
            PG8_WAIT_V(8); PG8_WAIT_L(0); PG8_BAR; PG8_MMA(0, 0, At, B0); PG8_MMA(0, 1, At, B1); PG8_BAR; PG8_SCHED;
            PG8_LDA(At, 0, 1); PG8_STAGE_B(PG8_SB(0, 0), b2, 0); PG8_STAGE_B(PG8_SB(0, 1), b2, 1); PG8_STAGE_A(PG8_SA(0, 0), a2, o2, 0);
            PG8_WAIT_V(8); PG8_WAIT_L(0); PG8_BAR; PG8_MMA(1, 0, At, B0); PG8_MMA(1, 1, At, B1); PG8_BAR; PG8_SCHED;
            PG8_LDB(B0, 1, 0); PG8_LDB(B1, 1, 1); PG8_SCHED; PG8_LDA(At, 1, 0); PG8_STAGE_A(PG8_SA(0, 1), a2, o2, 1);
            PG8_WAIT_V(8); PG8_WAIT_L(0); PG8_BAR; PG8_MMA(0, 0, At, B0); PG8_MMA(0, 1, At, B1); PG8_BAR; PG8_SCHED;
            PG8_LDA(At, 1, 1); PG8_STAGE_B(PG8_SB(1, 0), b3, 0); PG8_STAGE_B(PG8_SB(1, 1), b3, 1); PG8_STAGE_A(PG8_SA(1, 0), a3, o2, 0);
            PG8_WAIT_V(8); PG8_WAIT_L(0); PG8_BAR; PG8_MMA(1, 0, At, B0); PG8_MMA(1, 1, At, B1); PG8_BAR; PG8_SCHED;
        }
        } else {
        for (int t = 0; t < nt; t += 2) {
            const bool last = (t == nt - 2);
            const char* a1 = cA + (size_t)(t + 1) * kA;
            const char* a2 = last ? nA : cA + (size_t)(t + 2) * kA; const char* a3 = a2 + kA;
            const char* b2 = last ? nB : ((t + 2 < cur.ntb) ? cB + (size_t)(t + 2) * 128 : cur.B2 + (size_t)(t + 2 - cur.ntb) * 128);
            const char* b3 = last ? ((1 < nxt.ntb) ? nB + 128 : nxt.B2 + (size_t)(1 - nxt.ntb) * 128) : ((t + 3 < cur.ntb) ? cB + (size_t)(t + 3) * 128 : cur.B2 + (size_t)(t + 3 - cur.ntb) * 128);
            const int o2 = (last && has_next) ? (par ^ 1) : par;
            PG8_LDB8(E0, 0, 0); PG8_LDB8(E1, 0, 1); PG8_SCHED; PG8_LDA8(Et, 0, 0); PG8_STAGE_A(PG8_SA(1, 1), a1, par, 1);
            PG8_WAIT_V(8); PG8_WAIT_L(0); PG8_BAR; PG8_MMA8(0, 0, Et, E0); PG8_MMA8(0, 1, Et, E1); PG8_BAR; PG8_SCHED;
            PG8_LDA8(Et, 0, 1); PG8_STAGE_B(PG8_SB(0, 0), b2, 0); PG8_STAGE_B(PG8_SB(0, 1), b2, 1); PG8_STAGE_A(PG8_SA(0, 0), a2, o2, 0);
            PG8_WAIT_V(8); PG8_WAIT_L(0); PG8_BAR; PG8_MMA8(1, 0, Et, E0); PG8_MMA8(1, 1, Et, E1); PG8_BAR; PG8_SCHED;
            PG8_LDB8(E0, 1, 0); PG8_LDB8(E1, 1, 1); PG8_SCHED; PG8_LDA8(Et, 1, 0); PG8_STAGE_A(PG8_SA(0, 1), a2, o2, 1);
            PG8_WAIT_V(8); PG8_WAIT_L(0); PG8_BAR; PG8_MMA8(0, 0, Et, E0); PG8_MMA8(0, 1, Et, E1); PG8_BAR; PG8_SCHED;
            PG8_LDA8(Et, 1, 1); PG8_STAGE_B(PG8_SB(1, 0), b3, 0); PG8_STAGE_B(PG8_SB(1, 1), b3, 1); PG8_STAGE_A(PG8_SA(1, 0), a3, o2, 0);
            PG8_WAIT_V(8); PG8_WAIT_L(0); PG8_BAR; PG8_MMA8(1, 0, Et, E0); PG8_MMA8(1, 1, Et, E1); PG8_BAR; PG8_SCHED;
        }
        }
        const int did_epi = cur.epi;
        if (did_epi) { if (wr == 0) PG8_BAR; S.epilogue(acc, cur, wr, wc, fr, fq); }
        if (!has_next) break;
        if (did_epi) PG8_ZERO_ACC();
        cur = nxt; ++ui;
        par ^= 1;
        if (did_epi) { if (wr == 1) PG8_BAR; }
    }
    PG8_WAIT_V(0);
    PG8_BAR;
#undef PG8_SA
#undef PG8_SB
#undef PG8_STAGE_A
#undef PG8_STAGE_B
#undef PG8_LDA
#undef PG8_LDA8
#undef PG8_LDB8
#undef PG8_MMA8
#undef PG8_LDB
#undef PG8_MMA
#undef PG8_WAIT_V
#undef PG8_WAIT_L
#undef PG8_BAR
#undef PG8_SCHED
#undef PG8_ZERO_ACC
}
}

using pg8::Seg; using pg8::Acc;
#define EPI_ROWCOL() const int row0 = wr * 64 + fr, col0 = wc * 32 + 8 * fq

struct PolInProj {
    static constexpr bool GATHER = false; static constexpr int FP8 = 0;
    const char* A; const char* B; int lda2, ldb2, kA, nt; pg8::TileOrder ord;
    bf16_t* P; const float* bias;
    __device__ __forceinline__ bool next(int i, Seg& s) const { int pm, pn; if (!ord.tile(i, pm, pn)) return false; s.A = A; s.B = B + (size_t)pn * 256 * ldb2; s.B2 = s.B; s.nt = nt; s.ntb = nt; s.epi = 1; s.pm = pm; s.pn = pn; s.aux = 0; s.f8 = 0; return true; }
    __device__ __forceinline__ unsigned arow(const Seg&, int) const { return 0u; }
    __device__ __forceinline__ size_t arow0(const Seg& s) const { return (size_t)s.pm * 256 * lda2; }
    __device__ __forceinline__ void epilogue(Acc& acc, const Seg& s, int wr, int wc, int fr, int fq) const {
        EPI_ROWCOL();
        f32x4 bv[2][2];
#pragma unroll
        for (int bj = 0; bj < 2; ++bj)
#pragma unroll
            for (int n = 0; n < 2; ++n) bv[bj][n] = *(const f32x4*)(bias + s.pn * 256 + col0 + bj * 128 + 4 * n);
#pragma unroll
        for (int ai = 0; ai < 2; ++ai)
#pragma unroll
            for (int m = 0; m < 4; ++m) {
                bf16_t* rowp = P + (size_t)(s.pm * 256 + row0 + ai * 128 + m * 16) * PP + s.pn * 256 + col0;
#pragma unroll
                for (int bj = 0; bj < 2; ++bj) { const f32x4 v0 = acc[ai][bj][m][0] + bv[bj][0], v1 = acc[ai][bj][m][1] + bv[bj][1];
                    u32x4 w; w.x = cvt_pk_bf16(v0[0], v0[1]); w.y = cvt_pk_bf16(v0[2], v0[3]); w.z = cvt_pk_bf16(v1[0], v1[1]); w.w = cvt_pk_bf16(v1[2], v1[3]);
                    *(u32x4*)(rowp + bj * 128) = w; }
            }
    }
};
struct PolOutProj {
    static constexpr bool GATHER = false; static constexpr int FP8 = 0;
    const char* A; const char* B; int lda2, ldb2, kA, nt; pg8::TileOrder ord;
    bf16_t* d1;
    __device__ __forceinline__ bool next(int i, Seg& s) const { int pm, pn; if (!ord.tile(i, pm, pn)) return false; s.A = A; s.B = B + (size_t)pn * 256 * ldb2; s.B2 = s.B; s.nt = nt; s.ntb = nt; s.epi = 1; s.pm = pm; s.pn = pn; s.aux = 0; s.f8 = 0; return true; }
    __device__ __forceinline__ unsigned arow(const Seg&, int) const { return 0u; }
    __device__ __forceinline__ size_t arow0(const Seg& s) const { return (size_t)s.pm * 256 * lda2; }
    __device__ __forceinline__ void epilogue(Acc& acc, const Seg& s, int wr, int wc, int fr, int fq) const {
        EPI_ROWCOL();
#pragma unroll
        for (int ai = 0; ai < 2; ++ai)
#pragma unroll
            for (int m = 0; m < 4; ++m) {
                bf16_t* rowp = d1 + (size_t)(s.pm * 256 + row0 + ai * 128 + m * 16) * D_ + s.pn * 256 + col0;
#pragma unroll
                for (int bj = 0; bj < 2; ++bj) { const f32x4 v0 = acc[ai][bj][m][0], v1 = acc[ai][bj][m][1];
                    u32x4 w; w.x = cvt_pk_bf16(v0[0], v0[1]); w.y = cvt_pk_bf16(v0[2], v0[3]); w.z = cvt_pk_bf16(v1[0], v1[1]); w.w = cvt_pk_bf16(v1[2], v1[3]);
                    *(u32x4*)(rowp + bj * 128) = w; }
            }
    }
};
struct PolMerge {
    static constexpr bool GATHER = false; static constexpr int FP8 = 2;
    const char* O; const char* H8; const char* WBR; const char* WG8;
    int lda2, ldb2, kA; int vcu, G;
    bf16_t* merged; const float* biasg; char* ys; char* ps; const char* zero;
    __device__ __forceinline__ bool next(int i, Seg& s) const {
        const int combo = vcu + G * (i / 6), j = i % 6; if (combo >= 512) return false;
        const int pm = combo >> 2, c = combo & 3, br = j >> 1;
        const int kofs = (br == 0) ? 0 : (br == 1 ? 384 : 640);
        if (!(j & 1)) { s.A = O + kofs * 2; s.B = WBR + (size_t)(c * 256) * 2048 + kofs * 2; s.nt = (br == 1) ? 4 : 6; s.f8 = 0; }
        else { s.A = H8; s.B = WG8 + (size_t)(br * 1024 + c * 256) * 2048; s.nt = 8; s.f8 = 1; }
        s.B2 = s.B; s.ntb = s.nt; s.epi = 1; s.pm = pm; s.pn = c; s.aux = j; return true;
    }
    __device__ __forceinline__ unsigned arow(const Seg&, int) const { return 0u; }
    __device__ __forceinline__ size_t arow0(const Seg& s) const { return (size_t)s.pm * 256 * 2048; }
    __device__ __forceinline__ void epilogue(Acc& acc, const Seg& s, int wr, int wc, int fr, int fq) const {
        EPI_ROWCOL(); const int j = s.aux, br = j >> 1; const unsigned tofs0 = (unsigned)((((wr << 2) | wc) << 6) | (fq << 4) | fr) * 16u;
        if (!(j & 1)) {
#pragma unroll
            for (int e = 0; e < 16; ++e) { const int ai = e >> 3, bj = (e >> 2) & 1, m = e & 3; const f32x4 v0 = acc[ai][bj][m][0], v1 = acc[ai][bj][m][1]; unsigned tofs = tofs0; asm volatile("" : "+v"(tofs));
                u32x4 w; w.x = cvt_pk_bf16(v0[0], v0[1]); w.y = cvt_pk_bf16(v0[2], v0[3]); w.z = cvt_pk_bf16(v1[0], v1[1]); w.w = cvt_pk_bf16(v1[2], v1[3]);
                *(u32x4*)((ys + e * 8192) + tofs) = w; }
            return;
        }
        constexpr int DEPTH = 4;
        f32x4 b0[2], b1[2];
#pragma unroll
        for (int bj = 0; bj < 2; ++bj) { b0[bj] = *(const f32x4*)(biasg + br * 1024 + s.pn * 256 + col0 + bj * 128); b1[bj] = *(const f32x4*)(biasg + br * 1024 + s.pn * 256 + col0 + bj * 128 + 4); }
        const char* pin = (br > 0) ? ps : zero;
        char* pout = (br < 2) ? ps : (char*)(merged + (size_t)s.pm * 256 * D_ + s.pn * 256);
        const unsigned mofs0 = (unsigned)(row0 * D_ + col0) * 2u;
        u32x4 yq[DEPTH], pq[DEPTH];
#pragma unroll
        for (int e = 0; e < DEPTH; ++e) { unsigned tofs = tofs0; asm volatile("" : "+v"(tofs)); yq[e] = *(const u32x4*)((ys + e * 8192) + tofs); pq[e] = *(const u32x4*)((pin + e * 8192) + tofs); }
#pragma unroll
        for (int e = 0; e < 16; ++e) {
            const int ai = e >> 3, bj = (e >> 2) & 1, m = e & 3;
            const u32x4 yw = yq[e % DEPTH], pw = pq[e % DEPTH];
            asm volatile("" ::: "memory");
            if (e + DEPTH < 16) { unsigned tofs = tofs0; asm volatile("" : "+v"(tofs)); yq[e % DEPTH] = *(const u32x4*)((ys + (e + DEPTH) * 8192) + tofs); pq[e % DEPTH] = *(const u32x4*)((pin + (e + DEPTH) * 8192) + tofs); }
            asm volatile("" ::: "memory");
            const f32x4 g0 = acc[ai][bj][m][0] * 0.015625f + b0[bj], g1 = acc[ai][bj][m][1] * 0.015625f + b1[bj];
            float z[8];
            z[0] = fast_sigmoid(g0[0]) * __builtin_bit_cast(float, yw.x << 16) + __builtin_bit_cast(float, pw.x << 16); z[1] = fast_sigmoid(g0[1]) * __builtin_bit_cast(float, yw.x & 0xffff0000u) + __builtin_bit_cast(float, pw.x & 0xffff0000u);
            z[2] = fast_sigmoid(g0[2]) * __builtin_bit_cast(float, yw.y << 16) + __builtin_bit_cast(float, pw.y << 16); z[3] = fast_sigmoid(g0[3]) * __builtin_bit_cast(float, yw.y & 0xffff0000u) + __builtin_bit_cast(float, pw.y & 0xffff0000u);
            z[4] = fast_sigmoid(g1[0]) * __builtin_bit_cast(float, yw.z << 16) + __builtin_bit_cast(float, pw.z << 16); z[5] = fast_sigmoid(g1[1]) * __builtin_bit_cast(float, yw.z & 0xffff0000u) + __builtin_bit_cast(float, pw.z & 0xffff0000u);
            z[6] = fast_sigmoid(g1[2]) * __builtin_bit_cast(float, yw.w << 16) + __builtin_bit_cast(float, pw.w << 16); z[7] = fast_sigmoid(g1[3]) * __builtin_bit_cast(float, yw.w & 0xffff0000u) + __builtin_bit_cast(float, pw.w & 0xffff0000u);
            u32x4 w; w.x = cvt_pk_bf16(z[0], z[1]); w.y = cvt_pk_bf16(z[2], z[3]); w.z = cvt_pk_bf16(z[4], z[5]); w.w = cvt_pk_bf16(z[6], z[7]);
            unsigned so = (br < 2) ? (tofs0 + (unsigned)(e * 8192)) : (mofs0 + (unsigned)((ai * 128 + m * 16) * D_ + bj * 128) * 2u); asm volatile("" : "+v"(so));
            *(u32x4*)(pout + so) = w;
        }
    }
};
__device__ __forceinline__ bool moe_find(const LAS unsigned* cnt, int rt, int& bucket, int& local, int& count) {
    int accn = 0;
    for (int b = 0; b < 24; ++b) { const int c = (int)cnt[b]; const int n = (c + 255) >> 8; if (rt < accn + n) { bucket = b; local = rt - accn; count = c; return true; } accn += n; }
    return false;
}
__device__ __forceinline__ void pair_of(int pidx, int& a, int& b) { a = (pidx < 3) ? 0 : (pidx < 5 ? 1 : 2); b = (pidx < 3) ? pidx + 1 : (pidx < 5 ? pidx - 1 : 3); }
struct PolMoeUp {
    static constexpr bool GATHER = true; static constexpr int FP8 = 0;
    __device__ __forceinline__ size_t arow0(const Seg&) const { return 0; }
    const char* H; const char* WGU; int lda2, ldb2, kA; int c, G;
    const LAS unsigned* cnt; const int* list; const float* tokw; bf16_t* hid;
    __device__ __forceinline__ bool next(int i, Seg& s) const {
        const int u = i * G + c, rt = u >> 2, pn = u & 3; int bucket, local, count; if (!moe_find(cnt, rt, bucket, local, count)) return false;
        int a, b; pair_of(bucket % 6, a, b); const int e = (bucket / 6) * 4 + (pn < 2 ? a : b);
        s.A = H; s.B = WGU + ((size_t)e * 512 + (pn & 1) * 256) * 2048; s.B2 = s.B; s.nt = 16; s.ntb = 16; s.epi = 1; s.pm = bucket | (local << 8); s.pn = pn; s.aux = count; s.f8 = 0; return true;
    }
    __device__ __forceinline__ unsigned arow(const Seg& s, int r) const { int idx = (s.pm >> 8) * 256 + r; idx = idx < s.aux ? idx : s.aux - 1; return (unsigned)list[(size_t)(s.pm & 255) * T_ + idx] * 2048u; }
    __device__ __forceinline__ void epilogue(Acc& acc, const Seg& s, int wr, int wc, int fr, int fq) const {
        EPI_ROWCOL(); const int bucket = s.pm & 255, local = s.pm >> 8, slot = s.pn >> 1;
        int tok[8]; float w[8];
#pragma unroll
        for (int e = 0; e < 8; ++e) { const int idx = local * 256 + row0 + (e >> 2) * 128 + (e & 3) * 16; tok[e] = list[(size_t)bucket * T_ + (idx < s.aux ? idx : s.aux - 1)]; }
#pragma unroll
        for (int e = 0; e < 8; ++e) w[e] = tokw[tok[e] * 2 + slot];
#pragma unroll
        for (int e = 0; e < 8; ++e) { const int ai = e >> 2, m = e & 3; const bool valid = (local * 256 + row0 + ai * 128 + m * 16) < s.aux;
            float hv[8];
#pragma unroll
            for (int n = 0; n < 2; ++n)
#pragma unroll
                for (int k = 0; k < 4; ++k) { const float g = acc[ai][0][m][n][k], u = acc[ai][1][m][n][k]; hv[n * 4 + k] = g * fast_sigmoid(g) * u * w[e]; }
            u32x4 o; o.x = cvt_pk_bf16(hv[0], hv[1]); o.y = cvt_pk_bf16(hv[2], hv[3]); o.z = cvt_pk_bf16(hv[4], hv[5]); o.w = cvt_pk_bf16(hv[6], hv[7]);
            if (valid) *(u32x4*)(hid + (size_t)tok[e] * 512 + slot * 256 + (s.pn & 1) * 128 + col0) = o;
        }
    }
};
struct PolMoeDown {
    static constexpr bool GATHER = true; static constexpr int FP8 = 0;
    __device__ __forceinline__ size_t arow0(const Seg&) const { return 0; }
    const char* HID; const char* WD; int lda2, ldb2, kA; int c, G;
    const LAS unsigned* cnt; const int* list; bf16_t* d2;
    __device__ __forceinline__ bool next(int i, Seg& s) const {
        const int u = i * G + c, rt = u >> 2, pn = u & 3; int bucket, local, count; if (!moe_find(cnt, rt, bucket, local, count)) return false;
        int a, b; pair_of(bucket % 6, a, b); const int g4 = (bucket / 6) * 4;
        s.A = HID; s.B = WD + ((size_t)(g4 + a) * 1024 + pn * 256) * 512; s.B2 = WD + ((size_t)(g4 + b) * 1024 + pn * 256) * 512; s.nt = 8; s.ntb = 4; s.epi = 1; s.pm = bucket | (local << 8); s.pn = pn; s.aux = count; s.f8 = 0; return true;
    }
    __device__ __forceinline__ unsigned arow(const Seg& s, int r) const { int idx = (s.pm >> 8) * 256 + r; idx = idx < s.aux ? idx : s.aux - 1; return (unsigned)list[(size_t)(s.pm & 255) * T_ + idx] * 1024u; }
    __device__ __forceinline__ void epilogue(Acc& acc, const Seg& s, int wr, int wc, int fr, int fq) const {
        EPI_ROWCOL(); const int bucket = s.pm & 255, local = s.pm >> 8;
        int tok[8];
#pragma unroll
        for (int e = 0; e < 8; ++e) { const int idx = local * 256 + row0 + (e >> 2) * 128 + (e & 3) * 16; tok[e] = list[(size_t)bucket * T_ + (idx < s.aux ? idx : s.aux - 1)]; }
#pragma unroll
        for (int e = 0; e < 8; ++e) { const int ai = e >> 2, m = e & 3; const bool valid = (local * 256 + row0 + ai * 128 + m * 16) < s.aux;
            bf16_t* dp = d2 + (size_t)tok[e] * D_ + s.pn * 256 + col0;
#pragma unroll
            for (int bj = 0; bj < 2; ++bj) { const f32x4 v0 = acc[ai][bj][m][0], v1 = acc[ai][bj][m][1];
                u32x4 w; w.x = cvt_pk_bf16(v0[0], v0[1]); w.y = cvt_pk_bf16(v0[2], v0[3]); w.z = cvt_pk_bf16(v1[0], v1[1]); w.w = cvt_pk_bf16(v1[2], v1[3]);
                if (valid) *(u32x4*)(dp + bj * 128) = w; }
        }
    }
};

namespace att {
typedef LAS const char* lds_cptr;
typedef short v4i16_t __attribute__((ext_vector_type(4)));
__device__ __forceinline__ int crow(int r, int hi) { return (r & 3) + 8 * (r >> 2) + 4 * hi; }
#define SBAR() __builtin_amdgcn_sched_barrier(0)
__device__ __forceinline__ void glds16(const void* gsrc, unsigned lds_dst) { unsigned keep;
    asm volatile("s_mov_b32 %0, m0\n\ts_mov_b32 m0, %2\n\ts_nop 0\n\tglobal_load_lds_dwordx4 %1, off\n\ts_mov_b32 m0, %0" : "=&s"(keep) : "v"(gsrc), "s"(lds_dst) : "memory"); }
#define WAIT_BAR0() asm volatile("s_waitcnt vmcnt(0) lgkmcnt(0)\n\ts_barrier" ::: "memory")
__device__ __forceinline__ void kload8(bf16x8* kf, lds_cptr kp) {
    kf[0] = *(const LAS bf16x8*)(kp);        kf[1] = *(const LAS bf16x8*)(kp + 512);
    kf[2] = *(const LAS bf16x8*)(kp + 2048); kf[3] = *(const LAS bf16x8*)(kp + 2560);
    kf[4] = *(const LAS bf16x8*)(kp + 4096); kf[5] = *(const LAS bf16x8*)(kp + 4608);
    kf[6] = *(const LAS bf16x8*)(kp + 6144); kf[7] = *(const LAS bf16x8*)(kp + 6656);
}
#define MX3(a, b, c) __builtin_fmaxf(__builtin_fmaxf((a), (b)), (c))
__device__ __forceinline__ float rowmax(const f32x16& p0, const f32x16& p1) {
    float a = MX3(p0[0], p0[1], p1[0]), b = MX3(p0[2], p0[3], p1[1]); a = MX3(a, p1[2], p1[3]);
#pragma unroll
    for (int r = 4; r < 16; r += 4) { a = MX3(a, p0[r], p0[r + 1]); b = MX3(b, p0[r + 2], p0[r + 3]); a = MX3(a, p1[r], p1[r + 1]); b = MX3(b, p1[r + 2], p1[r + 3]); }
    const float m = __builtin_fmaxf(a, b); auto rr = __builtin_amdgcn_permlane32_swap(__float_as_uint(m), __float_as_uint(m), false, false);
    return __builtin_fmaxf(__uint_as_float(rr[0]), __uint_as_float(rr[1]));
}
__device__ __forceinline__ float halfsum(float v) { auto rr = __builtin_amdgcn_permlane32_swap(__float_as_uint(v), __float_as_uint(v), false, false); return __uint_as_float(rr[0]) + __uint_as_float(rr[1]); }
__device__ __forceinline__ s16x4 vtr(lds_cptr p) { return __builtin_bit_cast(s16x4, __builtin_amdgcn_ds_read_tr16_b64_v4i16((LAS v4i16_t*)p)); }
__device__ __forceinline__ void pv(f32x16* o, lds_cptr vp, bf16x8 pa0, bf16x8 pa1, bf16x8 pa2, bf16x8 pa3) {
#pragma unroll
    for (int d0 = 0; d0 < 2; ++d0) { s16x4 lo[4], hi[4];
#pragma unroll
        for (int ks = 0; ks < 4; ++ks) { lo[ks] = vtr(vp + d0 * 4096 + ks * 1024); hi[ks] = vtr(vp + d0 * 4096 + ks * 1024 + 512); }
#define PK(k) (bf16x8){lo[k][0], lo[k][1], lo[k][2], lo[k][3], hi[k][0], hi[k][1], hi[k][2], hi[k][3]}
        o[d0] = __builtin_amdgcn_mfma_f32_32x32x16_bf16(pa0, PK(0), o[d0], 0, 0, 0);
        o[d0] = __builtin_amdgcn_mfma_f32_32x32x16_bf16(pa1, PK(1), o[d0], 0, 0, 0);
        o[d0] = __builtin_amdgcn_mfma_f32_32x32x16_bf16(pa2, PK(2), o[d0], 0, 0, 0);
        o[d0] = __builtin_amdgcn_mfma_f32_32x32x16_bf16(pa3, PK(3), o[d0], 0, 0, 0);
#undef PK
    }
}
typedef float f32x2_t __attribute__((ext_vector_type(2))); typedef __bf16 bf16x2_t __attribute__((ext_vector_type(2)));
__device__ __forceinline__ unsigned cvtpk_s(float lo, float hi) { f32x2_t v = {lo, hi}; bf16x2_t b = __builtin_convertvector(v, bf16x2_t); return __builtin_bit_cast(unsigned, b); }
__device__ __forceinline__ int wave_min_i(int v) {
#pragma unroll
    for (int o = 1; o < 64; o <<= 1) v = min(v, __shfl_xor(v, o));
    return __builtin_amdgcn_readfirstlane(v); }
__device__ __forceinline__ int wave_max_i(int v) {
#pragma unroll
    for (int o = 1; o < 64; o <<= 1) v = max(v, __shfl_xor(v, o));
    return __builtin_amdgcn_readfirstlane(v); }

template <int MODE, bool EXIT>
__device__ __forceinline__ void flash_pass(LAS char* shm, const bf16_t* kbase, const bf16_t* vbase, int pitch, int t_lo, int t_hi, unsigned long long tmask, int tshift, int kref,
                                           const bf16x8* qr, int khi, int klo, float slope2, unsigned long long rmask, float& m, float& l, f32x16* o, float invl, float knmax = 0.f) {
    const int tid = opaque_tid(), lane = tid & 63, r32 = lane & 31, hi = lane >> 5; const int wid = __builtin_amdgcn_readfirstlane(tid >> 6);
    const unsigned lds0 = (unsigned)(uintptr_t)shm;
    const bf16_t* ksrc = kbase + (long)lane * pitch + wid * 8;
    const bf16_t* vsrc = vbase + (long)(16 * (wid & 3) + (lane >> 2)) * pitch + (wid >> 2) * 32 + (lane & 3) * 8;
    const unsigned kdst = lds0 + L_K + wid * 1024, vdst = lds0 + L_V + wid * 1024;
    const lds_cptr kp0 = (lds_cptr)shm + L_K + hi * 1024 + r32 * 16;
    const lds_cptr vp0 = (lds_cptr)shm + L_V + ((lane >> 4) & 1) * 32 + (lane & 3) * 8 + (4 * hi + ((lane & 15) >> 2)) * 64;
    LAS float* wsf = (LAS float*)(shm + L_WSF) + wid * 128;
    const int wmin_khi = wave_min_i(khi), wmax_klo = wave_max_i(klo);
#define ACTIVE(t) (((tmask) >> ((t) >> tshift)) & 1ull)
#define DMA_KV(t, slot) do { glds16(ksrc + (long)(t) * 64 * pitch, (unsigned)__builtin_amdgcn_readfirstlane(kdst + (slot) * SLOTB)); \
                             if (MODE != 2) glds16(vsrc + (long)(t) * 64 * pitch, (unsigned)__builtin_amdgcn_readfirstlane(vdst + (slot) * SLOTB)); } while (0)
    int t = t_hi - 1; while (t >= t_lo && !ACTIVE(t)) --t;
    if (t < t_lo) return;
    float qb = 0.f, mt = -INFINITY; LAS unsigned* votes = (LAS unsigned*)(shm + L_VOTE);
    if (EXIT) {
        float ss = 0.f;
#pragma unroll
        for (int d0 = 0; d0 < 4; ++d0)
#pragma unroll
            for (int e = 0; e < 8; ++e) { const float v = bf2f((unsigned short)qr[d0][e]); ss += v * v; }
        qb = sqrtf(halfsum(ss)) * knmax * 1.01f;
        if (tid < 64) votes[tid] = 0u;
    }
    int slot = 0;
    int tn = t - 1; while (tn >= t_lo && !ACTIVE(tn)) --tn;
    int tnn = tn - 1; while (tnn >= t_lo && !ACTIVE(tnn)) --tnn;
    constexpr int NDMA = (MODE != 2) ? 2 : 1;
    DMA_KV(t, 0);
    if (tn >= t_lo) DMA_KV(tn, 1);
    if (tnn >= t_lo) DMA_KV(tnn, 2);
    if (tnn >= t_lo) { if (NDMA == 2) asm volatile("s_waitcnt vmcnt(2) lgkmcnt(0)\n\ts_barrier" ::: "memory"); else asm volatile("s_waitcnt vmcnt(1) lgkmcnt(0)\n\ts_barrier" ::: "memory"); }
    else WAIT_BAR0();
    constexpr bool KE = EXIT;
    bf16x8 kf[8]; if (KE) kload8(kf, kp0);
    for (;;) {
        int tnnn = tnn - 1; while (tnnn >= t_lo && !ACTIVE(tnnn)) --tnnn;
        const int slot1 = (slot + 1) & 3, slot3 = (slot + 3) & 3;
        if (tnn >= t_lo && tnnn >= t_lo) DMA_KV(tnnn, slot3);
        if (!KE) kload8(kf, kp0 + slot * SLOTB);
        f32x16 p0, p1;
        if (MODE == 1) { const LAS float* fb = (const LAS float*)(shm + L_AUX) + 64 * t + 4 * hi;
#pragma unroll
            for (int g = 0; g < 4; ++g) { const f32x4 a_ = *(const LAS f32x4*)(fb + 8 * g), b_ = *(const LAS f32x4*)(fb + 32 + 8 * g);
#pragma unroll
                for (int k = 0; k < 4; ++k) { p0[4 * g + k] = a_[k] - m; p1[4 * g + k] = b_[k] - m; } }
        } else { const bool rowok = (rmask >> (t >> tshift)) & 1ull;
            const float base = rowok ? (slope2 * (float)(64 * t + 4 * hi - kref) - m) : -INFINITY, base1 = base + 32.f * slope2;
#pragma unroll
            for (int r = 0; r < 16; ++r) { const float cr = (float)((r & 3) + 8 * (r >> 2)); p0[r] = __builtin_fmaf(slope2, cr, base); p1[r] = __builtin_fmaf(slope2, cr, base1); } }
#pragma unroll
        for (int d0 = 0; d0 < 4; ++d0) { p0 = __builtin_amdgcn_mfma_f32_32x32x16_bf16(kf[2 * d0], qr[d0], p0, 0, 0, 0); p1 = __builtin_amdgcn_mfma_f32_32x32x16_bf16(kf[2 * d0 + 1], qr[d0], p1, 0, 0, 0); }
        if (KE) { if (tn >= t_lo) kload8(kf, kp0 + slot1 * SLOTB); }
        if (64 * t + 63 > wmin_khi || 64 * t < wmax_klo) {
            const int kb = 64 * t + 4 * hi;
#pragma unroll
            for (int r = 0; r < 16; ++r) { const int kv = kb + (r & 3) + 8 * (r >> 2); if (kv > khi || kv < klo) p0[r] = -INFINITY; if (kv + 32 > khi || kv + 32 < klo) p1[r] = -INFINITY; }
        }
        if (MODE == 2) {
            LAS float* imp = (LAS float*)(shm + L_IMP) + (wid * 8 + (r32 >> 2)) * IMP_LD + 64 * t + 4 * hi;
#pragma unroll
            for (int r = 0; r < 16; ++r) {
                float a = __builtin_amdgcn_exp2f(p0[r]) * invl, b = __builtin_amdgcn_exp2f(p1[r]) * invl;
                a += __shfl_xor(a, 1); a += __shfl_xor(a, 2); b += __shfl_xor(b, 1); b += __shfl_xor(b, 2);
                if ((r32 & 3) == 0) { imp[(r & 3) + 8 * (r >> 2)] = a; imp[32 + (r & 3) + 8 * (r >> 2)] = b; }
            }
        } else {
            const float rm = rowmax(p0, p1);
            if (EXIT) mt = __builtin_fmaxf(mt, rm + m);
            if (__any(rm > THR)) {
                const float dl = __builtin_fmaxf(rm, 0.f); m += dl;
#pragma unroll
                for (int r = 0; r < 16; ++r) { p0[r] -= dl; p1[r] -= dl; }
                const float f = __builtin_amdgcn_exp2f(-dl); l *= f;
                if (hi == 0) wsf[r32] = f;
                asm volatile("s_waitcnt lgkmcnt(0)" ::: "memory");
#pragma unroll
                for (int r = 0; r < 16; ++r) { const float fr_ = wsf[crow(r, hi)]; o[0][r] *= fr_; o[1][r] *= fr_; }
            }
            const lds_cptr vp = vp0 + slot * SLOTB;
            s16x4 vlo[4][2], vhi[4][2];
#pragma unroll
            for (int ks = 0; ks < 4; ++ks)
#pragma unroll
                for (int d0 = 0; d0 < 2; ++d0) { vlo[ks][d0] = vtr(vp + d0 * 4096 + ks * 1024); vhi[ks][d0] = vtr(vp + d0 * 4096 + ks * 1024 + 512); }
            float sacc = 0.f;
#pragma unroll
            for (int ks = 0; ks < 4; ++ks) {
                float e[8];
#pragma unroll
                for (int i = 0; i < 8; ++i) { e[i] = __builtin_amdgcn_exp2f((ks < 2) ? p0[(ks & 1) * 8 + i] : p1[(ks & 1) * 8 + i]); sacc += e[i]; }
                const u32x4 pw = (u32x4){cvtpk_s(e[0], e[1]), cvtpk_s(e[2], e[3]), cvtpk_s(e[4], e[5]), cvtpk_s(e[6], e[7])};
                const bf16x8 pa = __builtin_bit_cast(bf16x8, pw);
#pragma unroll
                for (int d0 = 0; d0 < 2; ++d0) { const bf16x8 vf = (bf16x8){vlo[ks][d0][0], vlo[ks][d0][1], vlo[ks][d0][2], vlo[ks][d0][3], vhi[ks][d0][0], vhi[ks][d0][1], vhi[ks][d0][2], vhi[ks][d0][3]};
                    o[d0] = __builtin_amdgcn_mfma_f32_32x32x16_bf16(pa, vf, o[d0], 0, 0, 0); }
            }
            l += sacc;
        }
        if (tn < t_lo) { WAIT_BAR0(); break; }
        if (EXIT) {
            const float bmax = (MODE == 1) ? ((const LAS float*)(shm + L_AUX))[64 * tn + 63] : slope2 * (float)(64 * tn + 63 - kref);
            const bool rowdone = (khi < 0) || (klo > 64 * tn + 63) || ((rmask & ((2ull << (tn >> tshift)) - 1ull)) == 0ull);
            const bool sat = rowdone || (qb + bmax < mt - 50.f);
            if (__all(sat) && lane == 0) __hip_atomic_fetch_add(&votes[tn], 1u, __ATOMIC_RELAXED, __HIP_MEMORY_SCOPE_WORKGROUP);
        }
        if (tnn >= t_lo && tnnn >= t_lo) { if (NDMA == 2) asm volatile("s_waitcnt vmcnt(2) lgkmcnt(0)\n\ts_barrier" ::: "memory"); else asm volatile("s_waitcnt vmcnt(1) lgkmcnt(0)\n\ts_barrier" ::: "memory"); }
        else WAIT_BAR0();
        if (EXIT) { if (votes[tn] == 8u) { WAIT_BAR0(); break; } }
        t = tn; tn = tnn; tnn = tnnn; slot = slot1;
    }
#undef ACTIVE
#undef DMA_KV
}
__device__ __forceinline__ float inv_l(float l) { const float lt = halfsum(l); return lt > 0.f ? 1.0f / lt : 0.f; }
__device__ __forceinline__ void scale_rows(LAS char* shm, f32x16* o, float fac, f32x16* dst, bool accumulate) {
    const int tid_ = opaque_tid(), lane = tid_ & 63, r32 = lane & 31, hi = lane >> 5; const int wid = __builtin_amdgcn_readfirstlane(tid_ >> 6);
    LAS float* wsf = (LAS float*)(shm + L_WSF) + wid * 128 + 64;
    if (hi == 0) wsf[r32] = fac;
    asm volatile("s_waitcnt lgkmcnt(0)" ::: "memory");
#pragma unroll
    for (int r = 0; r < 16; ++r) { const float f = wsf[crow(r, hi)];
        if (accumulate) { dst[0][r] += o[0][r] * f; dst[1][r] += o[1][r] * f; } else { dst[0][r] = o[0][r] * f; dst[1][r] = o[1][r] * f; } }
    asm volatile("s_waitcnt lgkmcnt(0)" ::: "memory");
}
template <class RowPtr>
__device__ __forceinline__ void store_o(LAS char* shm, const f32x16* o, const RowPtr& rowptr) {
    const int tid_ = opaque_tid(), lane = tid_ & 63, r32 = lane & 31, hi = lane >> 5; const int wid = __builtin_amdgcn_readfirstlane(tid_ >> 6);
    LAS bf16_t* stg = (LAS bf16_t*)(shm + L_OST) + wid * 2048;
#pragma unroll
    for (int r = 0; r < 16; ++r) { const int orow = crow(r, hi);
#pragma unroll
        for (int d0 = 0; d0 < 2; ++d0) stg[orow * 64 + d0 * 32 + r32] = (bf16_t)f2bf(o[d0][r]); }
    asm volatile("s_waitcnt lgkmcnt(0)" ::: "memory");
#pragma unroll
    for (int i = 0; i < 4; ++i) { const int row = i * 8 + (lane >> 3), ch = lane & 7; const u32x4 v = *(const LAS u32x4*)(stg + row * 64 + ch * 8); *(u32x4*)(rowptr(row) + ch * 8) = v; }
    asm volatile("s_waitcnt lgkmcnt(0)" ::: "memory");
}
__device__ __forceinline__ void load_q(bf16x8* qr, const bf16_t* qrow, int hi) {
#pragma unroll
    for (int d0 = 0; d0 < 4; ++d0) qr[d0] = *(const bf16x8*)(qrow + d0 * 16 + hi * 8);
}

__device__ __forceinline__ void fox_unit(LAS char* shm, const bf16_t* P, const float* FB, bf16_t* O, int b, int h, int qb, float knmax) {
    const int tid = opaque_tid(), lane = tid & 63, r32 = lane & 31, hi = lane >> 5; const int wid = __builtin_amdgcn_readfirstlane(tid >> 6);
    const int q0 = qb * 256, qpos = q0 + wid * 32 + r32;
    const float* fbs = FB + (size_t)(b * 6 + h) * S_; const float ref = fbs[q0];
    LAS float* fbl = (LAS float*)(shm + L_AUX);
    for (int i = tid; i < q0 + 256; i += 512) fbl[i] = fbs[i] - ref;
    bf16x8 qr[4]; load_q(qr, P + (size_t)(b * S_ + qpos) * PP + PC_FQ + h * 64, hi);
    float m = 0.f, l = 0.f; f32x16 o[2]; o[0] = f32x16{}; o[1] = f32x16{};
    flash_pass<1, true>(shm, P + (size_t)(b * S_) * PP + PC_FK + h * 64, P + (size_t)(b * S_) * PP + PC_FV + h * 64, PP, 0, 4 * (qb + 1), ~0ull, 0, 0, qr, qpos, -(1 << 30), 0.f, ~0ull, m, l, o, 0.f, knmax);
    scale_rows(shm, o, inv_l(l), o, false);
    bf16_t* obase = O + (size_t)(b * S_ + q0 + wid * 32) * D_ + h * 64;
    store_o(shm, o, [&](int row) { return obase + (size_t)row * D_; });
}
__device__ __forceinline__ void moba_unit(LAS char* shm, const bf16_t* P, const float* KMEAN, bf16_t* O, int b, int h, int qb, float knmax) {
    const int tid = opaque_tid(), lane = tid & 63, r32 = lane & 31, hi = lane >> 5; const int wid = __builtin_amdgcn_readfirstlane(tid >> 6);
    const int q0 = qb * 256, cur = qb;
    LAS unsigned* mb = (LAS unsigned*)(shm + L_SELM);
    LAS unsigned* un = (LAS unsigned*)(shm + L_UNION);
    LAS float* kml = (LAS float*)(shm + L_AUX);
    if (tid == 0) un[0] = 0u;
    if (tid < 256) ((LAS f32x4*)kml)[tid] = ((const f32x4*)(KMEAN + (size_t)(b * 6 + h) * 16 * 64))[tid];
    __syncthreads();
    {
        const int qi = tid & 255, hf = tid >> 8;
        const bf16_t* qrow = P + (size_t)(b * S_ + q0 + qi) * PP + PC_MQ + h * 64;
        float q[64];
#pragma unroll
        for (int c = 0; c < 8; ++c) { const u32x4 v = *(const u32x4*)(qrow + c * 8);
            q[c * 8 + 0] = __builtin_bit_cast(float, v.x << 16); q[c * 8 + 1] = __builtin_bit_cast(float, v.x & 0xffff0000u); q[c * 8 + 2] = __builtin_bit_cast(float, v.y << 16); q[c * 8 + 3] = __builtin_bit_cast(float, v.y & 0xffff0000u);
            q[c * 8 + 4] = __builtin_bit_cast(float, v.z << 16); q[c * 8 + 5] = __builtin_bit_cast(float, v.z & 0xffff0000u); q[c * 8 + 6] = __builtin_bit_cast(float, v.w << 16); q[c * 8 + 7] = __builtin_bit_cast(float, v.w & 0xffff0000u); }
        int s0 = -1, s1 = -1, s2 = -1; float g0 = -INFINITY, g1 = -INFINITY, g2 = -INFINITY;
        for (int n = hf; n < cur; n += 2) {
            float g = 0.f;
#pragma unroll
            for (int d4 = 0; d4 < 16; ++d4) { const f32x4 kv = *(const LAS f32x4*)(kml + n * 64 + d4 * 4); g += (q[d4 * 4] * kv.x + q[d4 * 4 + 1] * kv.y) + (q[d4 * 4 + 2] * kv.z + q[d4 * 4 + 3] * kv.w); }
            if (g > g0) { s2 = s1; g2 = g1; s1 = s0; g1 = g0; s0 = n; g0 = g; }
            else if (g > g1) { s2 = s1; g2 = g1; s1 = n; g1 = g; }
            else if (g > g2) { s2 = n; g2 = g; }
        }
        LAS float* xg = (LAS float*)(shm + L_AUX + 4096); LAS int* xs = (LAS int*)(shm + L_AUX + 4096 + 3072);
        if (hf == 1) { xg[qi * 3] = g0; xg[qi * 3 + 1] = g1; xg[qi * 3 + 2] = g2; xs[qi * 3] = s0; xs[qi * 3 + 1] = s1; xs[qi * 3 + 2] = s2; }
        __syncthreads();
        if (hf == 0) {
#pragma unroll
            for (int k = 0; k < 3; ++k) { const float g = xg[qi * 3 + k]; const int n = xs[qi * 3 + k];
                if (n >= 0) {
                    if (g > g0 || (g == g0 && n < s0)) { s2 = s1; g2 = g1; s1 = s0; g1 = g0; s0 = n; g0 = g; }
                    else if (g > g1 || (g == g1 && n < s1)) { s2 = s1; g2 = g1; s1 = n; g1 = g; }
                    else if (g > g2 || (g == g2 && n < s2)) { s2 = n; g2 = g; }
                } }
            unsigned mask = 1u << cur;
            if (s0 >= 0) mask |= 1u << s0; if (s1 >= 0) mask |= 1u << s1; if (s2 >= 0) mask |= 1u << s2;
            mb[qi] = mask;
            __hip_atomic_fetch_or(&un[0], mask, __ATOMIC_RELAXED, __HIP_MEMORY_SCOPE_WORKGROUP);
        }
    }
    __syncthreads();
    const unsigned uni = un[0];
    const unsigned long long rmask = mb[wid * 32 + r32];
    const int qpos = q0 + wid * 32 + r32;
    const float slope2 = exp2f(-8.0f * (float)(h + 1) / 6.0f) * LOG2E;
    bf16x8 qr[4]; load_q(qr, P + (size_t)(b * S_ + qpos) * PP + PC_MQ + h * 64, hi);
    float m = 0.f, l = 0.f; f32x16 o[2]; o[0] = f32x16{}; o[1] = f32x16{};
    flash_pass<0, true>(shm, P + (size_t)(b * S_) * PP + PC_MK + h * 64, P + (size_t)(b * S_) * PP + PC_MV + h * 64, PP, 0, 4 * (qb + 1), (unsigned long long)uni, 2, q0, qr, qpos, -(1 << 30), slope2, rmask, m, l, o, 0.f, knmax);
    scale_rows(shm, o, inv_l(l), o, false);
    bf16_t* obase = O + (size_t)(b * S_ + q0 + wid * 32) * D_ + 640 + h * 64;
    store_o(shm, o, [&](int row) { return obase + (size_t)row * D_; });
}
__device__ __forceinline__ void nsa_unit(LAS char* shm, const bf16_t* P, const bf16_t* KCMP, bf16_t* O, int b, int qb) {
    const int tid = opaque_tid(), lane = tid & 63, r32 = lane & 31, hi = lane >> 5; const int wid = __builtin_amdgcn_readfirstlane(tid >> 6);
    const int q0 = qb * 64, ql = wid * 8 + (r32 >> 2), head = r32 & 3, qpos = q0 + ql, cur = qb;
    const float slope2 = exp2f(-2.0f * (float)(head + 1)) * LOG2E;
    const bf16_t* prow = P + (size_t)(b * S_ + qpos) * PP;
    bf16x8 qr[4]; load_q(qr, prow + PC_NQ + head * 64, hi);
    const float gc = fast_sigmoid(bf2f(prow[PC_NG + 0 + head])), gs = fast_sigmoid(bf2f(prow[PC_NG + 4 + head])), gw = fast_sigmoid(bf2f(prow[PC_NG + 8 + head]));
    LAS float* impz = (LAS float*)(shm + L_IMP);
    for (int i = tid; i < 64 * IMP_LD; i += 512) impz[i] = 0.f;
    LAS unsigned long long* selm = (LAS unsigned long long*)(shm + L_SELM);
    LAS unsigned long long* un = (LAS unsigned long long*)(shm + L_UNION);
    if (tid == 0) un[0] = 0ull;
    f32x16 oacc[2]; f32x16 o[2];
    {
        const int nmax = (q0 + 63 - 31) >> 4;
        const int ntile = (q0 + 63 >= 31) ? (nmax >> 6) + 1 : 0;
        const int khi = (qpos >= 31) ? ((qpos - 31) >> 4) : -1;
        const bf16_t* kc = KCMP + (size_t)(b * 2 + 0) * 256 * 64; const bf16_t* vc = KCMP + (size_t)(b * 2 + 1) * 256 * 64;
        float m = 0.f, l = 0.f; o[0] = f32x16{}; o[1] = f32x16{};
        const int kref = q0 >> 4;
        flash_pass<0, false>(shm, kc, vc, 64, 0, ntile, ~0ull, 0, kref, qr, khi, -(1 << 30), slope2 * 16.f, ~0ull, m, l, o, 0.f);
        const float il = inv_l(l);
        scale_rows(shm, o, il * gc, oacc, false);
        float m2 = m, l2 = l;
        flash_pass<2, false>(shm, kc, vc, 64, 0, ntile, ~0ull, 0, kref, qr, khi, -(1 << 30), slope2 * 16.f, ~0ull, m2, l2, o, il);
    }
    __syncthreads();
    for (int qi = 0; qi < 8; ++qi) {
        const int q = wid * 8 + qi, j = lane;
        const LAS float* ip = (const LAS float*)(shm + L_IMP) + q * IMP_LD + 4 * j;
        const float is = ip[0] + 2.f * (ip[1] + ip[2] + ip[3]) + ip[4];
        const bool causal = j <= cur, forced = (j == 0) || (j > cur - 2);
        const float sc = causal ? (forced ? 1e9f : is) : -1e9f;
        bool sel;
        if (cur < 16) sel = causal;
        else {
            int cnt = 0;
#pragma unroll
            for (int jj = 0; jj < 64; ++jj) { const float v = __builtin_bit_cast(float, __builtin_amdgcn_readlane(__builtin_bit_cast(int, sc), jj)); cnt += (v > sc || (v == sc && jj < j)) ? 1 : 0; }
            sel = (cnt < 16) && causal;
        }
        const unsigned long long msk = __ballot(sel);
        if (lane == 0) { selm[q] = msk; __hip_atomic_fetch_or(&un[0], msk, __ATOMIC_RELAXED, __HIP_MEMORY_SCOPE_WORKGROUP); }
    }
    __syncthreads();
    const unsigned long long uni = un[0], rmask = selm[ql];
    {
        float m = 0.f, l = 0.f; o[0] = f32x16{}; o[1] = f32x16{};
        flash_pass<0, false>(shm, P + (size_t)(b * S_) * PP + PC_KS, P + (size_t)(b * S_) * PP + PC_VS, PP, 0, qb + 1, uni, 0, q0, qr, qpos, -(1 << 30), slope2, rmask, m, l, o, 0.f);
        scale_rows(shm, o, inv_l(l) * gs, oacc, true);
    }
    {
        float m = 0.f, l = 0.f; o[0] = f32x16{}; o[1] = f32x16{};
        const int tlo = qb >= 8 ? qb - 8 : 0;
        flash_pass<0, false>(shm, P + (size_t)(b * S_) * PP + PC_KW, P + (size_t)(b * S_) * PP + PC_VW, PP, tlo, qb + 1, ~0ull, 0, q0, qr, qpos, qpos - 511, slope2, ~0ull, m, l, o, 0.f);
        scale_rows(shm, o, inv_l(l) * gw, oacc, true);
    }
    bf16_t* obase = O + (size_t)(b * S_ + q0 + wid * 8) * D_ + 384;
    store_o(shm, oacc, [&](int row) { return obase + (size_t)(row >> 2) * D_ + (row & 3) * 64; });
}
#undef SBAR
}

struct Frame {
    LAS unsigned char* lds; volatile LAS unsigned* MISC; gu32* ctl;
    int tid, lane, wave, vcu, G;
    unsigned char* ws;
};
__device__ __forceinline__ float wave_sum(float v) {
#pragma unroll
    for (int o = 1; o < 64; o <<= 1) v += __shfl_xor(v, o);
    return v;
}
__device__ __forceinline__ unsigned pk4_fp8(float a, float b, float c, float d) { int w = 0; w = __builtin_amdgcn_cvt_pk_fp8_f32(a, b, w, false); w = __builtin_amdgcn_cvt_pk_fp8_f32(c, d, w, true); return (unsigned)w; }
__device__ __forceinline__ int win_dst(int c) {
    if (c < 1152) return c; if (c < 1158) return 2944 + (c - 1152); if (c < 1798) return c - 6; if (c < 1810) return 2950 + (c - 1798); if (c < 2962) return c - 18; return c + 110;
}
__device__ __forceinline__ bool win_isq(int p) { return p < 384 || (p >= PC_NQ && p < PC_NQ + 256) || (p >= PC_MQ && p < PC_MQ + 384); }
__device__ __forceinline__ int rowmap(int kind, int n) { return kind == 1 ? win_dst(n) : (kind == 2 ? ((n >> 7) * 256 + (n & 127)) : (kind == 3 ? ((n >> 7) * 256 + 128 + (n & 127)) : n)); }
__device__ __forceinline__ void tr_item(const float* W, int N, bf16_t* WT, int dld, int dcol, int kind, LAS float* scr, int kb, int nb, int lane) {
    const int k0 = 64 * kb, n0 = 32 * nb;
    const int nn = n0 + (lane & 31);
#pragma unroll
    for (int i = 0; i < 32; ++i) { const int kk = 2 * i + (lane >> 5); scr[kk * 33 + (lane & 31)] = (nn < N) ? W[(size_t)(k0 + kk) * N + nn] : 0.f; }
    asm volatile("s_waitcnt lgkmcnt(0)" ::: "memory");
    const int c = lane & 7;
#pragma unroll
    for (int j = 0; j < 4; ++j) { const int n = (lane >> 3) + 8 * j; const LAS float* s = scr + (8 * c) * 33 + n;
        if (n0 + n < N) {
            const int dr = rowmap(kind, n0 + n); const float sc = (kind == 1 && win_isq(dr)) ? C2 : 1.0f;
            u32x4 o; o.x = pk2(s[0 * 33] * sc, s[1 * 33] * sc); o.y = pk2(s[2 * 33] * sc, s[3 * 33] * sc); o.z = pk2(s[4 * 33] * sc, s[5 * 33] * sc); o.w = pk2(s[6 * 33] * sc, s[7 * 33] * sc);
            *(u32x4*)(WT + (size_t)dr * dld + dcol + k0 + 8 * c) = o; } }
    asm volatile("s_waitcnt lgkmcnt(0)" ::: "memory");
}
struct CvtJob { const float* W; int K, N; bf16_t* WT; int dld, dcol, kind; };
__device__ __forceinline__ void convert_weights(Frame& F, const float* const* in) {
    LAS float* scr = (LAS float*)(F.lds + F.wave * 16384);
    const int gw = F.vcu * 8 + F.wave, NGW = F.G * 8;
    unsigned char* ws = F.ws;
    for (int g = gw; g < 2 * 10704; g += NGW) {
        const int l = g / 10704, r = g % 10704; int it; CvtJob J;
        if (r < 3024) { it = r; J.W = in[4] + (size_t)l * D_ * INC; J.K = D_; J.N = INC; J.WT = (bf16_t*)(ws + WS_WIN) + (size_t)l * NWIN * D_; J.dld = D_; J.dcol = 0; J.kind = 1; }
        else if (r < 3536) { const int br = (r < 3216) ? 0 : (r < 3344 ? 1 : 2); it = r - ((br == 0) ? 3024 : (br == 1 ? 3216 : 3344)); const int Kb = (br == 1) ? 256 : 384; const int kofs = (br == 0) ? 0 : (br == 1 ? 384 : 640);
            J.W = in[10 + br] + (size_t)l * Kb * D_; J.K = Kb; J.N = D_; J.WT = (bf16_t*)(ws + WS_WBR) + (size_t)l * D_ * D_; J.dld = D_; J.dcol = kofs; J.kind = 0; }
        else if (r < 4048) { it = r - 3536; J.W = in[13] + (size_t)l * D_ * D_; J.K = D_; J.N = D_; J.WT = (bf16_t*)(ws + WS_WOUT) + (size_t)l * D_ * D_; J.dld = D_; J.dcol = 0; J.kind = 0; }
        else if (r < 6096) { const int e = (r - 4048) >> 7; it = (r - 4048) & 127; J.W = in[18] + ((size_t)l * 16 + e) * D_ * 256; J.K = D_; J.N = 256; J.WT = (bf16_t*)(ws + WS_WGU) + ((size_t)l * 16 + e) * 512 * D_; J.dld = D_; J.dcol = 0; J.kind = 2; }
        else if (r < 8144) { const int e = (r - 6096) >> 7; it = (r - 6096) & 127; J.W = in[19] + ((size_t)l * 16 + e) * D_ * 256; J.K = D_; J.N = 256; J.WT = (bf16_t*)(ws + WS_WGU) + ((size_t)l * 16 + e) * 512 * D_; J.dld = D_; J.dcol = 0; J.kind = 3; }
        else if (r < 10192) { const int e = (r - 8144) >> 7; it = (r - 8144) & 127; J.W = in[20] + ((size_t)l * 16 + e) * 256 * D_; J.K = 256; J.N = D_; J.WT = (bf16_t*)(ws + WS_WD) + ((size_t)l * 16 + e) * D_ * 256; J.dld = 256; J.dcol = 0; J.kind = 0; }
        else { const int wh = (r - 10192) >> 8; it = (r - 10192) & 255; J.W = in[6] + ((size_t)l * 2 + wh) * 2048 * 256; J.K = 2048; J.N = 256; J.WT = (bf16_t*)(ws + WS_WC1) + ((size_t)l * 2 + wh) * 256 * 2048; J.dld = 2048; J.dcol = 0; J.kind = 0; }
        const int nnb = (J.N + 31) / 32;
        tr_item(J.W, J.N, J.WT, J.dld, J.dcol, J.kind, scr, it / nnb, it % nnb, F.lane);
    }
    const int gt = F.vcu * 512 + F.tid, NGT = F.G * 512;
    for (int i = gt; i < 2 * NWIN; i += NGT) { const int l = i / NWIN, p = i % NWIN; int c = -1;
        if (p < 1152) c = p; else if (p < 1792) c = p + 6; else if (p < 2944) c = p + 18; else if (p < 2950) c = 1152 + (p - 2944); else if (p < 2962) c = 1798 + (p - 2950); else if (p >= 3072) c = p - 110;
        ((float*)(ws + WS_BIAS))[i] = (c >= 0) ? in[5][l * INC + c] * (win_isq(p) ? C2 : 1.0f) : 0.f; }
    for (int i = gt; i < 2 * 110 * D_; i += NGT) { const int l = i / (110 * D_), r = (i % (110 * D_)) / D_, k = i % D_; ((bf16_t*)(ws + WS_WIN))[((size_t)l * NWIN + 2962 + r) * D_ + k] = 0; }
    for (int i = gt; i < 2 * 32 * 1024; i += NGT) { const int l = i >> 15, c = (i >> 10) & 31, k = i & 1023;
        const float w = (c < 4) ? in[14][((size_t)l * D_ + k) * 4 + c] : ((c < 20) ? in[16][((size_t)l * D_ + k) * 16 + (c - 4)] : 0.f);
        const unsigned hb = f2bf(w); const float lo = w - bf2f((unsigned short)hb);
        bf16_t* wrt = (bf16_t*)(ws + WS_WRT) + (size_t)l * 2 * 32 * 1024; wrt[c * 1024 + k] = (bf16_t)hb; wrt[32 * 1024 + c * 1024 + k] = (bf16_t)f2bf(lo); }
    for (int i = gt; i < 2 * 128 * 3072; i += NGT) { const int l = i / (128 * 3072), r = i % (128 * 3072), kb = r / 3072, n = r % 3072;
        const float* wp = in[4] + ((size_t)l * D_ + kb * 8) * INC + 2962 + n; float w8[8];
#pragma unroll
        for (int k = 0; k < 8; ++k) w8[k] = wp[(size_t)k * INC] * 64.0f;
        u32x2 o; o.x = pk4_fp8(w8[0], w8[1], w8[2], w8[3]); o.y = pk4_fp8(w8[4], w8[5], w8[6], w8[7]);
        *(u32x2*)(ws + WS_WG8 + ((size_t)l * 3072 + n) * 2048 + kb * 8) = o; }
    for (int it = gw; it < 4 * 4 * 64; it += NGW) {
        const int m = it >> 8, hg = (it >> 6) & 3, kc = it & 63, h = hg * 64 + F.lane;
        const float* w1 = in[6] + (size_t)m * 2048 * 256 + h; const float* pos = in[9] + (size_t)m * 2048;
        float a = 0.f;
#pragma unroll
        for (int k = kc * 32; k < kc * 32 + 32; ++k) a += pos[k] * w1[(size_t)k * 256];
        ((float*)(ws + WS_BC1P))[(m * 64 + kc) * 256 + h] = a;
    }
}
__device__ __forceinline__ void load_row(f32x4* v, u32x2* a, u32x2* b, const float* x, const bf16_t* d1, const bf16_t* d2, size_t m, int lane) {
    const f32x4* xr = (const f32x4*)(x + m * D_) + lane;
#pragma unroll
    for (int j = 0; j < 4; ++j) v[j] = xr[64 * j];
    if (d1) { const u32x2* p = (const u32x2*)(d1 + m * D_) + lane;
#pragma unroll
        for (int j = 0; j < 4; ++j) a[j] = p[64 * j]; }
    if (d2) { const u32x2* p = (const u32x2*)(d2 + m * D_) + lane;
#pragma unroll
        for (int j = 0; j < 4; ++j) b[j] = p[64 * j]; }
}
__device__ __forceinline__ f32x4 add_bf4(f32x4 v, u32x2 w) { v.x += __builtin_bit_cast(float, w.x << 16); v.y += __builtin_bit_cast(float, w.x & 0xffff0000u); v.z += __builtin_bit_cast(float, w.y << 16); v.w += __builtin_bit_cast(float, w.y & 0xffff0000u); return v; }
__device__ __forceinline__ void norm_rows(Frame& F, const float* x, const bf16_t* d1, const bf16_t* d2, float* xout, const float* g, bf16_t* out, unsigned char* out8) {
    const int gw = F.vcu * 8 + F.wave, NGW = F.G * 8;
    f32x4 gv[4];
#pragma unroll
    for (int j = 0; j < 4; ++j) gv[j] = ((const f32x4*)g)[F.lane + 64 * j];
    f32x4 vn[4]; u32x2 an[4], bn[4];
    if (gw < T_) load_row(vn, an, bn, x, d1, d2, (size_t)gw, F.lane);
    for (int m = gw; m < T_; m += NGW) {
        f32x4 v[4]; float s = 0.f;
#pragma unroll
        for (int j = 0; j < 4; ++j) { v[j] = vn[j]; if (d1) v[j] = add_bf4(v[j], an[j]); if (d2) v[j] = add_bf4(v[j], bn[j]); }
        if (m + NGW < T_) load_row(vn, an, bn, x, d1, d2, (size_t)(m + NGW), F.lane);
#pragma unroll
        for (int j = 0; j < 4; ++j) s += (v[j].x * v[j].x + v[j].y * v[j].y) + (v[j].z * v[j].z + v[j].w * v[j].w);
        const float r = 1.0f / sqrtf(wave_sum(s) * (1.0f / D_) + 1e-6f);
        if (xout) { f32x4* xo = (f32x4*)(xout + (size_t)m * D_) + F.lane;
#pragma unroll
            for (int j = 0; j < 4; ++j) xo[64 * j] = v[j]; }
        u32x2* o8 = (u32x2*)(out + (size_t)m * D_) + F.lane;
#pragma unroll
        for (int j = 0; j < 4; ++j) { u32x2 w; w.x = pk2(v[j].x * r * gv[j].x, v[j].y * r * gv[j].y); w.y = pk2(v[j].z * r * gv[j].z, v[j].w * r * gv[j].w); o8[64 * j] = w; }
        unsigned* q8 = (unsigned*)(out8 + (size_t)m * 2048) + F.lane;
#pragma unroll
        for (int j = 0; j < 4; ++j) q8[64 * j] = pk4_fp8(v[j].x * r * gv[j].x, v[j].y * r * gv[j].y, v[j].z * r * gv[j].z, v[j].w * r * gv[j].w);
    }
}
__device__ __forceinline__ void final_norm(Frame& F, const float* x, const bf16_t* d1, const bf16_t* d2, float* outp, const float* g) {
    const int gw = F.vcu * 8 + F.wave, NGW = F.G * 8;
    f32x4 gv[4];
#pragma unroll
    for (int j = 0; j < 4; ++j) gv[j] = ((const f32x4*)g)[F.lane + 64 * j];
    f32x4 vn[4]; u32x2 an[4], bn[4];
    if (gw < T_) load_row(vn, an, bn, x, d1, d2, (size_t)gw, F.lane);
    for (int m = gw; m < T_; m += NGW) {
        f32x4 v[4]; float s = 0.f;
#pragma unroll
        for (int j = 0; j < 4; ++j) { v[j] = add_bf4(add_bf4(vn[j], an[j]), bn[j]); }
        if (m + NGW < T_) load_row(vn, an, bn, x, d1, d2, (size_t)(m + NGW), F.lane);
#pragma unroll
        for (int j = 0; j < 4; ++j) s += (v[j].x * v[j].x + v[j].y * v[j].y) + (v[j].z * v[j].z + v[j].w * v[j].w);
        const float r = 1.0f / sqrtf(wave_sum(s) * (1.0f / D_) + 1e-6f);
        f32x4* xo = (f32x4*)(outp + (size_t)m * D_) + F.lane;
#pragma unroll
        for (int j = 0; j < 4; ++j) xo[64 * j] = v[j] * r * gv[j];
    }
}
__device__ __forceinline__ void norm2_route(Frame& F, const float* x, const bf16_t* d1, const float* g, bf16_t* out, const bf16_t* wrt, const float* bg, const float* be,
                                            unsigned* cnt, int* list, float* tokw) {
    constexpr int YLD = 1032;
    LAS bf16_t* yh = (LAS bf16_t*)F.lds; LAS bf16_t* yl = yh + 16 * YLD;
    LAS float* part = (LAS float*)(F.lds + 2 * 16 * YLD * 2);
    LAS float* lgt = part + 8 * 512;
    const int lane = F.lane, w = F.wave;
    bf16x8 bh[2][4], bl[2][4];
#pragma unroll
    for (int cb = 0; cb < 2; ++cb)
#pragma unroll
        for (int ks = 0; ks < 4; ++ks) { const size_t o = (size_t)(cb * 16 + (lane & 15)) * 1024 + 128 * w + 32 * ks + 8 * (lane >> 4);
            bh[cb][ks] = *(const bf16x8*)(wrt + o); bl[cb][ks] = *(const bf16x8*)(wrt + 32 * 1024 + o); }
    f32x4 gv[4];
#pragma unroll
    for (int j = 0; j < 4; ++j) gv[j] = ((const f32x4*)g)[lane + 64 * j];
    const int nblk = T_ / 16;
    f32x4 vn[2][4]; u32x2 an[2][4], bn_[4];
    { const int blk0 = F.vcu; if (blk0 < nblk) { load_row(vn[0], an[0], bn_, x, d1, nullptr, (size_t)blk0 * 16 + 2 * w, lane); load_row(vn[1], an[1], bn_, x, d1, nullptr, (size_t)blk0 * 16 + 2 * w + 1, lane); } }
    for (int blk = F.vcu; blk < nblk; blk += F.G) {
#pragma unroll
        for (int rr = 0; rr < 2; ++rr) {
            const int rl = 2 * w + rr; const size_t m = (size_t)blk * 16 + rl;
            f32x4 v[4]; float s = 0.f;
#pragma unroll
            for (int j = 0; j < 4; ++j) { v[j] = add_bf4(vn[rr][j], an[rr][j]); s += (v[j].x * v[j].x + v[j].y * v[j].y) + (v[j].z * v[j].z + v[j].w * v[j].w); }
            const float r = 1.0f / sqrtf(wave_sum(s) * (1.0f / D_) + 1e-6f);
            u32x2* o8 = (u32x2*)(out + m * D_) + lane;
#pragma unroll
            for (int j = 0; j < 4; ++j) { v[j] = v[j] * r * gv[j];
                const unsigned h0 = f2bf(v[j].x), h1 = f2bf(v[j].y), h2 = f2bf(v[j].z), h3 = f2bf(v[j].w);
                u32x2 hw; hw.x = h0 | (h1 << 16); hw.y = h2 | (h3 << 16); o8[64 * j] = hw;
                u32x2 lw; lw.x = pk2(v[j].x - bf2f((unsigned short)h0), v[j].y - bf2f((unsigned short)h1)); lw.y = pk2(v[j].z - bf2f((unsigned short)h2), v[j].w - bf2f((unsigned short)h3));
                *(LAS u32x2*)(yh + rl * YLD + 4 * lane + 256 * j) = hw; *(LAS u32x2*)(yl + rl * YLD + 4 * lane + 256 * j) = lw; }
        }
        { const int nb = blk + F.G; if (nb < nblk) { load_row(vn[0], an[0], bn_, x, d1, nullptr, (size_t)nb * 16 + 2 * w, lane); load_row(vn[1], an[1], bn_, x, d1, nullptr, (size_t)nb * 16 + 2 * w + 1, lane); } }
        __syncthreads();
        f32x4 acc0 = (f32x4){0.f, 0.f, 0.f, 0.f}, acc1 = acc0;
#pragma unroll
        for (int ks = 0; ks < 4; ++ks) {
            const int ko = (lane & 15) * YLD + 128 * w + 32 * ks + 8 * (lane >> 4);
            const bf16x8 ah = *(const LAS bf16x8*)(yh + ko), al = *(const LAS bf16x8*)(yl + ko);
            acc0 = __builtin_amdgcn_mfma_f32_16x16x32_bf16(ah, bh[0][ks], acc0, 0, 0, 0); acc0 = __builtin_amdgcn_mfma_f32_16x16x32_bf16(ah, bl[0][ks], acc0, 0, 0, 0); acc0 = __builtin_amdgcn_mfma_f32_16x16x32_bf16(al, bh[0][ks], acc0, 0, 0, 0);
            acc1 = __builtin_amdgcn_mfma_f32_16x16x32_bf16(ah, bh[1][ks], acc1, 0, 0, 0); acc1 = __builtin_amdgcn_mfma_f32_16x16x32_bf16(ah, bl[1][ks], acc1, 0, 0, 0); acc1 = __builtin_amdgcn_mfma_f32_16x16x32_bf16(al, bh[1][ks], acc1, 0, 0, 0);
        }
#pragma unroll
        for (int i = 0; i < 4; ++i) { part[w * 512 + (4 * (lane >> 4) + i) * 32 + (lane & 15)] = acc0[i]; part[w * 512 + (4 * (lane >> 4) + i) * 32 + 16 + (lane & 15)] = acc1[i]; }
        __syncthreads();
        { const int t = F.tid; float sacc = 0.f;
#pragma unroll
            for (int q = 0; q < 8; ++q) sacc += part[q * 512 + t];
            const int c = t & 31; lgt[t] = sacc + ((c < 4) ? bg[c & 3] : ((c < 20) ? be[(c - 4) & 15] : 0.f)); }
        __syncthreads();
        if (F.tid < 16) {
            const int rl = F.tid; const size_t m = (size_t)blk * 16 + rl;
            const f32x4 lgg = *(const LAS f32x4*)(lgt + rl * 32), le0 = *(const LAS f32x4*)(lgt + rl * 32 + 4), le1 = *(const LAS f32x4*)(lgt + rl * 32 + 8), le2 = *(const LAS f32x4*)(lgt + rl * 32 + 12), le3 = *(const LAS f32x4*)(lgt + rl * 32 + 16);
            int gi = 0; float mg = lgg[0];
#pragma unroll
            for (int c = 1; c < 4; ++c) if (lgg[c] > mg) { mg = lgg[c]; gi = c; }
            float sg = 0.f;
#pragma unroll
            for (int c = 0; c < 4; ++c) sg += expf(lgg[c] - mg);
            const float gp = 1.0f / sg;
            const f32x4 l4 = (gi == 0) ? le0 : ((gi == 1) ? le1 : ((gi == 2) ? le2 : le3));
            int a1 = 0; float va = l4[0];
#pragma unroll
            for (int c = 1; c < 4; ++c) if (l4[c] > va) { va = l4[c]; a1 = c; }
            int b1 = -1; float vb = 0.f;
#pragma unroll
            for (int c = 0; c < 4; ++c) if (c != a1 && (b1 < 0 || l4[c] > vb)) { vb = l4[c]; b1 = c; }
            const float eb = expf(vb - va), w_hi = gp / (1.0f + eb), w_lo = gp * eb / (1.0f + eb);
            const int ea = a1 < b1 ? a1 : b1, ebx = a1 < b1 ? b1 : a1;
            const int pidx = (ea == 0) ? (ebx - 1) : (ea == 1 ? ebx + 1 : 5);
            const float wa = (a1 < b1) ? w_hi : w_lo, wb = (a1 < b1) ? w_lo : w_hi;
            const int bucket = gi * 6 + pidx;
            const unsigned pos = __hip_atomic_fetch_add(cnt + bucket * 64, 1u, RLX_AGENT);
            list[(size_t)bucket * T_ + pos] = (int)m; tokw[m * 2] = wa; tokw[m * 2 + 1] = wb;
        }
    }
    __syncthreads();
}
__device__ __forceinline__ float logsig(float x) { return fminf(x, 0.f) - log1pf(expf(-fabsf(x))); }
__device__ __forceinline__ void knorm_max(Frame& F, const bf16_t* P, int b, int col, gu32* dst) {
    float mx = 0.f;
#pragma unroll 2
    for (int r = F.tid; r < S_; r += 512) { const bf16_t* kp = P + (size_t)(b * S_ + r) * PP + col; float ss = 0.f;
#pragma unroll
        for (int c = 0; c < 8; ++c) { const u32x4 v = *(const u32x4*)(kp + c * 8);
            const float a0 = __builtin_bit_cast(float, v.x << 16), a1 = __builtin_bit_cast(float, v.x & 0xffff0000u), a2 = __builtin_bit_cast(float, v.y << 16), a3 = __builtin_bit_cast(float, v.y & 0xffff0000u);
            const float a4 = __builtin_bit_cast(float, v.z << 16), a5 = __builtin_bit_cast(float, v.z & 0xffff0000u), a6 = __builtin_bit_cast(float, v.w << 16), a7 = __builtin_bit_cast(float, v.w & 0xffff0000u);
            ss += (a0 * a0 + a1 * a1) + (a2 * a2 + a3 * a3) + (a4 * a4 + a5 * a5) + (a6 * a6 + a7 * a7); }
        mx = fmaxf(mx, ss); }
#pragma unroll
    for (int o = 1; o < 64; o <<= 1) mx = fmaxf(mx, __shfl_xor(mx, o));
    if (F.lane == 0) __hip_atomic_fetch_max(dst, __float_as_uint(sqrtf(mx)), RLX_AGENT);
}
__device__ __forceinline__ void fox_cumsum_unit(Frame& F, const bf16_t* P, float* FB, int b, int h) {
    LAS float* tot = (LAS float*)F.lds;
    float v[8]; float run = 0.f;
#pragma unroll
    for (int i = 0; i < 8; ++i) { const int t = F.tid * 8 + i; run += logsig(bf2f(P[(size_t)(b * S_ + t) * PP + PC_FF + h])); v[i] = run; }
    float sc = run;
#pragma unroll
    for (int o = 1; o < 64; o <<= 1) { const float u = __shfl_up(sc, o); if (F.lane >= o) sc += u; }
    if (F.lane == 63) tot[F.wave] = sc;
    __syncthreads();
    float base = sc - run;
    for (int w = 0; w < F.wave; ++w) base += tot[w];
#pragma unroll
    for (int i = 0; i < 8; ++i) FB[(size_t)(b * 6 + h) * S_ + F.tid * 8 + i] = -(base + v[i]) * LOG2E;
    __syncthreads();
}
__device__ __forceinline__ void kmean_unit(Frame& F, const bf16_t* P, float* KMEAN, int b, int h) {
    for (int blk = F.wave * 2; blk < F.wave * 2 + 2; ++blk) {
        const int rg = F.lane >> 3, ch = F.lane & 7; float s8[8];
#pragma unroll
        for (int k = 0; k < 8; ++k) s8[k] = 0.f;
#pragma unroll 16
        for (int i = 0; i < 32; ++i) { const u32x4 v = *(const u32x4*)(P + (size_t)(b * S_ + blk * 256 + i * 8 + rg) * PP + PC_MK + h * 64 + ch * 8);
            s8[0] += __builtin_bit_cast(float, v.x << 16); s8[1] += __builtin_bit_cast(float, v.x & 0xffff0000u); s8[2] += __builtin_bit_cast(float, v.y << 16); s8[3] += __builtin_bit_cast(float, v.y & 0xffff0000u);
            s8[4] += __builtin_bit_cast(float, v.z << 16); s8[5] += __builtin_bit_cast(float, v.z & 0xffff0000u); s8[6] += __builtin_bit_cast(float, v.w << 16); s8[7] += __builtin_bit_cast(float, v.w & 0xffff0000u); }
#pragma unroll
        for (int k = 0; k < 8; ++k) { s8[k] += __shfl_xor(s8[k], 8); s8[k] += __shfl_xor(s8[k], 16); s8[k] += __shfl_xor(s8[k], 32); }
        if (rg == 0) { float* kp = KMEAN + ((size_t)(b * 6 + h) * 16 + blk) * 64 + ch * 8;
            *(f32x4*)kp = (f32x4){s8[0], s8[1], s8[2], s8[3]} * (1.0f / 256.0f); *(f32x4*)(kp + 4) = (f32x4){s8[4], s8[5], s8[6], s8[7]} * (1.0f / 256.0f); }
    }
}
__device__ __forceinline__ void cmp_unit(Frame& F, const bf16_t* P, const bf16_t* WC1, const float* BC1P, const float* B1, const float* W2, bf16_t* KCMP, int b, int which, int ntile) {
    const int lane = F.lane, r32 = lane & 31, hi = lane >> 5, wid = F.wave;
    const int n = ntile * 32 + r32, nn = n < 254 ? n : 254;
    const bf16_t* Arow = P + (size_t)(b * S_ + 16 * nn) * PP + (which ? PC_VC : PC_KC) + hi * 8;
    const bf16_t* Brow = WC1 + (size_t)(wid * 32 + r32) * 2048 + hi * 8;
    f32x16 acc = f32x16{};
#pragma unroll 16
    for (int kk = 0; kk < 128; ++kk) {
        const bf16x8 a = *(const bf16x8*)(Arow + (size_t)(kk >> 2) * PP + (kk & 3) * 16);
        const bf16x8 bb = *(const bf16x8*)(Brow + kk * 16);
        acc = __builtin_amdgcn_mfma_f32_32x32x16_bf16(a, bb, acc, 0, 0, 0);
    }
    LAS float* hs = (LAS float*)F.lds;
    LAS float* w2s = (LAS float*)(F.lds + 40960);
    for (int i = F.tid; i < 256 * 16; i += 512) ((LAS f32x4*)w2s)[i] = ((const f32x4*)W2)[i];
    float bias = B1[wid * 32 + r32];
#pragma unroll 16
    for (int kc = 0; kc < 64; ++kc) bias += BC1P[kc * 256 + wid * 32 + r32];
#pragma unroll
    for (int r = 0; r < 16; ++r) { const float a = acc[r] + bias; const float z = 0.7978845608028654f * (a + 0.044715f * a * a * a);
        hs[att::crow(r, hi) * 260 + wid * 32 + r32] = a * fast_sigmoid(2.0f * z); }
    __syncthreads();
    const int nl = F.tid >> 4, d4 = (F.tid & 15) * 4;
    f32x4 o = (f32x4){0.f, 0.f, 0.f, 0.f};
#pragma unroll 16
    for (int hd = 0; hd < 256; ++hd) { const f32x4 w = *(const LAS f32x4*)(w2s + hd * 64 + d4); o += hs[nl * 260 + hd] * w; }
    const int no = ntile * 32 + nl;
    u32x2 w2; w2.x = (no < 255) ? pk2(o[0], o[1]) : 0u; w2.y = (no < 255) ? pk2(o[2], o[3]) : 0u;
    *(u32x2*)(KCMP + ((size_t)(b * 2 + which) * 256 + no) * 64 + d4) = w2;
    __syncthreads();
}

struct Args { const float* in[21]; float* out; unsigned char* ws; int ph_lo, ph_hi; };
constexpr int NPH = 19;


__device__ __forceinline__ LAS unsigned char* opaque_lds(LAS unsigned char* p) { unsigned v = (unsigned)(uintptr_t)p; asm volatile("" : "+s"(v)); return (LAS unsigned char*)(uintptr_t)v; }
#ifndef PROBE_DUP
#define PROBE_DUP -1
#endif
#define NREP(k) ((PROBE_DUP == (k)) ? 2 : 1)
#define IN(k) (lo <= (k) && (k) < hi)
#define SEAM(k) do { if (IN(k) && IN((k) + 1)) { XcdBarrier bar_; bar_.bar = (unsigned*)((gu32*)(args.ws + WS_CTL) + CW_BAR); bar_.x = xb_xcc_id(); bar_.st = (volatile LAS unsigned*)((LAS unsigned char*)lds + MISC_OFF) + 8; xcd_barrier(bar_); } } while (0)
#define PHASE_ENTRY() const int t_ = opaque_tid(); F.tid = t_; F.lane = t_ & 63; F.wave = __builtin_amdgcn_readfirstlane(t_ >> 6); F.lds = opaque_lds((LAS unsigned char*)lds); \
    unsigned zofs_; asm volatile("s_mov_b32 %0, 0" : "=s"(zofs_)); \
    unsigned char* ws = args.ws + zofs_; F.ws = ws; F.ctl = (gu32*)(ws + WS_CTL); \
    bf16_t* H = (bf16_t*)(ws + WS_H); bf16_t* P = (bf16_t*)(ws + WS_P); bf16_t* O = (bf16_t*)(ws + WS_O); (void)H; (void)P; (void)O
template <int l>
__device__ __forceinline__ void layer_body(Frame& F, const Args& args, const int lo, const int hi) {
    extern __shared__ __attribute__((aligned(16))) unsigned char lds[];
    const float* const* in = args.in; float* X = args.out;
    const int p0 = l * 9;
        const float* xin = (l == 0) ? in[0] : X;
        if (IN(p0 + 0)) {
            PHASE_ENTRY();
            for (int rep = 0; rep < NREP(0); ++rep) {
            if (l == 0) { convert_weights(F, in); }
            norm_rows(F, (l == 0) ? in[0] : in[0], (l == 0) ? nullptr : (const bf16_t*)(ws + WS_D1), (l == 0) ? nullptr : (const bf16_t*)(ws + WS_D2), (l == 0) ? nullptr : X, in[1] + l * D_, H, ws + WS_H8);
            }
        }
        SEAM(p0 + 0);
        if (IN(p0 + 1)) {
            PHASE_ENTRY();
            for (int rep = 0; rep < NREP(1); ++rep) {
            PolInProj pol; pol.A = (const char*)H; pol.B = (const char*)(ws + WS_WIN) + (size_t)l * NWIN * D_ * 2; pol.lda2 = 2048; pol.ldb2 = 2048; pol.kA = 128; pol.nt = 16;
            pol.ord.init(T_, PP, F.G, (int)blockIdx.x); pol.P = P; pol.bias = (const float*)(ws + WS_BIAS) + l * NWIN;
            pg8::gemm_stream(F.lds, pol);
            }
        }
        SEAM(p0 + 1);
        if (IN(p0 + 2)) {
            PHASE_ENTRY();
            for (int rep = 0; rep < NREP(2); ++rep) {
            for (int u = F.vcu; u < 224; u += F.G) {
                if (u < 128) { const int b = u >> 4, which = (u >> 3) & 1, nt = u & 7;
                    cmp_unit(F, P, (const bf16_t*)(ws + WS_WC1) + ((size_t)l * 2 + which) * 256 * 2048, (const float*)(ws + WS_BC1P) + (size_t)(l * 2 + which) * 64 * 256, in[7] + (l * 2 + which) * 256,
                             in[8] + ((size_t)l * 2 + which) * 256 * 64, (bf16_t*)(ws + WS_KCMP), b, which, nt); }
                else if (u < 176) { const int k = u - 128; fox_cumsum_unit(F, P, (float*)(ws + WS_FB), k / 6, k % 6); knorm_max(F, P, k / 6, PC_FK + (k % 6) * 64, F.ctl + CW_KN + l * 128 + k); }
                else { const int k = u - 176; kmean_unit(F, P, (float*)(ws + WS_KMEAN), k / 6, k % 6); knorm_max(F, P, k / 6, PC_MK + (k % 6) * 64, F.ctl + CW_KN + l * 128 + 48 + k); }
            }
            }
        }
        SEAM(p0 + 2);
        if (IN(p0 + 3)) {
            PHASE_ENTRY();
            for (int rep = 0; rep < NREP(3); ++rep) {
            LAS char* shm = (LAS char*)F.lds;
            for (;;) {
                if (F.tid == 0) F.MISC[0] = __hip_atomic_fetch_add(F.ctl + CW_Q + (l * 2 + rep) * 64, 1u, RLX_AGENT);
                __syncthreads();
                const int u = (int)F.MISC[0];
                __syncthreads();
                if (u >= 2048) break;
                const int s = 15 - (u >> 7), k = u & 127;
#ifdef PROBE_ATT_MASK
                if (rep == 1 && !((PROBE_ATT_MASK >> (k < 48 ? 0 : (k < 96 ? 1 : 2))) & 1)) continue;
#endif
                if (k < 48) att::fox_unit(shm, P, (const float*)(ws + WS_FB), O, k / 6, k % 6, s, __uint_as_float(__hip_atomic_load(F.ctl + CW_KN + l * 128 + k, RLX_AGENT)));
                else if (k < 96) att::moba_unit(shm, P, (const float*)(ws + WS_KMEAN), O, (k - 48) / 6, (k - 48) % 6, s, __uint_as_float(__hip_atomic_load(F.ctl + CW_KN + l * 128 + k, RLX_AGENT)));
                else { const int j = k - 96; att::nsa_unit(shm, P, (const bf16_t*)(ws + WS_KCMP), O, j >> 2, 4 * s + (j & 3)); }
            }
            }
        }
        SEAM(p0 + 3);
        if (IN(p0 + 4)) {
            PHASE_ENTRY();
            for (int rep = 0; rep < NREP(4); ++rep) {
            PolMerge pol; pol.O = (const char*)O; pol.H8 = (const char*)(ws + WS_H8); pol.WBR = (const char*)(ws + WS_WBR) + (size_t)l * D_ * D_ * 2;
            pol.WG8 = (const char*)(ws + WS_WG8) + (size_t)l * 3072 * 2048; pol.lda2 = 2048; pol.ldb2 = 2048; pol.kA = 128; pol.vcu = F.vcu; pol.G = F.G;
            pol.merged = (bf16_t*)(ws + WS_MERGED); pol.biasg = (const float*)(ws + WS_BIAS) + l * NWIN + 3072;
            pol.ys = (char*)(ws + WS_YSCR) + (size_t)blockIdx.x * 131072; pol.ps = (char*)(ws + WS_PSCR) + (size_t)blockIdx.x * 131072; pol.zero = (const char*)(ws + WS_CTL + 256 * 1024);
            pg8::gemm_stream(F.lds, pol);
            }
        }
        SEAM(p0 + 4);
        if (IN(p0 + 5)) {
            PHASE_ENTRY();
            for (int rep = 0; rep < NREP(5); ++rep) {
            PolOutProj pol; pol.A = (const char*)(ws + WS_MERGED); pol.B = (const char*)(ws + WS_WOUT) + (size_t)l * D_ * D_ * 2; pol.lda2 = 2048; pol.ldb2 = 2048; pol.kA = 128; pol.nt = 16;
            pol.ord.init(T_, D_, F.G, (int)blockIdx.x); pol.d1 = (bf16_t*)(ws + WS_D1);
            pg8::gemm_stream(F.lds, pol);
            }
        }
        SEAM(p0 + 5);
        if (IN(p0 + 6)) {
            PHASE_ENTRY();
            for (int rep = 0; rep < NREP(6); ++rep) {
            norm2_route(F, xin, (const bf16_t*)(ws + WS_D1), in[2] + l * D_, H, (const bf16_t*)(ws + WS_WRT) + (size_t)l * 2 * 32 * 1024, in[15] + l * 4, in[17] + l * 16, (unsigned*)(F.ctl + CW_CNT + (l + 2 * rep) * 24 * 64), (int*)(ws + WS_LIST + rep * 8 * MiB), (float*)(ws + WS_TOKW + rep * 20 * MiB));
            }
        }
        SEAM(p0 + 6);
        if (IN(p0 + 7)) {
            PHASE_ENTRY();
            for (int rep = 0; rep < NREP(7); ++rep) {
            if (F.tid < 24) F.MISC[32 + F.tid] = __hip_atomic_load(F.ctl + CW_CNT + (l * 24 + F.tid) * 64, RLX_AGENT);
            __syncthreads();
            PolMoeUp pol; pol.H = (const char*)H; pol.WGU = (const char*)(ws + WS_WGU) + (size_t)l * 16 * 512 * D_ * 2; pol.lda2 = 2048; pol.ldb2 = 2048; pol.kA = 128; pol.c = (int)blockIdx.x; pol.G = F.G;
            pol.cnt = (const LAS unsigned*)(F.lds + MISC_OFF) + 32; pol.list = (const int*)(ws + WS_LIST); pol.tokw = (const float*)(ws + WS_TOKW); pol.hid = (bf16_t*)(ws + WS_HID);
            pg8::gemm_stream(F.lds, pol);
            }
        }
        SEAM(p0 + 7);
        if (IN(p0 + 8)) {
            PHASE_ENTRY();
            for (int rep = 0; rep < NREP(8); ++rep) {
            if (F.tid < 24) F.MISC[32 + F.tid] = __hip_atomic_load(F.ctl + CW_CNT + (l * 24 + F.tid) * 64, RLX_AGENT);
            __syncthreads();
            PolMoeDown pol; pol.HID = (const char*)(ws + WS_HID); pol.WD = (const char*)(ws + WS_WD) + (size_t)l * 16 * D_ * 256 * 2; pol.lda2 = 1024; pol.ldb2 = 512; pol.kA = 128; pol.c = (int)blockIdx.x; pol.G = F.G;
            pol.cnt = (const LAS unsigned*)(F.lds + MISC_OFF) + 32; pol.list = (const int*)(ws + WS_LIST); pol.d2 = (bf16_t*)(ws + WS_D2);
            pg8::gemm_stream(F.lds, pol);
            }
        }
        SEAM(p0 + 8);
    }
__global__ void __launch_bounds__(512, 2) mega(Args args) {
    extern __shared__ __attribute__((aligned(16))) unsigned char lds[];
    Frame F;
    F.lds = (LAS unsigned char*)lds; F.MISC = (volatile LAS unsigned*)(F.lds + MISC_OFF);
    F.tid = threadIdx.x; F.lane = F.tid & 63; F.wave = __builtin_amdgcn_readfirstlane(F.tid >> 6);
    F.G = gridDim.x; { const int bx = blockIdx.x; F.vcu = (F.G % 8 == 0) ? (bx % 8) * (F.G / 8) + bx / 8 : bx; }
    F.ws = args.ws; F.ctl = (gu32*)(args.ws + WS_CTL);
    for (int u = F.tid; u < (LDS_BYTES - MISC_OFF) / 4; u += 512) ((LAS unsigned*)(F.lds + MISC_OFF))[u] = 0u;
    __syncthreads();
    if (F.lane == 0) F.MISC[64 + hw_slot()] = (unsigned)F.wave;
    __syncthreads();
    const int lo = args.ph_lo, hi = args.ph_hi;
    if (hi - lo > 1) (void)xcd_barrier_post((unsigned*)(F.ctl + CW_BAR), F.MISC + 8);
    const float* const* in = args.in;
    float* X = args.out;
    layer_body<0>(F, args, lo, hi);
    layer_body<1>(F, args, lo, hi);
    if (IN(18)) { PHASE_ENTRY(); final_norm(F, X, (const bf16_t*)(ws + WS_D1), (const bf16_t*)(ws + WS_D2), X, in[3]); }
#undef IN
#undef SEAM
}

#ifndef MK_PER_PHASE
#define MK_PER_PHASE 0
#endif
extern "C" void kernel_launch(void* const* d_in, const int* in_sizes, int n_in, void* d_out, int out_size, void* d_ws, size_t ws_size, hipStream_t stream) {
    static int grid = 0;
    if (grid == 0) {
        if (n_in != 21 || out_size != T_ * D_ || ws_size < WS_END2) { fprintf(stderr, "kernel_launch: unexpected shapes (n_in %d out %d ws %zu)\n", n_in, out_size, ws_size); grid = -1; return; }
        int dev = 0, cus = 0;
        if (hipGetDevice(&dev) != hipSuccess || hipDeviceGetAttribute(&cus, hipDeviceAttributeMultiprocessorCount, dev) != hipSuccess) { grid = -1; return; }
        if (hipFuncSetAttribute((const void*)mega, hipFuncAttributeMaxDynamicSharedMemorySize, LDS_BYTES) != hipSuccess) { fprintf(stderr, "kernel_launch: hipFuncSetAttribute failed\n"); grid = -1; return; }
        int per_cu = 0;
        if (hipOccupancyMaxActiveBlocksPerMultiprocessor(&per_cu, (const void*)mega, 512, LDS_BYTES) != hipSuccess || per_cu < 1) fprintf(stderr, "kernel_launch: occupancy query says %d\n", per_cu);
        (void)hipGetLastError();
        grid = cus;
    }
    if (grid < 0) return;
    (void)hipMemsetAsync((char*)d_ws + WS_CTL, 0, CTL_ZERO_BYTES, stream);
    Args a{};
    for (int i = 0; i < 21; ++i) a.in[i] = (const float*)d_in[i];
    a.out = (float*)d_out; a.ws = (unsigned char*)d_ws;
#if MK_PER_PHASE
    for (int p = 0; p < NPH; ++p) { a.ph_lo = p; a.ph_hi = p + 1; hipLaunchKernelGGL(mega, dim3(grid), dim3(512), LDS_BYTES, stream, a); }
#else
    a.ph_lo = 0; a.ph_hi = NPH;
    hipLaunchKernelGGL(mega, dim3(grid), dim3(512), LDS_BYTES, stream, a);
#endif
}
```

```cpp
#include <hip/hip_runtime.h>
#include <stdint.h>
#include <math.h>
#include <stdio.h>

#define LAS __attribute__((address_space(3)))
#define GAS __attribute__((address_space(1)))
typedef unsigned short bf16_t;
typedef short bf16x8 __attribute__((ext_vector_type(8)));
typedef short s16x4 __attribute__((ext_vector_type(4)));
typedef float f32x2 __attribute__((ext_vector_type(2)));
typedef float f32x4 __attribute__((ext_vector_type(4)));
typedef float f32x16 __attribute__((ext_vector_type(16)));
typedef unsigned u32x2 __attribute__((ext_vector_type(2)));
typedef unsigned u32x4 __attribute__((ext_vector_type(4)));
typedef GAS unsigned gu32;

constexpr int NB = 8, S_ = 4096, T_ = NB * S_, D_ = 1024, PP = 3072, INC = 6034, NWIN = 6144;
constexpr int PC_FQ = 0, PC_FK = 384, PC_FV = 768, PC_NQ = 1152, PC_KC = 1408, PC_VC = 1472, PC_KS = 1536, PC_VS = 1600, PC_KW = 1664, PC_VW = 1728,
              PC_MQ = 1792, PC_MK = 2176, PC_MV = 2560, PC_FF = 2944, PC_NG = 2950;
constexpr float LOG2E = 1.4426950408889634f;
constexpr float C2 = 0.125f * LOG2E;
constexpr float THR = 6.0f;

constexpr size_t MiB = 1u << 20;
constexpr size_t WS_CTL = 0, CTL_ZERO_BYTES = 1 * MiB;
constexpr size_t WS_WIN = 2 * MiB;
constexpr size_t WS_WBR = 26 * MiB;
constexpr size_t WS_WOUT = 30 * MiB;
constexpr size_t WS_WGU = 34 * MiB;
constexpr size_t WS_WD = 66 * MiB;
constexpr size_t WS_WC1 = 82 * MiB;
constexpr size_t WS_BIAS = 86 * MiB;
constexpr size_t WS_WRT = 87 * MiB + 512 * 1024;
constexpr size_t WS_BC1P = 87 * MiB;
constexpr size_t WS_H = 88 * MiB;
constexpr size_t WS_P = 152 * MiB;
constexpr size_t WS_O = 344 * MiB;
constexpr size_t WS_FB = 408 * MiB;
constexpr size_t WS_KCMP = 409 * MiB;
constexpr size_t WS_KMEAN = 410 * MiB;
constexpr size_t WS_TOKW = 411 * MiB;
constexpr size_t WS_LIST = 412 * MiB;
constexpr size_t WS_MERGED = WS_P;
constexpr size_t WS_YSCR = WS_P + 64 * MiB;
constexpr size_t WS_PSCR = WS_P + 96 * MiB;
constexpr size_t WS_HID = WS_P + 160 * MiB;
constexpr size_t WS_D1 = WS_P + 64 * MiB;
constexpr size_t WS_D2 = WS_P;
constexpr size_t WS_END = 416 * MiB;
constexpr size_t WS_H8 = 416 * MiB;
constexpr size_t WS_WG8 = 480 * MiB;
constexpr size_t WS_END2 = 492 * MiB;
constexpr int CW_TMO = 0, CW_BAR = 4096, CW_Q = 8192, CW_CNT = 8448, CW_KN = 16384;

constexpr int LDS_BYTES = 147456;
constexpr int MISC_OFF = 146944;
constexpr int SLOTB = 8192, NSLOT = 4, L_K = 0, L_V = NSLOT * SLOTB, L_WSF = 2 * NSLOT * SLOTB, L_OST = 0  , L_AUX = L_WSF + 4096;
constexpr int L_IMP = L_AUX, IMP_LD = 260, L_SELM = L_IMP + 64 * IMP_LD * 4, L_UNION = L_SELM + 1024, L_VOTE = L_UNION + 64;
static_assert(L_VOTE + 256 <= MISC_OFF, "lds");

#define RLX_AGENT __ATOMIC_RELAXED, __HIP_MEMORY_SCOPE_AGENT
__device__ __forceinline__ unsigned f2bf(float f) { unsigned u = __builtin_bit_cast(unsigned, f); return (u + 0x7fffu + ((u >> 16) & 1u)) >> 16; }
__device__ __forceinline__ unsigned pk2(float lo, float hi) { return f2bf(lo) | (f2bf(hi) << 16); }
__device__ __forceinline__ float bf2f(unsigned short v) { return __builtin_bit_cast(float, (unsigned)v << 16); }
__device__ __forceinline__ unsigned cvt_pk_bf16(float lo, float hi) { unsigned r; asm volatile("v_cvt_pk_bf16_f32 %0, %1, %2" : "=v"(r) : "v"(lo), "v"(hi)); return r; }
__device__ __forceinline__ unsigned hw_slot() { return (unsigned)__builtin_amdgcn_s_getreg((5 << 11) | (0 << 6) | 4) & 63u; }
__device__ __forceinline__ int opaque_tid() { extern __shared__ __attribute__((aligned(16))) unsigned char lds_ot[];
    const unsigned w = ((volatile LAS unsigned*)((LAS unsigned char*)lds_ot + MISC_OFF))[64 + hw_slot()];
    int t = (int)(w * 64u + __builtin_amdgcn_mbcnt_hi(~0u, __builtin_amdgcn_mbcnt_lo(~0u, 0u))); asm volatile("" : "+v"(t)); return t; }
__device__ __forceinline__ float fast_sigmoid(float x) { return __builtin_amdgcn_rcpf(1.0f + __builtin_amdgcn_exp2f(-x * LOG2E)); }

#define XB_TMO      128
#define XB_XCNT(j)  (256  + 64 * (j))
#define XB_XSUB(j)  (1280 + 64 * (j))
#define XB_XGEN(j)  (2304 + 64 * (j))
#define XB_TOP      3328
#define XB_TOPGEN   3392
#define XCD_BAR_WORDS 3456
#define XB_SPIN_CAP (1u << 20)
__device__ __forceinline__ unsigned xb_ld(unsigned* p)              { return __hip_atomic_load(p, __ATOMIC_RELAXED, __HIP_MEMORY_SCOPE_AGENT); }
__device__ __forceinline__ unsigned xb_add(unsigned* p, unsigned v) { return __hip_atomic_fetch_add(p, v, __ATOMIC_RELAXED, __HIP_MEMORY_SCOPE_AGENT); }
__device__ __forceinline__ unsigned xb_xcc_id() { return (unsigned)__builtin_amdgcn_s_getreg((3 << 11) | 20) & 0xFu; }
#define XB_SPIN(cond, bar) do { unsigned _sp = 0; while (cond) { __builtin_amdgcn_s_sleep(1); \
    if ((++_sp & 255u) == 0u) { if (xb_ld(&(bar)[XB_TMO])) break; if (_sp > XB_SPIN_CAP) { atomicAdd(&(bar)[XB_TMO], 1u); break; } } } } while (0)
struct XcdBarrier { unsigned* bar; unsigned x; volatile LAS unsigned* st; };
__device__ __forceinline__ XcdBarrier xcd_barrier_post(unsigned* bar, volatile LAS unsigned* st) {
    XcdBarrier b; b.bar = bar; b.x = xb_xcc_id(); b.st = st;
    if (threadIdx.x == 0) (void)xb_add(&bar[XB_XCNT(b.x)], 1u);
    return b;
}
__device__ __forceinline__ void xcd_barrier_complete(unsigned* bar, unsigned x, unsigned& nloc, unsigned& nx) {
    const unsigned G = gridDim.x * gridDim.y * gridDim.z;
    unsigned sum, cnt, mine, sp = 0u;
    for (;;) {
        sum = 0u; cnt = 0u; mine = 0u;
#pragma unroll
        for (unsigned j = 0; j < 16; ++j) { const unsigned c = xb_ld(&bar[XB_XCNT(j)]); sum += c; cnt += (c > 0u) ? 1u : 0u; mine = (j == x) ? c : mine; }
        if (sum == G) break;
        __builtin_amdgcn_s_sleep(1);
        if ((++sp & 255u) == 0u) { if (xb_ld(&bar[XB_TMO])) break; if (sp > XB_SPIN_CAP) { atomicAdd(&bar[XB_TMO], 1u); break; } }
    }
    nloc = mine > 0u ? mine : 1u; nx = cnt > 0u ? cnt : 1u;
}
__device__ __forceinline__ void xcd_barrier(const XcdBarrier& b) {
    asm volatile("s_waitcnt vmcnt(0)" ::: "memory");
    __syncthreads();
    if (opaque_tid() == 0) {
        unsigned* bar = b.bar;
        __builtin_amdgcn_s_waitcnt(0);
        unsigned nloc = b.st[0], nx = b.st[1];
        if (nloc == 0u) { xcd_barrier_complete(bar, b.x, nloc, nx); b.st[0] = nloc; b.st[1] = nx; }
        const unsigned old = xb_add(&bar[XB_XSUB(b.x)], 1u);
        const unsigned gen = old / nloc;
        if (old + 1u == (gen + 1u) * nloc) {
            __builtin_amdgcn_fence(__ATOMIC_RELEASE, "agent");
            asm volatile("s_waitcnt vmcnt(0)" ::: "memory");
            const unsigned og = xb_add(&bar[XB_TOP], 1u);
            const unsigned tg = og / nx;
            if (og + 1u == (tg + 1u) * nx) xb_add(&bar[XB_TOPGEN], 1u);
            else XB_SPIN(xb_ld(&bar[XB_TOPGEN]) == tg, bar);
            __builtin_amdgcn_fence(__ATOMIC_ACQUIRE, "agent");
            xb_add(&bar[XB_XGEN(b.x)], 1u);
            asm volatile("s_waitcnt vmcnt(0)" ::: "memory");
        } else {
            XB_SPIN(xb_ld(&bar[XB_XGEN(b.x)]) == gen, bar);
            __builtin_amdgcn_fence(__ATOMIC_ACQUIRE, "agent");
            asm volatile("s_waitcnt vmcnt(0)" ::: "memory");
        }
    }
    __syncthreads();
}

namespace pg8 {
constexpr int BM = 256, BK = 64, HALF = 128, HTB = HALF * BK * 2, STAGE_BYTES = 8 * HTB, NXCD = 8, WGM = 8;
__host__ __device__ __forceinline__ int lds_byte(int r, int c) { const int st = (r >> 4) * 2 + (c >> 5), rr = r & 15, cc = c & 31, ob = rr * 64 + cc * 2; return st * 1024 + (ob ^ (((ob >> 9) & 1) << 5)); }
__host__ __device__ __forceinline__ void stage_rc(int b, int& R, int& C) { const int st = b / 1024, sb = b % 1024, swz = sb ^ (((sb >> 9) & 1) << 5); R = (st >> 1) * 16 + swz / 64; C = (st & 1) * 32 + (swz % 64) / 2; }
__host__ __device__ __forceinline__ int perm32(int rho) { const int n = rho >> 4, i = rho & 15; return 8 * (i >> 2) + 4 * n + (i & 3); }

struct Seg { const char* A; const char* B; const char* B2; int nt, ntb, epi, pm, pn, aux, f8; };
typedef f32x4 Acc[2][2][4][2];
typedef int v8i __attribute__((ext_vector_type(8)));

struct TileOrder {
    int nM, nN, nwg, G, c;
    __device__ void init(int M, int N, int G_, int c_) { nM = M / BM; nN = N / BM; nwg = nM * nN; G = G_; c = c_; }
    __device__ bool tile(int i, int& pm, int& pn) const {
        const long L = (long)i * G + c; if (L >= nwg) return false;
        int wgid = (int)L; { const int q = nwg / NXCD, r = nwg % NXCD, xcd = wgid % NXCD, off = wgid / NXCD; wgid = (xcd < r ? xcd * (q + 1) : r * (q + 1) + (xcd - r) * q) + off; }
        const int nig = WGM * nN, gid = wgid / nig, fm = gid * WGM, gsz = (nM - fm) < WGM ? (nM - fm) : WGM;
        pm = fm + ((wgid % nig) % gsz); pn = (wgid % nig) / gsz; return true;
    }
};

template <class Pol>
__device__ __forceinline__ void gemm_stream(LAS unsigned char* lds, const Pol& S) {
    constexpr bool GA = Pol::GATHER; constexpr int F8M = Pol::FP8;
    const int tid = opaque_tid(), wid = __builtin_amdgcn_readfirstlane(tid >> 6), lane = tid & 63, wr = wid >> 2, wc = wid & 3, fr = lane & 15, fq = lane >> 4;
    int Rr[2]; unsigned voffA[2], voffB[2];
#pragma unroll
    for (int i = 0; i < 2; ++i) { int R, C; stage_rc(tid * 16 + i * 8192, R, C); Rr[i] = R; voffA[i] = GA ? (unsigned)(C * 2) : (unsigned)(R * S.lda2 + C * 2); const int Rb = (R & ~31) + perm32(R & 31); voffB[i] = (unsigned)(Rb * S.ldb2 + C * 2); }
    const unsigned hstepB = (unsigned)(HALF * S.ldb2), hstepA = (unsigned)(HALF * S.lda2);
    const size_t kA = (size_t)S.kA;
    const unsigned ldsw = (unsigned)wid * 1024u;
    const int aoff = lds_byte(wr * 64 + fr, fq * 8), boff = lds_byte(wc * 32 + fr, fq * 8);
    const int sw8 = (fr * 64 + (fq & 1) * 32) ^ ((fr >> 3) << 5);
    const int aoff8 = (wr * 8 + (fq >> 1)) * 1024 + sw8, boff8 = (wc * 4 + (fq >> 1)) * 1024 + sw8;
#define PG8_SA(b, h) (((b) * 2 + (h)) * HTB)
#define PG8_SB(b, h) ((4 + (b) * 2 + (h)) * HTB)
#define PG8_STAGE_A(bufoff, gbase, tsel, h) do { _Pragma("unroll") for (int _i = 0; _i < 2; ++_i) \
        __builtin_amdgcn_global_load_lds((const unsigned*)((gbase) + (GA ? (tab[(tsel) * 256 + (h) * HALF + Rr[_i]] + voffA[_i]) : ((h) * hstepA + voffA[_i]))), (LAS unsigned*)(lds + (bufoff) + ldsw + _i * 8192), 16, 0, 0); } while (0)
#define PG8_STAGE_B(bufoff, gbase, h) do { _Pragma("unroll") for (int _i = 0; _i < 2; ++_i) \
        __builtin_amdgcn_global_load_lds((const unsigned*)((gbase) + (h) * hstepB + voffB[_i]), (LAS unsigned*)(lds + (bufoff) + ldsw + _i * 8192), 16, 0, 0); } while (0)
#define PG8_LDA(dst, b, h) do { _Pragma("unroll") for (int m = 0; m < 4; ++m) _Pragma("unroll") for (int k = 0; k < 2; ++k) dst[m][k] = *(const LAS bf16x8*)(lds + PG8_SA(b, h) + aoff + m * 2048 + k * 1024); } while (0)
#define PG8_LDB(dst, b, h) do { _Pragma("unroll") for (int n = 0; n < 2; ++n) _Pragma("unroll") for (int k = 0; k < 2; ++k) dst[n][k] = *(const LAS bf16x8*)(lds + PG8_SB(b, h) + boff + n * 2048 + k * 1024); } while (0)
#define PG8_MMA(ai, bj, At, Bt) do { __builtin_amdgcn_s_setprio(1); _Pragma("unroll") for (int m = 0; m < 4; ++m) _Pragma("unroll") for (int n = 0; n < 2; ++n) _Pragma("unroll") for (int k = 0; k < 2; ++k) \
        acc[ai][bj][m][n] = __builtin_amdgcn_mfma_f32_16x16x32_bf16(Bt[n][k], At[m][k], acc[ai][bj][m][n], 0, 0, 0); __builtin_amdgcn_s_setprio(0); } while (0)
#define PG8_LDA8(dst, b, h) do { _Pragma("unroll") for (int m = 0; m < 4; ++m) { const u32x4 lo_ = *(const LAS u32x4*)(lds + PG8_SA(b, h) + aoff8 + m * 2048), hi_ = *(const LAS u32x4*)(lds + PG8_SA(b, h) + aoff8 + m * 2048 + 16); dst[m] = (v8i){(int)lo_.x, (int)lo_.y, (int)lo_.z, (int)lo_.w, (int)hi_.x, (int)hi_.y, (int)hi_.z, (int)hi_.w}; } } while (0)
#define PG8_LDB8(dst, b, h) do { _Pragma("unroll") for (int n = 0; n < 2; ++n) { const u32x4 lo_ = *(const LAS u32x4*)(lds + PG8_SB(b, h) + boff8 + n * 2048), hi_ = *(const LAS u32x4*)(lds + PG8_SB(b, h) + boff8 + n * 2048 + 16); dst[n] = (v8i){(int)lo_.x, (int)lo_.y, (int)lo_.z, (int)lo_.w, (int)hi_.x, (int)hi_.y, (int)hi_.z, (int)hi_.w}; } } while (0)
#define PG8_MMA8(ai, bj, At, Bt) do { __builtin_amdgcn_s_setprio(1); _Pragma("unroll") for (int m = 0; m < 4; ++m) _Pragma("unroll") for (int n = 0; n < 2; ++n) \
        asm volatile("v_mfma_scale_f32_16x16x128_f8f6f4 %0, %1, %2, %0, %3, %3 op_sel_hi:[0,0,0]" : "+v"(acc[ai][bj][m][n]) : "v"(Bt[n]), "v"(At[m]), "v"(sc8)); __builtin_amdgcn_s_setprio(0); } while (0)
#define PG8_WAIT_V(n) asm volatile("s_waitcnt vmcnt(" #n ")" ::: "memory")
#define PG8_WAIT_L(n) asm volatile("s_waitcnt lgkmcnt(" #n ")" ::: "memory")
#define PG8_BAR __builtin_amdgcn_s_barrier()
#define PG8_SCHED __builtin_amdgcn_sched_barrier(0)
#define PG8_ZERO_ACC() do { _Pragma("unroll") for (int a = 0; a < 2; ++a) _Pragma("unroll") for (int b = 0; b < 2; ++b) _Pragma("unroll") for (int m = 0; m < 4; ++m) _Pragma("unroll") for (int n = 0; n < 2; ++n) acc[a][b][m][n] = (f32x4){0.f, 0.f, 0.f, 0.f}; } while (0)
    Seg cur, nxt; int ui = 0;
    if (!S.next(0, cur)) return;
    const LAS unsigned* tab = (const LAS unsigned*)(lds + STAGE_BYTES);
    int par = 0;
    if (GA) { if (tid < 256) ((LAS unsigned*)(lds + STAGE_BYTES))[tid] = S.arow(cur, tid); asm volatile("s_waitcnt lgkmcnt(0)" ::: "memory"); PG8_BAR; }
    Acc acc; PG8_ZERO_ACC();
    bf16x8 At[4][2], B0[2][2], B1[2][2]; v8i Et[4], E0[2], E1[2]; const int sc8 = 0x7f7f7f7f;
    {
        const char* cA = cur.A + S.arow0(cur); const char* cB = cur.B;
        PG8_STAGE_B(PG8_SB(0, 0), cB, 0); PG8_STAGE_B(PG8_SB(0, 1), cB, 1); PG8_STAGE_A(PG8_SA(0, 0), cA, par, 0); PG8_STAGE_A(PG8_SA(0, 1), cA, par, 1);
        if (wr == 1) PG8_BAR;
        PG8_WAIT_V(2); PG8_BAR;
        PG8_STAGE_B(PG8_SB(1, 0), cB + 128, 0); PG8_STAGE_A(PG8_SA(1, 0), cA + kA, par, 0); PG8_STAGE_B(PG8_SB(1, 1), cB + 128, 1);
        PG8_WAIT_V(6); PG8_BAR;
    }
    for (;;) {
        const bool has_next = S.next(ui + 1, nxt);
        if (!has_next) nxt = cur;
        const char* cA = cur.A + S.arow0(cur); const char* cB = cur.B; const char* nA = nxt.A + S.arow0(nxt); const char* nB = nxt.B;
        const int nt = cur.nt;
        if (GA) { if (has_next && tid < 256) ((LAS unsigned*)(lds + STAGE_BYTES))[(par ^ 1) * 256 + tid] = S.arow(nxt, tid); }
        const bool use8 = (F8M == 2) && (cur.f8 != 0);
        if (!use8) {
        for (int t = 0; t < nt; t += 2) {
            const bool last = (t == nt - 2);
            const char* a1 = cA + (size_t)(t + 1) * kA;
            const char* a2 = last ? nA : cA + (size_t)(t + 2) * kA; const char* a3 = a2 + kA;
            const char* b2 = last ? nB : ((t + 2 < cur.ntb) ? cB + (size_t)(t + 2) * 128 : cur.B2 + (size_t)(t + 2 - cur.ntb) * 128);
            const char* b3 = last ? ((1 < nxt.ntb) ? nB + 128 : nxt.B2 + (size_t)(1 - nxt.ntb) * 128) : ((t + 3 < cur.ntb) ? cB + (size_t)(t + 3) * 128 : cur.B2 + (size_t)(t + 3 - cur.ntb) * 128);
            const int o2 = (last && has_next) ? (par ^ 1) : par;
            PG8_LDB(B0, 0, 0); PG8_LDB(B1, 0, 1); PG8_SCHED; PG8_LDA(At, 0, 0); PG8_STAGE_A(PG8_SA(1, 1), a1, par, 1);
            PG8_WAIT_V(8); PG8_WAIT_L(0); PG8_BAR; PG8_MMA(0, 0, At, B0); PG8_MMA(0, 1, At, B1); PG8_BAR; PG8_SCHED;
            PG8_LDA(At, 0, 1); PG8_STAGE_B(PG8_SB(0, 0), b2, 0); PG8_STAGE_B(PG8_SB(0, 1), b2, 1); PG8_STAGE_A(PG8_SA(0, 0), a2, o2, 0);
            PG8_WAIT_V(8); PG8_WAIT_L(0); PG8_BAR; PG8_MMA(1, 0, At, B0); PG8_MMA(1, 1, At, B1); PG8_BAR; PG8_SCHED;
            PG8_LDB(B0, 1, 0); PG8_LDB(B1, 1, 1); PG8_SCHED; PG8_LDA(At, 1, 0); PG8_STAGE_A(PG8_SA(0, 1), a2, o2, 1);
            PG8_WAIT_V(8); PG8_WAIT_L(0); PG8_BAR; PG8_MMA(0, 0, At, B0); PG8_MMA(0, 1, At, B1); PG8_BAR; PG8_SCHED;
            PG8_LDA(At, 1, 1); PG8_STAGE_B(PG8_SB(1, 0), b3, 0); PG8_STAGE_B(PG8_SB(1, 1), b3, 1); PG8_STAGE_A(PG8_SA(1, 0), a3, o2, 0);
            PG8_WAIT_V(8); PG8_WAIT_L(0); PG8_BAR; PG8_MMA(1, 0, At, B0); PG8_MMA(1, 1, At, B1); PG8_BAR; PG8_SCHED;
        }
        } else {
        for (int t = 0; t < nt; t += 2) {
            const bool last = (t == nt - 2);
            const char* a1 = cA + (size_t)(t + 1) * kA;
            const char* a2 = last ? nA : cA + (size_t)(t + 2) * kA; const char* a3 = a2 + kA;
            const char* b2 = last ? nB : ((t + 2 < cur.ntb) ? cB + (size_t)(t + 2) * 128 : cur.B2 + (size_t)(t + 2 - cur.ntb) * 128);
            const char* b3 = last ? ((1 < nxt.ntb) ? nB + 128 : nxt.B2 + (size_t)(1 - nxt.ntb) * 128) : ((t + 3 < cur.ntb) ? cB + (size_t)(t + 3) * 128 : cur.B2 + (size_t)(t + 3 - cur.ntb) * 128);
            const int o2 = (last && has_next) ? (par ^ 1) : par;
            PG8_LDB8(E0, 0, 0); PG8_LDB8(E1, 0, 1); PG8_SCHED; PG8_LDA8(Et, 0, 0); PG8_STAGE_A(PG8_SA(1, 1), a1, par, 1);
            PG8_WAIT_V(8); PG8_WAIT_L(0); PG8_BAR; PG8_MMA8(0, 0, Et, E0); PG8_MMA8(0, 1, Et, E1); PG8_BAR; PG8_SCHED;
            PG8_LDA8(Et, 0, 1); PG8_STAGE_B(PG8_SB(0, 0), b2, 0); PG8_STAGE_B(PG8_SB(0, 1), b2, 1); PG8_STAGE_A(PG8_SA(0, 0), a2, o2, 0);
            PG8_WAIT_V(8); PG8_WAIT_L(0); PG8_BAR; PG8_MMA8(1, 0, Et, E0); PG8_MMA8(1, 1, Et, E1); PG8_BAR; PG8_SCHED;
            PG8_LDB8(E0, 1, 0); PG8_LDB8(E1, 1, 1); PG8_SCHED; PG8_LDA8(Et, 1, 0); PG8_STAGE_A(PG8_SA(0, 1), a2, o2, 1);
            PG8_WAIT_V(8); PG8_WAIT_L(0); PG8_BAR; PG8_MMA8(0, 0, Et, E0); PG8_MMA8(0, 1, Et, E1); PG8_BAR; PG8_SCHED;
            PG8_LDA8(Et, 1, 1); PG8_STAGE_B(PG8_SB(1, 0), b3, 0); PG8_STAGE_B(PG8_SB(1, 1), b3, 1); PG8_STAGE_A(PG8_SA(1, 0), a3, o2, 0);
            PG8_WAIT_V(8); PG8_WAIT_L(0); PG8_BAR; PG8_MMA8(1, 0, Et, E0); PG8_MMA8(1, 1, Et, E1); PG8_BAR; PG8_SCHED;
        }
        }
        const int did_epi = cur.epi;
        if (did_epi) { if (wr == 0) PG8_BAR; S.epilogue(acc, cur, wr, wc, fr, fq); }
        if (!has_next) break;
        if (did_epi) PG8_ZERO_ACC();
        cur = nxt; ++ui;
        par ^= 1;
        if (did_epi) { if (wr == 1) PG8_BAR; }
    }
    PG8_WAIT_V(0);
    PG8_BAR;
#undef PG8_SA
#undef PG8_SB
#undef PG8_STAGE_A
#undef PG8_STAGE_B
#undef PG8_LDA
#undef PG8_LDA8
#undef PG8_LDB8
#undef PG8_MMA8
#undef PG8_LDB
#undef PG8_MMA
#undef PG8_WAIT_V
#undef PG8_WAIT_L
#undef PG8_BAR
#undef PG8_SCHED
#undef PG8_ZERO_ACC
}
}

using pg8::Seg; using pg8::Acc;
#define EPI_ROWCOL() const int row0 = wr * 64 + fr, col0 = wc * 32 + 8 * fq

struct PolInProj {
    static constexpr bool GATHER = false; static constexpr int FP8 = 0;
    const char* A; const char* B; int lda2, ldb2, kA, nt; pg8::TileOrder ord;
    bf16_t* P; const float* bias;
    __device__ __forceinline__ bool next(int i, Seg& s) const { int pm, pn; if (!ord.tile(i, pm, pn)) return false; s.A = A; s.B = B + (size_t)pn * 256 * ldb2; s.B2 = s.B; s.nt = nt; s.ntb = nt; s.epi = 1; s.pm = pm; s.pn = pn; s.aux = 0; s.f8 = 0; return true; }
    __device__ __forceinline__ unsigned arow(const Seg&, int) const { return 0u; }
    __device__ __forceinline__ size_t arow0(const Seg& s) const { return (size_t)s.pm * 256 * lda2; }
    __device__ __forceinline__ void epilogue(Acc& acc, const Seg& s, int wr, int wc, int fr, int fq) const {
        EPI_ROWCOL();
        f32x4 bv[2][2];
#pragma unroll
        for (int bj = 0; bj < 2; ++bj)
#pragma unroll
            for (int n = 0; n < 2; ++n) bv[bj][n] = *(const f32x4*)(bias + s.pn * 256 + col0 + bj * 128 + 4 * n);
#pragma unroll
        for (int ai = 0; ai < 2; ++ai)
#pragma unroll
            for (int m = 0; m < 4; ++m) {
                bf16_t* rowp = P + (size_t)(s.pm * 256 + row0 + ai * 128 + m * 16) * PP + s.pn * 256 + col0;
#pragma unroll
                for (int bj = 0; bj < 2; ++bj) { const f32x4 v0 = acc[ai][bj][m][0] + bv[bj][0], v1 = acc[ai][bj][m][1] + bv[bj][1];
                    u32x4 w; w.x = cvt_pk_bf16(v0[0], v0[1]); w.y = cvt_pk_bf16(v0[2], v0[3]); w.z = cvt_pk_bf16(v1[0], v1[1]); w.w = cvt_pk_bf16(v1[2], v1[3]);
                    *(u32x4*)(rowp + bj * 128) = w; }
            }
    }
};
struct PolOutProj {
    static constexpr bool GATHER = false; static constexpr int FP8 = 0;
    const char* A; const char* B; int lda2, ldb2, kA, nt; pg8::TileOrder ord;
    bf16_t* d1;
    __device__ __forceinline__ bool next(int i, Seg& s) const { int pm, pn; if (!ord.tile(i, pm, pn)) return false; s.A = A; s.B = B + (size_t)pn * 256 * ldb2; s.B2 = s.B; s.nt = nt; s.ntb = nt; s.epi = 1; s.pm = pm; s.pn = pn; s.aux = 0; s.f8 = 0; return true; }
    __device__ __forceinline__ unsigned arow(const Seg&, int) const { return 0u; }
    __device__ __forceinline__ size_t arow0(const Seg& s) const { return (size_t)s.pm * 256 * lda2; }
    __device__ __forceinline__ void epilogue(Acc& acc, const Seg& s, int wr, int wc, int fr, int fq) const {
        EPI_ROWCOL();
#pragma unroll
        for (int ai = 0; ai < 2; ++ai)
#pragma unroll
            for (int m = 0; m < 4; ++m) {
                bf16_t* rowp = d1 + (size_t)(s.pm * 256 + row0 + ai * 128 + m * 16) * D_ + s.pn * 256 + col0;
#pragma unroll
                for (int bj = 0; bj < 2; ++bj) { const f32x4 v0 = acc[ai][bj][m][0], v1 = acc[ai][bj][m][1];
                    u32x4 w; w.x = cvt_pk_bf16(v0[0], v0[1]); w.y = cvt_pk_bf16(v0[2], v0[3]); w.z = cvt_pk_bf16(v1[0], v1[1]); w.w = cvt_pk_bf16(v1[2], v1[3]);
                    *(u32x4*)(rowp + bj * 128) = w; }
            }
    }
};
struct PolMerge {
    static constexpr bool GATHER = false; static constexpr int FP8 = 2;
    const char* O; const char* H8; const char* WBR; const char* WG8;
    int lda2, ldb2, kA; int vcu, G;
    bf16_t* merged; const float* biasg; char* ys; char* ps; const char* zero;
    __device__ __forceinline__ bool next(int i, Seg& s) const {
        const int combo = vcu + G * (i / 6), j = i % 6; if (combo >= 512) return false;
        const int pm = combo >> 2, c = combo & 3, br = j >> 1;
        const int kofs = (br == 0) ? 0 : (br == 1 ? 384 : 640);
        if (!(j & 1)) { s.A = O + kofs * 2; s.B = WBR + (size_t)(c * 256) * 2048 + kofs * 2; s.nt = (br == 1) ? 4 : 6; s.f8 = 0; }
        else { s.A = H8; s.B = WG8 + (size_t)(br * 1024 + c * 256) * 2048; s.nt = 8; s.f8 = 1; }
        s.B2 = s.B; s.ntb = s.nt; s.epi = 1; s.pm = pm; s.pn = c; s.aux = j; return true;
    }
    __device__ __forceinline__ unsigned arow(const Seg&, int) const { return 0u; }
    __device__ __forceinline__ size_t arow0(const Seg& s) const { return (size_t)s.pm * 256 * 2048; }
    __device__ __forceinline__ void epilogue(Acc& acc, const Seg& s, int wr, int wc, int fr, int fq) const {
        EPI_ROWCOL(); const int j = s.aux, br = j >> 1; const unsigned tofs0 = (unsigned)((((wr << 2) | wc) << 6) | (fq << 4) | fr) * 16u;
        if (!(j & 1)) {
#pragma unroll
            for (int e = 0; e < 16; ++e) { const int ai = e >> 3, bj = (e >> 2) & 1, m = e & 3; const f32x4 v0 = acc[ai][bj][m][0], v1 = acc[ai][bj][m][1]; unsigned tofs = tofs0; asm volatile("" : "+v"(tofs));
                u32x4 w; w.x = cvt_pk_bf16(v0[0], v0[1]); w.y = cvt_pk_bf16(v0[2], v0[3]); w.z = cvt_pk_bf16(v1[0], v1[1]); w.w = cvt_pk_bf16(v1[2], v1[3]);
                *(u32x4*)((ys + e * 8192) + tofs) = w; }
            return;
        }
        constexpr int DEPTH = 4;
        f32x4 b0[2], b1[2];
#pragma unroll
        for (int bj = 0; bj < 2; ++bj) { b0[bj] = *(const f32x4*)(biasg + br * 1024 + s.pn * 256 + col0 + bj * 128); b1[bj] = *(const f32x4*)(biasg + br * 1024 + s.pn * 256 + col0 + bj * 128 + 4); }
        const char* pin = (br > 0) ? ps : zero;
        char* pout = (br < 2) ? ps : (char*)(merged + (size_t)s.pm * 256 * D_ + s.pn * 256);
        const unsigned mofs0 = (unsigned)(row0 * D_ + col0) * 2u;
        u32x4 yq[DEPTH], pq[DEPTH];
#pragma unroll
        for (int e = 0; e < DEPTH; ++e) { unsigned tofs = tofs0; asm volatile("" : "+v"(tofs)); yq[e] = *(const u32x4*)((ys + e * 8192) + tofs); pq[e] = *(const u32x4*)((pin + e * 8192) + tofs); }
#pragma unroll
        for (int e = 0; e < 16; ++e) {
            const int ai = e >> 3, bj = (e >> 2) & 1, m = e & 3;
            const u32x4 yw = yq[e % DEPTH], pw = pq[e % DEPTH];
            asm volatile("" ::: "memory");
            if (e + DEPTH < 16) { unsigned tofs = tofs0; asm volatile("" : "+v"(tofs)); yq[e % DEPTH] = *(const u32x4*)((ys + (e + DEPTH) * 8192) + tofs); pq[e % DEPTH] = *(const u32x4*)((pin + (e + DEPTH) * 8192) + tofs); }
            asm volatile("" ::: "memory");
            const f32x4 g0 = acc[ai][bj][m][0] * 0.015625f + b0[bj], g1 = acc[ai][bj][m][1] * 0.015625f + b1[bj];
            float z[8];
            z[0] = fast_sigmoid(g0[0]) * __builtin_bit_cast(float, yw.x << 16) + __builtin_bit_cast(float, pw.x << 16); z[1] = fast_sigmoid(g0[1]) * __builtin_bit_cast(float, yw.x & 0xffff0000u) + __builtin_bit_cast(float, pw.x & 0xffff0000u);
            z[2] = fast_sigmoid(g0[2]) * __builtin_bit_cast(float, yw.y << 16) + __builtin_bit_cast(float, pw.y << 16); z[3] = fast_sigmoid(g0[3]) * __builtin_bit_cast(float, yw.y & 0xffff0000u) + __builtin_bit_cast(float, pw.y & 0xffff0000u);
            z[4] = fast_sigmoid(g1[0]) * __builtin_bit_cast(float, yw.z << 16) + __builtin_bit_cast(float, pw.z << 16); z[5] = fast_sigmoid(g1[1]) * __builtin_bit_cast(float, yw.z & 0xffff0000u) + __builtin_bit_cast(float, pw.z & 0xffff0000u);
            z[6] = fast_sigmoid(g1[2]) * __builtin_bit_cast(float, yw.w << 16) + __builtin_bit_cast(float, pw.w << 16); z[7] = fast_sigmoid(g1[3]) * __builtin_bit_cast(float, yw.w & 0xffff0000u) + __builtin_bit_cast(float, pw.w & 0xffff0000u);
            u32x4 w; w.x = cvt_pk_bf16(z[0], z[1]); w.y = cvt_pk_bf16(z[2], z[3]); w.z = cvt_pk_bf16(z[4], z[5]); w.w = cvt_pk_bf16(z[6], z[7]);
            unsigned so = (br < 2) ? (tofs0 + (unsigned)(e * 8192)) : (mofs0 + (unsigned)((ai * 128 + m * 16) * D_ + bj * 128) * 2u); asm volatile("" : "+v"(so));
            *(u32x4*)(pout + so) = w;
        }
    }
};
__device__ __forceinline__ bool moe_find(const LAS unsigned* cnt, int rt, int& bucket, int& local, int& count) {
    int accn = 0;
    for (int b = 0; b < 24; ++b) { const int c = (int)cnt[b]; const int n = (c + 255) >> 8; if (rt < accn + n) { bucket = b; local = rt - accn; count = c; return true; } accn += n; }
    return false;
}
__device__ __forceinline__ void pair_of(int pidx, int& a, int& b) { a = (pidx < 3) ? 0 : (pidx < 5 ? 1 : 2); b = (pidx < 3) ? pidx + 1 : (pidx < 5 ? pidx - 1 : 3); }
struct PolMoeUp {
    static constexpr bool GATHER = true; static constexpr int FP8 = 0;
    __device__ __forceinline__ size_t arow0(const Seg&) const { return 0; }
    const char* H; const char* WGU; int lda2, ldb2, kA; int c, G;
    const LAS unsigned* cnt; const int* list; const float* tokw; bf16_t* hid;
    __device__ __forceinline__ bool next(int i, Seg& s) const {
        const int u = i * G + c, rt = u >> 2, pn = u & 3; int bucket, local, count; if (!moe_find(cnt, rt, bucket, local, count)) return false;
        int a, b; pair_of(bucket % 6, a, b); const int e = (bucket / 6) * 4 + (pn < 2 ? a : b);
        s.A = H; s.B = WGU + ((size_t)e * 512 + (pn & 1) * 256) * 2048; s.B2 = s.B; s.nt = 16; s.ntb = 16; s.epi = 1; s.pm = bucket | (local << 8); s.pn = pn; s.aux = count; s.f8 = 0; return true;
    }
    __device__ __forceinline__ unsigned arow(const Seg& s, int r) const { int idx = (s.pm >> 8) * 256 + r; idx = idx < s.aux ? idx : s.aux - 1; return (unsigned)list[(size_t)(s.pm & 255) * T_ + idx] * 2048u; }
    __device__ __forceinline__ void epilogue(Acc& acc, const Seg& s, int wr, int wc, int fr, int fq) const {
        EPI_ROWCOL(); const int bucket = s.pm & 255, local = s.pm >> 8, slot = s.pn >> 1;
        int tok[8]; float w[8];
#pragma unroll
        for (int e = 0; e < 8; ++e) { const int idx = local * 256 + row0 + (e >> 2) * 128 + (e & 3) * 16; tok[e] = list[(size_t)bucket * T_ + (idx < s.aux ? idx : s.aux - 1)]; }
#pragma unroll
        for (int e = 0; e < 8; ++e) w[e] = tokw[tok[e] * 2 + slot];
#pragma unroll
        for (int e = 0; e < 8; ++e) { const int ai = e >> 2, m = e & 3; const bool valid = (local * 256 + row0 + ai * 128 + m * 16) < s.aux;
            float hv[8];
#pragma unroll
            for (int n = 0; n < 2; ++n)
#pragma unroll
                for (int k = 0; k < 4; ++k) { const float g = acc[ai][0][m][n][k], u = acc[ai][1][m][n][k]; hv[n * 4 + k] = g * fast_sigmoid(g) * u * w[e]; }
            u32x4 o; o.x = cvt_pk_bf16(hv[0], hv[1]); o.y = cvt_pk_bf16(hv[2], hv[3]); o.z = cvt_pk_bf16(hv[4], hv[5]); o.w = cvt_pk_bf16(hv[6], hv[7]);
            if (valid) *(u32x4*)(hid + (size_t)tok[e] * 512 + slot * 256 + (s.pn & 1) * 128 + col0) = o;
        }
    }
};
struct PolMoeDown {
    static constexpr bool GATHER = true; static constexpr int FP8 = 0;
    __device__ __forceinline__ size_t arow0(const Seg&) const { return 0; }
    const char* HID; const char* WD; int lda2, ldb2, kA; int c, G;
    const LAS unsigned* cnt; const int* list; bf16_t* d2;
    __device__ __forceinline__ bool next(int i, Seg& s) const {
        const int u = i * G + c, rt = u >> 2, pn = u & 3; int bucket, local, count; if (!moe_find(cnt, rt, bucket, local, count)) return false;
        int a, b; pair_of(bucket % 6, a, b); const int g4 = (bucket / 6) * 4;
        s.A = HID; s.B = WD + ((size_t)(g4 + a) * 1024 + pn * 256) * 512; s.B2 = WD + ((size_t)(g4 + b) * 1024 + pn * 256) * 512; s.nt = 8; s.ntb = 4; s.epi = 1; s.pm = bucket | (local << 8); s.pn = pn; s.aux = count; s.f8 = 0; return true;
    }
    __device__ __forceinline__ unsigned arow(const Seg& s, int r) const { int idx = (s.pm >> 8) * 256 + r; idx = idx < s.aux ? idx : s.aux - 1; return (unsigned)list[(size_t)(s.pm & 255) * T_ + idx] * 1024u; }
    __device__ __forceinline__ void epilogue(Acc& acc, const Seg& s, int wr, int wc, int fr, int fq) const {
        EPI_ROWCOL(); const int bucket = s.pm & 255, local = s.pm >> 8;
        int tok[8];
#pragma unroll
        for (int e = 0; e < 8; ++e) { const int idx = local * 256 + row0 + (e >> 2) * 128 + (e & 3) * 16; tok[e] = list[(size_t)bucket * T_ + (idx < s.aux ? idx : s.aux - 1)]; }
#pragma unroll
        for (int e = 0; e < 8; ++e) { const int ai = e >> 2, m = e & 3; const bool valid = (local * 256 + row0 + ai * 128 + m * 16) < s.aux;
            bf16_t* dp = d2 + (size_t)tok[e] * D_ + s.pn * 256 + col0;
#pragma unroll
            for (int bj = 0; bj < 2; ++bj) { const f32x4 v0 = acc[ai][bj][m][0], v1 = acc[ai][bj][m][1];
                u32x4 w; w.x = cvt_pk_bf16(v0[0], v0[1]); w.y = cvt_pk_bf16(v0[2], v0[3]); w.z = cvt_pk_bf16(v1[0], v1[1]); w.w = cvt_pk_bf16(v1[2], v1[3]);
                if (valid) *(u32x4*)(dp + bj * 128) = w; }
        }
    }
};

namespace att {
typedef LAS const char* lds_cptr;
typedef short v4i16_t __attribute__((ext_vector_type(4)));
__device__ __forceinline__ int crow(int r, int hi) { return (r & 3) + 8 * (r >> 2) + 4 * hi; }
#define SBAR() __builtin_amdgcn_sched_barrier(0)
__device__ __forceinline__ void glds16(const void* gsrc, unsigned lds_dst) { unsigned keep;
    asm volatile("s_mov_b32 %0, m0\n\ts_mov_b32 m0, %2\n\ts_nop 0\n\tglobal_load_lds_dwordx4 %1, off\n\ts_mov_b32 m0, %0" : "=&s"(keep) : "v"(gsrc), "s"(lds_dst) : "memory"); }
#define WAIT_BAR0() asm volatile("s_waitcnt vmcnt(0) lgkmcnt(0)\n\ts_barrier" ::: "memory")
__device__ __forceinline__ void kload8(bf16x8* kf, lds_cptr kp) {
    kf[0] = *(const LAS bf16x8*)(kp);        kf[1] = *(const LAS bf16x8*)(kp + 512);
    kf[2] = *(const LAS bf16x8*)(kp + 2048); kf[3] = *(const LAS bf16x8*)(kp + 2560);
    kf[4] = *(const LAS bf16x8*)(kp + 4096); kf[5] = *(const LAS bf16x8*)(kp + 4608);
    kf[6] = *(const LAS bf16x8*)(kp + 6144); kf[7] = *(const LAS bf16x8*)(kp + 6656);
}
#define MX3(a, b, c) __builtin_fmaxf(__builtin_fmaxf((a), (b)), (c))
__device__ __forceinline__ float rowmax(const f32x16& p0, const f32x16& p1) {
    float a = MX3(p0[0], p0[1], p1[0]), b = MX3(p0[2], p0[3], p1[1]); a = MX3(a, p1[2], p1[3]);
#pragma unroll
    for (int r = 4; r < 16; r += 4) { a = MX3(a, p0[r], p0[r + 1]); b = MX3(b, p0[r + 2], p0[r + 3]); a = MX3(a, p1[r], p1[r + 1]); b = MX3(b, p1[r + 2], p1[r + 3]); }
    const float m = __builtin_fmaxf(a, b); auto rr = __builtin_amdgcn_permlane32_swap(__float_as_uint(m), __float_as_uint(m), false, false);
    return __builtin_fmaxf(__uint_as_float(rr[0]), __uint_as_float(rr[1]));
}
__device__ __forceinline__ float halfsum(float v) { auto rr = __builtin_amdgcn_permlane32_swap(__float_as_uint(v), __float_as_uint(v), false, false); return __uint_as_float(rr[0]) + __uint_as_float(rr[1]); }
__device__ __forceinline__ s16x4 vtr(lds_cptr p) { return __builtin_bit_cast(s16x4, __builtin_amdgcn_ds_read_tr16_b64_v4i16((LAS v4i16_t*)p)); }
__device__ __forceinline__ void pv(f32x16* o, lds_cptr vp, bf16x8 pa0, bf16x8 pa1, bf16x8 pa2, bf16x8 pa3) {
#pragma unroll
    for (int d0 = 0; d0 < 2; ++d0) { s16x4 lo[4], hi[4];
#pragma unroll
        for (int ks = 0; ks < 4; ++ks) { lo[ks] = vtr(vp + d0 * 4096 + ks * 1024); hi[ks] = vtr(vp + d0 * 4096 + ks * 1024 + 512); }
#define PK(k) (bf16x8){lo[k][0], lo[k][1], lo[k][2], lo[k][3], hi[k][0], hi[k][1], hi[k][2], hi[k][3]}
        o[d0] = __builtin_amdgcn_mfma_f32_32x32x16_bf16(pa0, PK(0), o[d0], 0, 0, 0);
        o[d0] = __builtin_amdgcn_mfma_f32_32x32x16_bf16(pa1, PK(1), o[d0], 0, 0, 0);
        o[d0] = __builtin_amdgcn_mfma_f32_32x32x16_bf16(pa2, PK(2), o[d0], 0, 0, 0);
        o[d0] = __builtin_amdgcn_mfma_f32_32x32x16_bf16(pa3, PK(3), o[d0], 0, 0, 0);
#undef PK
    }
}
typedef float f32x2_t __attribute__((ext_vector_type(2))); typedef __bf16 bf16x2_t __attribute__((ext_vector_type(2)));
__device__ __forceinline__ unsigned cvtpk_s(float lo, float hi) { f32x2_t v = {lo, hi}; bf16x2_t b = __builtin_convertvector(v, bf16x2_t); return __builtin_bit_cast(unsigned, b); }
__device__ __forceinline__ int wave_min_i(int v) {
#pragma unroll
    for (int o = 1; o < 64; o <<= 1) v = min(v, __shfl_xor(v, o));
    return __builtin_amdgcn_readfirstlane(v); }
__device__ __forceinline__ int wave_max_i(int v) {
#pragma unroll
    for (int o = 1; o < 64; o <<= 1) v = max(v, __shfl_xor(v, o));
    return __builtin_amdgcn_readfirstlane(v); }

template <int MODE, bool EXIT>
__device__ __forceinline__ void flash_pass(LAS char* shm, const bf16_t* kbase, const bf16_t* vbase, int pitch, int t_lo, int t_hi, unsigned long long tmask, int tshift, int kref,
                                           const bf16x8* qr, int khi, int klo, float slope2, unsigned long long rmask, float& m, float& l, f32x16* o, float invl, float knmax = 0.f) {
    const int tid = opaque_tid(), lane = tid & 63, r32 = lane & 31, hi = lane >> 5; const int wid = __builtin_amdgcn_readfirstlane(tid >> 6);
    const unsigned lds0 = (unsigned)(uintptr_t)shm;
    const bf16_t* ksrc = kbase + (long)lane * pitch + wid * 8;
    const bf16_t* vsrc = vbase + (long)(16 * (wid & 3) + (lane >> 2)) * pitch + (wid >> 2) * 32 + (lane & 3) * 8;
    const unsigned kdst = lds0 + L_K + wid * 1024, vdst = lds0 + L_V + wid * 1024;
    const lds_cptr kp0 = (lds_cptr)shm + L_K + hi * 1024 + r32 * 16;
    const lds_cptr vp0 = (lds_cptr)shm + L_V + ((lane >> 4) & 1) * 32 + (lane & 3) * 8 + (4 * hi + ((lane & 15) >> 2)) * 64;
    LAS float* wsf = (LAS float*)(shm + L_WSF) + wid * 128;
    const int wmin_khi = wave_min_i(khi), wmax_klo = wave_max_i(klo);
#define ACTIVE(t) (((tmask) >> ((t) >> tshift)) & 1ull)
#define DMA_KV(t, slot) do { glds16(ksrc + (long)(t) * 64 * pitch, (unsigned)__builtin_amdgcn_readfirstlane(kdst + (slot) * SLOTB)); \
                             if (MODE != 2) glds16(vsrc + (long)(t) * 64 * pitch, (unsigned)__builtin_amdgcn_readfirstlane(vdst + (slot) * SLOTB)); } while (0)
    int t = t_hi - 1; while (t >= t_lo && !ACTIVE(t)) --t;
    if (t < t_lo) return;
    float qb = 0.f, mt = -INFINITY; LAS unsigned* votes = (LAS unsigned*)(shm + L_VOTE);
    if (EXIT) {
        float ss = 0.f;
#pragma unroll
        for (int d0 = 0; d0 < 4; ++d0)
#pragma unroll
            for (int e = 0; e < 8; ++e) { const float v = bf2f((unsigned short)qr[d0][e]); ss += v * v; }
        qb = sqrtf(halfsum(ss)) * knmax * 1.01f;
        if (tid < 64) votes[tid] = 0u;
    }
    int slot = 0;
    int tn = t - 1; while (tn >= t_lo && !ACTIVE(tn)) --tn;
    int tnn = tn - 1; while (tnn >= t_lo && !ACTIVE(tnn)) --tnn;
    constexpr int NDMA = (MODE != 2) ? 2 : 1;
    DMA_KV(t, 0);
    if (tn >= t_lo) DMA_KV(tn, 1);
    if (tnn >= t_lo) DMA_KV(tnn, 2);
    if (tnn >= t_lo) { if (NDMA == 2) asm volatile("s_waitcnt vmcnt(2) lgkmcnt(0)\n\ts_barrier" ::: "memory"); else asm volatile("s_waitcnt vmcnt(1) lgkmcnt(0)\n\ts_barrier" ::: "memory"); }
    else WAIT_BAR0();
    constexpr bool KE = EXIT;
    bf16x8 kf[8]; if (KE) kload8(kf, kp0);
    for (;;) {
        int tnnn = tnn - 1; while (tnnn >= t_lo && !ACTIVE(tnnn)) --tnnn;
        const int slot1 = (slot + 1) & 3, slot3 = (slot + 3) & 3;
        if (tnn >= t_lo && tnnn >= t_lo) DMA_KV(tnnn, slot3);
        if (!KE) kload8(kf, kp0 + slot * SLOTB);
        f32x16 p0, p1;
        if (MODE == 1) { const LAS float* fb = (const LAS float*)(shm + L_AUX) + 64 * t + 4 * hi;
#pragma unroll
            for (int g = 0; g < 4; ++g) { const f32x4 a_ = *(const LAS f32x4*)(fb + 8 * g), b_ = *(const LAS f32x4*)(fb + 32 + 8 * g);
#pragma unroll
                for (int k = 0; k < 4; ++k) { p0[4 * g + k] = a_[k] - m; p1[4 * g + k] = b_[k] - m; } }
        } else { const bool rowok = (rmask >> (t >> tshift)) & 1ull;
            const float base = rowok ? (slope2 * (float)(64 * t + 4 * hi - kref) - m) : -INFINITY, base1 = base + 32.f * slope2;
#pragma unroll
            for (int r = 0; r < 16; ++r) { const float cr = (float)((r & 3) + 8 * (r >> 2)); p0[r] = __builtin_fmaf(slope2, cr, base); p1[r] = __builtin_fmaf(slope2, cr, base1); } }
#pragma unroll
        for (int d0 = 0; d0 < 4; ++d0) { p0 = __builtin_amdgcn_mfma_f32_32x32x16_bf16(kf[2 * d0], qr[d0], p0, 0, 0, 0); p1 = __builtin_amdgcn_mfma_f32_32x32x16_bf16(kf[2 * d0 + 1], qr[d0], p1, 0, 0, 0); }
        if (KE) { if (tn >= t_lo) kload8(kf, kp0 + slot1 * SLOTB); }
        if (64 * t + 63 > wmin_khi || 64 * t < wmax_klo) {
            const int kb = 64 * t + 4 * hi;
#pragma unroll
            for (int r = 0; r < 16; ++r) { const int kv = kb + (r & 3) + 8 * (r >> 2); if (kv > khi || kv < klo) p0[r] = -INFINITY; if (kv + 32 > khi || kv + 32 < klo) p1[r] = -INFINITY; }
        }
        if (MODE == 2) {
            LAS float* imp = (LAS float*)(shm + L_IMP) + (wid * 8 + (r32 >> 2)) * IMP_LD + 64 * t + 4 * hi;
#pragma unroll
            for (int r = 0; r < 16; ++r) {
                float a = __builtin_amdgcn_exp2f(p0[r]) * invl, b = __builtin_amdgcn_exp2f(p1[r]) * invl;
                a += __shfl_xor(a, 1); a += __shfl_xor(a, 2); b += __shfl_xor(b, 1); b += __shfl_xor(b, 2);
                if ((r32 & 3) == 0) { imp[(r & 3) + 8 * (r >> 2)] = a; imp[32 + (r & 3) + 8 * (r >> 2)] = b; }
            }
        } else {
            const float rm = rowmax(p0, p1);
            if (EXIT) mt = __builtin_fmaxf(mt, rm + m);
            if (__any(rm > THR)) {
                const float dl = __builtin_fmaxf(rm, 0.f); m += dl;
#pragma unroll
                for (int r = 0; r < 16; ++r) { p0[r] -= dl; p1[r] -= dl; }
                const float f = __builtin_amdgcn_exp2f(-dl); l *= f;
                if (hi == 0) wsf[r32] = f;
                asm volatile("s_waitcnt lgkmcnt(0)" ::: "memory");
#pragma unroll
                for (int r = 0; r < 16; ++r) { const float fr_ = wsf[crow(r, hi)]; o[0][r] *= fr_; o[1][r] *= fr_; }
            }
            const lds_cptr vp = vp0 + slot * SLOTB;
            s16x4 vlo[4][2], vhi[4][2];
#pragma unroll
            for (int ks = 0; ks < 4; ++ks)
#pragma unroll
                for (int d0 = 0; d0 < 2; ++d0) { vlo[ks][d0] = vtr(vp + d0 * 4096 + ks * 1024); vhi[ks][d0] = vtr(vp + d0 * 4096 + ks * 1024 + 512); }
            float sacc = 0.f;
#pragma unroll
            for (int ks = 0; ks < 4; ++ks) {
                float e[8];
#pragma unroll
                for (int i = 0; i < 8; ++i) { e[i] = __builtin_amdgcn_exp2f((ks < 2) ? p0[(ks & 1) * 8 + i] : p1[(ks & 1) * 8 + i]); sacc += e[i]; }
                const u32x4 pw = (u32x4){cvtpk_s(e[0], e[1]), cvtpk_s(e[2], e[3]), cvtpk_s(e[4], e[5]), cvtpk_s(e[6], e[7])};
                const bf16x8 pa = __builtin_bit_cast(bf16x8, pw);
#pragma unroll
                for (int d0 = 0; d0 < 2; ++d0) { const bf16x8 vf = (bf16x8){vlo[ks][d0][0], vlo[ks][d0][1], vlo[ks][d0][2], vlo[ks][d0][3], vhi[ks][d0][0], vhi[ks][d0][1], vhi[ks][d0][2], vhi[ks][d0][3]};
                    o[d0] = __builtin_amdgcn_mfma_f32_32x32x16_bf16(pa, vf, o[d0], 0, 0, 0); }
            }
            l += sacc;
        }
        if (tn < t_lo) { WAIT_BAR0(); break; }
        if (EXIT) {
            const float bmax = (MODE == 1) ? ((const LAS float*)(shm + L_AUX))[64 * tn + 63] : slope2 * (float)(64 * tn + 63 - kref);
            const bool rowdone = (khi < 0) || (klo > 64 * tn + 63) || ((rmask & ((2ull << (tn >> tshift)) - 1ull)) == 0ull);
            const bool sat = rowdone || (qb + bmax < mt - 50.f);
            if (__all(sat) && lane == 0) __hip_atomic_fetch_add(&votes[tn], 1u, __ATOMIC_RELAXED, __HIP_MEMORY_SCOPE_WORKGROUP);
        }
        if (tnn >= t_lo && tnnn >= t_lo) { if (NDMA == 2) asm volatile("s_waitcnt vmcnt(2) lgkmcnt(0)\n\ts_barrier" ::: "memory"); else asm volatile("s_waitcnt vmcnt(1) lgkmcnt(0)\n\ts_barrier" ::: "memory"); }
        else WAIT_BAR0();
        if (EXIT) { if (votes[tn] == 8u) { WAIT_BAR0(); break; } }
        t = tn; tn = tnn; tnn = tnnn; slot = slot1;
    }
#undef ACTIVE
#undef DMA_KV
}
__device__ __forceinline__ float inv_l(float l) { const float lt = halfsum(l); return lt > 0.f ? 1.0f / lt : 0.f; }
__device__ __forceinline__ void scale_rows(LAS char* shm, f32x16* o, float fac, f32x16* dst, bool accumulate) {
    const int tid_ = opaque_tid(), lane = tid_ & 63, r32 = lane & 31, hi = lane >> 5; const int wid = __builtin_amdgcn_readfirstlane(tid_ >> 6);
    LAS float* wsf = (LAS float*)(shm + L_WSF) + wid * 128 + 64;
    if (hi == 0) wsf[r32] = fac;
    asm volatile("s_waitcnt lgkmcnt(0)" ::: "memory");
#pragma unroll
    for (int r = 0; r < 16; ++r) { const float f = wsf[crow(r, hi)];
        if (accumulate) { dst[0][r] += o[0][r] * f; dst[1][r] += o[1][r] * f; } else { dst[0][r] = o[0][r] * f; dst[1][r] = o[1][r] * f; } }
    asm volatile("s_waitcnt lgkmcnt(0)" ::: "memory");
}
template <class RowPtr>
__device__ __forceinline__ void store_o(LAS char* shm, const f32x16* o, const RowPtr& rowptr) {
    const int tid_ = opaque_tid(), lane = tid_ & 63, r32 = lane & 31, hi = lane >> 5; const int wid = __builtin_amdgcn_readfirstlane(tid_ >> 6);
    LAS bf16_t* stg = (LAS bf16_t*)(shm + L_OST) + wid * 2048;
#pragma unroll
    for (int r = 0; r < 16; ++r) { const int orow = crow(r, hi);
#pragma unroll
        for (int d0 = 0; d0 < 2; ++d0) stg[orow * 64 + d0 * 32 + r32] = (bf16_t)f2bf(o[d0][r]); }
    asm volatile("s_waitcnt lgkmcnt(0)" ::: "memory");
#pragma unroll
    for (int i = 0; i < 4; ++i) { const int row = i * 8 + (lane >> 3), ch = lane & 7; const u32x4 v = *(const LAS u32x4*)(stg + row * 64 + ch * 8); *(u32x4*)(rowptr(row) + ch * 8) = v; }
    asm volatile("s_waitcnt lgkmcnt(0)" ::: "memory");
}
__device__ __forceinline__ void load_q(bf16x8* qr, const bf16_t* qrow, int hi) {
#pragma unroll
    for (int d0 = 0; d0 < 4; ++d0) qr[d0] = *(const bf16x8*)(qrow + d0 * 16 + hi * 8);
}

__device__ __forceinline__ void fox_unit(LAS char* shm, const bf16_t* P, const float* FB, bf16_t* O, int b, int h, int qb, float knmax) {
    const int tid = opaque_tid(), lane = tid & 63, r32 = lane & 31, hi = lane >> 5; const int wid = __builtin_amdgcn_readfirstlane(tid >> 6);
    const int q0 = qb * 256, qpos = q0 + wid * 32 + r32;
    const float* fbs = FB + (size_t)(b * 6 + h) * S_; const float ref = fbs[q0];
    LAS float* fbl = (LAS float*)(shm + L_AUX);
    for (int i = tid; i < q0 + 256; i += 512) fbl[i] = fbs[i] - ref;
    bf16x8 qr[4]; load_q(qr, P + (size_t)(b * S_ + qpos) * PP + PC_FQ + h * 64, hi);
    float m = 0.f, l = 0.f; f32x16 o[2]; o[0] = f32x16{}; o[1] = f32x16{};
    flash_pass<1, true>(shm, P + (size_t)(b * S_) * PP + PC_FK + h * 64, P + (size_t)(b * S_) * PP + PC_FV + h * 64, PP, 0, 4 * (qb + 1), ~0ull, 0, 0, qr, qpos, -(1 << 30), 0.f, ~0ull, m, l, o, 0.f, knmax);
    scale_rows(shm, o, inv_l(l), o, false);
    bf16_t* obase = O + (size_t)(b * S_ + q0 + wid * 32) * D_ + h * 64;
    store_o(shm, o, [&](int row) { return obase + (size_t)row * D_; });
}
__device__ __forceinline__ void moba_unit(LAS char* shm, const bf16_t* P, const float* KMEAN, bf16_t* O, int b, int h, int qb, float knmax) {
    const int tid = opaque_tid(), lane = tid & 63, r32 = lane & 31, hi = lane >> 5; const int wid = __builtin_amdgcn_readfirstlane(tid >> 6);
    const int q0 = qb * 256, cur = qb;
    LAS unsigned* mb = (LAS unsigned*)(shm + L_SELM);
    LAS unsigned* un = (LAS unsigned*)(shm + L_UNION);
    LAS float* kml = (LAS float*)(shm + L_AUX);
    if (tid == 0) un[0] = 0u;
    if (tid < 256) ((LAS f32x4*)kml)[tid] = ((const f32x4*)(KMEAN + (size_t)(b * 6 + h) * 16 * 64))[tid];
    __syncthreads();
    {
        const int qi = tid & 255, hf = tid >> 8;
        const bf16_t* qrow = P + (size_t)(b * S_ + q0 + qi) * PP + PC_MQ + h * 64;
        float q[64];
#pragma unroll
        for (int c = 0; c < 8; ++c) { const u32x4 v = *(const u32x4*)(qrow + c * 8);
            q[c * 8 + 0] = __builtin_bit_cast(float, v.x << 16); q[c * 8 + 1] = __builtin_bit_cast(float, v.x & 0xffff0000u); q[c * 8 + 2] = __builtin_bit_cast(float, v.y << 16); q[c * 8 + 3] = __builtin_bit_cast(float, v.y & 0xffff0000u);
            q[c * 8 + 4] = __builtin_bit_cast(float, v.z << 16); q[c * 8 + 5] = __builtin_bit_cast(float, v.z & 0xffff0000u); q[c * 8 + 6] = __builtin_bit_cast(float, v.w << 16); q[c * 8 + 7] = __builtin_bit_cast(float, v.w & 0xffff0000u); }
        int s0 = -1, s1 = -1, s2 = -1; float g0 = -INFINITY, g1 = -INFINITY, g2 = -INFINITY;
        for (int n = hf; n < cur; n += 2) {
            float g = 0.f;
#pragma unroll
            for (int d4 = 0; d4 < 16; ++d4) { const f32x4 kv = *(const LAS f32x4*)(kml + n * 64 + d4 * 4); g += (q[d4 * 4] * kv.x + q[d4 * 4 + 1] * kv.y) + (q[d4 * 4 + 2] * kv.z + q[d4 * 4 + 3] * kv.w); }
            if (g > g0) { s2 = s1; g2 = g1; s1 = s0; g1 = g0; s0 = n; g0 = g; }
            else if (g > g1) { s2 = s1; g2 = g1; s1 = n; g1 = g; }
            else if (g > g2) { s2 = n; g2 = g; }
        }
        LAS float* xg = (LAS float*)(shm + L_AUX + 4096); LAS int* xs = (LAS int*)(shm + L_AUX + 4096 + 3072);
        if (hf == 1) { xg[qi * 3] = g0; xg[qi * 3 + 1] = g1; xg[qi * 3 + 2] = g2; xs[qi * 3] = s0; xs[qi * 3 + 1] = s1; xs[qi * 3 + 2] = s2; }
        __syncthreads();
        if (hf == 0) {
#pragma unroll
            for (int k = 0; k < 3; ++k) { const float g = xg[qi * 3 + k]; const int n = xs[qi * 3 + k];
                if (n >= 0) {
                    if (g > g0 || (g == g0 && n < s0)) { s2 = s1; g2 = g1; s1 = s0; g1 = g0; s0 = n; g0 = g; }
                    else if (g > g1 || (g == g1 && n < s1)) { s2 = s1; g2 = g1; s1 = n; g1 = g; }
                    else if (g > g2 || (g == g2 && n < s2)) { s2 = n; g2 = g; }
                } }
            unsigned mask = 1u << cur;
            if (s0 >= 0) mask |= 1u << s0; if (s1 >= 0) mask |= 1u << s1; if (s2 >= 0) mask |= 1u << s2;
            mb[qi] = mask;
            __hip_atomic_fetch_or(&un[0], mask, __ATOMIC_RELAXED, __HIP_MEMORY_SCOPE_WORKGROUP);
        }
    }
    __syncthreads();
    const unsigned uni = un[0];
    const unsigned long long rmask = mb[wid * 32 + r32];
    const int qpos = q0 + wid * 32 + r32;
    const float slope2 = exp2f(-8.0f * (float)(h + 1) / 6.0f) * LOG2E;
    bf16x8 qr[4]; load_q(qr, P + (size_t)(b * S_ + qpos) * PP + PC_MQ + h * 64, hi);
    float m = 0.f, l = 0.f; f32x16 o[2]; o[0] = f32x16{}; o[1] = f32x16{};
    flash_pass<0, true>(shm, P + (size_t)(b * S_) * PP + PC_MK + h * 64, P + (size_t)(b * S_) * PP + PC_MV + h * 64, PP, 0, 4 * (qb + 1), (unsigned long long)uni, 2, q0, qr, qpos, -(1 << 30), slope2, rmask, m, l, o, 0.f, knmax);
    scale_rows(shm, o, inv_l(l), o, false);
    bf16_t* obase = O + (size_t)(b * S_ + q0 + wid * 32) * D_ + 640 + h * 64;
    store_o(shm, o, [&](int row) { return obase + (size_t)row * D_; });
}
__device__ __forceinline__ void nsa_unit(LAS char* shm, const bf16_t* P, const bf16_t* KCMP, bf16_t* O, int b, int qb) {
    const int tid = opaque_tid(), lane = tid & 63, r32 = lane & 31, hi = lane >> 5; const int wid = __builtin_amdgcn_readfirstlane(tid >> 6);
    const int q0 = qb * 64, ql = wid * 8 + (r32 >> 2), head = r32 & 3, qpos = q0 + ql, cur = qb;
    const float slope2 = exp2f(-2.0f * (float)(head + 1)) * LOG2E;
    const bf16_t* prow = P + (size_t)(b * S_ + qpos) * PP;
    bf16x8 qr[4]; load_q(qr, prow + PC_NQ + head * 64, hi);
    const float gc = fast_sigmoid(bf2f(prow[PC_NG + 0 + head])), gs = fast_sigmoid(bf2f(prow[PC_NG + 4 + head])), gw = fast_sigmoid(bf2f(prow[PC_NG + 8 + head]));
    LAS float* impz = (LAS float*)(shm + L_IMP);
    for (int i = tid; i < 64 * IMP_LD; i += 512) impz[i] = 0.f;
    LAS unsigned long long* selm = (LAS unsigned long long*)(shm + L_SELM);
    LAS unsigned long long* un = (LAS unsigned long long*)(shm + L_UNION);
    if (tid == 0) un[0] = 0ull;
    f32x16 oacc[2]; f32x16 o[2];
    {
        const int nmax = (q0 + 63 - 31) >> 4;
        const int ntile = (q0 + 63 >= 31) ? (nmax >> 6) + 1 : 0;
        const int khi = (qpos >= 31) ? ((qpos - 31) >> 4) : -1;
        const bf16_t* kc = KCMP + (size_t)(b * 2 + 0) * 256 * 64; const bf16_t* vc = KCMP + (size_t)(b * 2 + 1) * 256 * 64;
        float m = 0.f, l = 0.f; o[0] = f32x16{}; o[1] = f32x16{};
        const int kref = q0 >> 4;
        flash_pass<0, false>(shm, kc, vc, 64, 0, ntile, ~0ull, 0, kref, qr, khi, -(1 << 30), slope2 * 16.f, ~0ull, m, l, o, 0.f);
        const float il = inv_l(l);
        scale_rows(shm, o, il * gc, oacc, false);
        float m2 = m, l2 = l;
        flash_pass<2, false>(shm, kc, vc, 64, 0, ntile, ~0ull, 0, kref, qr, khi, -(1 << 30), slope2 * 16.f, ~0ull, m2, l2, o, il);
    }
    __syncthreads();
    for (int qi = 0; qi < 8; ++qi) {
        const int q = wid * 8 + qi, j = lane;
        const LAS float* ip = (const LAS float*)(shm + L_IMP) + q * IMP_LD + 4 * j;
        const float is = ip[0] + 2.f * (ip[1] + ip[2] + ip[3]) + ip[4];
        const bool causal = j <= cur, forced = (j == 0) || (j > cur - 2);
        const float sc = causal ? (forced ? 1e9f : is) : -1e9f;
        bool sel;
        if (cur < 16) sel = causal;
        else {
            int cnt = 0;
#pragma unroll
            for (int jj = 0; jj < 64; ++jj) { const float v = __builtin_bit_cast(float, __builtin_amdgcn_readlane(__builtin_bit_cast(int, sc), jj)); cnt += (v > sc || (v == sc && jj < j)) ? 1 : 0; }
            sel = (cnt < 16) && causal;
        }
        const unsigned long long msk = __ballot(sel);
        if (lane == 0) { selm[q] = msk; __hip_atomic_fetch_or(&un[0], msk, __ATOMIC_RELAXED, __HIP_MEMORY_SCOPE_WORKGROUP); }
    }
    __syncthreads();
    const unsigned long long uni = un[0], rmask = selm[ql];
    {
        float m = 0.f, l = 0.f; o[0] = f32x16{}; o[1] = f32x16{};
        flash_pass<0, false>(shm, P + (size_t)(b * S_) * PP + PC_KS, P + (size_t)(b * S_) * PP + PC_VS, PP, 0, qb + 1, uni, 0, q0, qr, qpos, -(1 << 30), slope2, rmask, m, l, o, 0.f);
        scale_rows(shm, o, inv_l(l) * gs, oacc, true);
    }
    {
        float m = 0.f, l = 0.f; o[0] = f32x16{}; o[1] = f32x16{};
        const int tlo = qb >= 8 ? qb - 8 : 0;
        flash_pass<0, false>(shm, P + (size_t)(b * S_) * PP + PC_KW, P + (size_t)(b * S_) * PP + PC_VW, PP, tlo, qb + 1, ~0ull, 0, q0, qr, qpos, qpos - 511, slope2, ~0ull, m, l, o, 0.f);
        scale_rows(shm, o, inv_l(l) * gw, oacc, true);
    }
    bf16_t* obase = O + (size_t)(b * S_ + q0 + wid * 8) * D_ + 384;
    store_o(shm, oacc, [&](int row) { return obase + (size_t)(row >> 2) * D_ + (row & 3) * 64; });
}
#undef SBAR
}

struct Frame {
    LAS unsigned char* lds; volatile LAS unsigned* MISC; gu32* ctl;
    int tid, lane, wave, vcu, G;
    unsigned char* ws;
};
__device__ __forceinline__ float wave_sum(float v) {
#pragma unroll
    for (int o = 1; o < 64; o <<= 1) v += __shfl_xor(v, o);
    return v;
}
__device__ __forceinline__ unsigned pk4_fp8(float a, float b, float c, float d) { int w = 0; w = __builtin_amdgcn_cvt_pk_fp8_f32(a, b, w, false); w = __builtin_amdgcn_cvt_pk_fp8_f32(c, d, w, true); return (unsigned)w; }
__device__ __forceinline__ int win_dst(int c) {
    if (c < 1152) return c; if (c < 1158) return 2944 + (c - 1152); if (c < 1798) return c - 6; if (c < 1810) return 2950 + (c - 1798); if (c < 2962) return c - 18; return c + 110;
}
__device__ __forceinline__ bool win_isq(int p) { return p < 384 || (p >= PC_NQ && p < PC_NQ + 256) || (p >= PC_MQ && p < PC_MQ + 384); }
__device__ __forceinline__ int rowmap(int kind, int n) { return kind == 1 ? win_dst(n) : (kind == 2 ? ((n >> 7) * 256 + (n & 127)) : (kind == 3 ? ((n >> 7) * 256 + 128 + (n & 127)) : n)); }
__device__ __forceinline__ void tr_item(const float* W, int N, bf16_t* WT, int dld, int dcol, int kind, LAS float* scr, int kb, int nb, int lane) {
    const int k0 = 64 * kb, n0 = 32 * nb;
    const int nn = n0 + (lane & 31);
#pragma unroll
    for (int i = 0; i < 32; ++i) { const int kk = 2 * i + (lane >> 5); scr[kk * 33 + (lane & 31)] = (nn < N) ? W[(size_t)(k0 + kk) * N + nn] : 0.f; }
    asm volatile("s_waitcnt lgkmcnt(0)" ::: "memory");
    const int c = lane & 7;
#pragma unroll
    for (int j = 0; j < 4; ++j) { const int n = (lane >> 3) + 8 * j; const LAS float* s = scr + (8 * c) * 33 + n;
        if (n0 + n < N) {
            const int dr = rowmap(kind, n0 + n); const float sc = (kind == 1 && win_isq(dr)) ? C2 : 1.0f;
            u32x4 o; o.x = pk2(s[0 * 33] * sc, s[1 * 33] * sc); o.y = pk2(s[2 * 33] * sc, s[3 * 33] * sc); o.z = pk2(s[4 * 33] * sc, s[5 * 33] * sc); o.w = pk2(s[6 * 33] * sc, s[7 * 33] * sc);
            bf16_t* dp = (kind == 4) ? WT + ((size_t)((k0 + 8 * c) >> 4) * 256 + dr) * 16 + ((8 * c) & 15) : WT + (size_t)dr * dld + dcol + k0 + 8 * c;
            *(u32x4*)dp = o; } }
    asm volatile("s_waitcnt lgkmcnt(0)" ::: "memory");
}
struct CvtJob { const float* W; int K, N; bf16_t* WT; int dld, dcol, kind; };
__device__ __forceinline__ void convert_weights(Frame& F, const float* const* in) {
    LAS float* scr = (LAS float*)(F.lds + F.wave * 16384);
    const int gw = F.vcu * 8 + F.wave, NGW = F.G * 8;
    unsigned char* ws = F.ws;
    for (int g = gw; g < 2 * 10704; g += NGW) {
        const int l = g / 10704, r = g % 10704; int it; CvtJob J;
        if (r < 3024) { it = r; J.W = in[4] + (size_t)l * D_ * INC; J.K = D_; J.N = INC; J.WT = (bf16_t*)(ws + WS_WIN) + (size_t)l * NWIN * D_; J.dld = D_; J.dcol = 0; J.kind = 1; }
        else if (r < 3536) { const int br = (r < 3216) ? 0 : (r < 3344 ? 1 : 2); it = r - ((br == 0) ? 3024 : (br == 1 ? 3216 : 3344)); const int Kb = (br == 1) ? 256 : 384; const int kofs = (br == 0) ? 0 : (br == 1 ? 384 : 640);
            J.W = in[10 + br] + (size_t)l * Kb * D_; J.K = Kb; J.N = D_; J.WT = (bf16_t*)(ws + WS_WBR) + (size_t)l * D_ * D_; J.dld = D_; J.dcol = kofs; J.kind = 0; }
        else if (r < 4048) { it = r - 3536; J.W = in[13] + (size_t)l * D_ * D_; J.K = D_; J.N = D_; J.WT = (bf16_t*)(ws + WS_WOUT) + (size_t)l * D_ * D_; J.dld = D_; J.dcol = 0; J.kind = 0; }
        else if (r < 6096) { const int e = (r - 4048) >> 7; it = (r - 4048) & 127; J.W = in[18] + ((size_t)l * 16 + e) * D_ * 256; J.K = D_; J.N = 256; J.WT = (bf16_t*)(ws + WS_WGU) + ((size_t)l * 16 + e) * 512 * D_; J.dld = D_; J.dcol = 0; J.kind = 2; }
        else if (r < 8144) { const int e = (r - 6096) >> 7; it = (r - 6096) & 127; J.W = in[19] + ((size_t)l * 16 + e) * D_ * 256; J.K = D_; J.N = 256; J.WT = (bf16_t*)(ws + WS_WGU) + ((size_t)l * 16 + e) * 512 * D_; J.dld = D_; J.dcol = 0; J.kind = 3; }
        else if (r < 10192) { const int e = (r - 8144) >> 7; it = (r - 8144) & 127; J.W = in[20] + ((size_t)l * 16 + e) * 256 * D_; J.K = 256; J.N = D_; J.WT = (bf16_t*)(ws + WS_WD) + ((size_t)l * 16 + e) * D_ * 256; J.dld = 256; J.dcol = 0; J.kind = 0; }
        else { const int wh = (r - 10192) >> 8; it = (r - 10192) & 255; J.W = in[6] + ((size_t)l * 2 + wh) * 2048 * 256; J.K = 2048; J.N = 256; J.WT = (bf16_t*)(ws + WS_WC1) + ((size_t)l * 2 + wh) * 256 * 2048; J.dld = 2048; J.dcol = 0; J.kind = 4; }
        const int nnb = (J.N + 31) / 32;
        tr_item(J.W, J.N, J.WT, J.dld, J.dcol, J.kind, scr, it / nnb, it % nnb, F.lane);
    }
    const int gt = F.vcu * 512 + F.tid, NGT = F.G * 512;
    for (int i = gt; i < 2 * NWIN; i += NGT) { const int l = i / NWIN, p = i % NWIN; int c = -1;
        if (p < 1152) c = p; else if (p < 1792) c = p + 6; else if (p < 2944) c = p + 18; else if (p < 2950) c = 1152 + (p - 2944); else if (p < 2962) c = 1798 + (p - 2950); else if (p >= 3072) c = p - 110;
        ((float*)(ws + WS_BIAS))[i] = (c >= 0) ? in[5][l * INC + c] * (win_isq(p) ? C2 : 1.0f) : 0.f; }
    for (int i = gt; i < 2 * 110 * D_; i += NGT) { const int l = i / (110 * D_), r = (i % (110 * D_)) / D_, k = i % D_; ((bf16_t*)(ws + WS_WIN))[((size_t)l * NWIN + 2962 + r) * D_ + k] = 0; }
    for (int i = gt; i < 2 * 32 * 1024; i += NGT) { const int l = i >> 15, c = (i >> 10) & 31, k = i & 1023;
        const float w = (c < 4) ? in[14][((size_t)l * D_ + k) * 4 + c] : ((c < 20) ? in[16][((size_t)l * D_ + k) * 16 + (c - 4)] : 0.f);
        const unsigned hb = f2bf(w); const float lo = w - bf2f((unsigned short)hb);
        bf16_t* wrt = (bf16_t*)(ws + WS_WRT) + (size_t)l * 2 * 32 * 1024; wrt[c * 1024 + k] = (bf16_t)hb; wrt[32 * 1024 + c * 1024 + k] = (bf16_t)f2bf(lo); }
    for (int i = gt; i < 2 * 128 * 3072; i += NGT) { const int l = i / (128 * 3072), r = i % (128 * 3072), kb = r / 3072, n = r % 3072;
        const float* wp = in[4] + ((size_t)l * D_ + kb * 8) * INC + 2962 + n; float w8[8];
#pragma unroll
        for (int k = 0; k < 8; ++k) w8[k] = wp[(size_t)k * INC] * 64.0f;
        u32x2 o; o.x = pk4_fp8(w8[0], w8[1], w8[2], w8[3]); o.y = pk4_fp8(w8[4], w8[5], w8[6], w8[7]);
        *(u32x2*)(ws + WS_WG8 + ((size_t)l * 3072 + n) * 2048 + kb * 8) = o; }
    for (int it = gw; it < 4 * 4 * 8; it += NGW) {
        const int m = it >> 5, hg = (it >> 3) & 3, kc = it & 7, h = hg * 64 + F.lane;
        const float* w1 = in[6] + (size_t)m * 2048 * 256 + h; const float* pos = in[9] + (size_t)m * 2048;
        float a = 0.f;
#pragma unroll 16
        for (int k = kc * 256; k < kc * 256 + 256; ++k) a += pos[k] * w1[(size_t)k * 256];
        ((float*)(ws + WS_BC1P))[(m * 8 + kc) * 256 + h] = a;
    }
}
__device__ __forceinline__ void load_row(f32x4* v, u32x2* a, u32x2* b, const float* x, const bf16_t* d1, const bf16_t* d2, size_t m, int lane) {
    const f32x4* xr = (const f32x4*)(x + m * D_) + lane;
#pragma unroll
    for (int j = 0; j < 4; ++j) v[j] = xr[64 * j];
    if (d1) { const u32x2* p = (const u32x2*)(d1 + m * D_) + lane;
#pragma unroll
        for (int j = 0; j < 4; ++j) a[j] = p[64 * j]; }
    if (d2) { const u32x2* p = (const u32x2*)(d2 + m * D_) + lane;
#pragma unroll
        for (int j = 0; j < 4; ++j) b[j] = p[64 * j]; }
}
__device__ __forceinline__ f32x4 add_bf4(f32x4 v, u32x2 w) { v.x += __builtin_bit_cast(float, w.x << 16); v.y += __builtin_bit_cast(float, w.x & 0xffff0000u); v.z += __builtin_bit_cast(float, w.y << 16); v.w += __builtin_bit_cast(float, w.y & 0xffff0000u); return v; }
__device__ __forceinline__ void norm_rows(Frame& F, const float* x, const bf16_t* d1, const bf16_t* d2, float* xout, const float* g, bf16_t* out, unsigned char* out8) {
    const int gw = F.vcu * 8 + F.wave, NGW = F.G * 8;
    f32x4 gv[4];
#pragma unroll
    for (int j = 0; j < 4; ++j) gv[j] = ((const f32x4*)g)[F.lane + 64 * j];
    f32x4 vn[4]; u32x2 an[4], bn[4];
    if (gw < T_) load_row(vn, an, bn, x, d1, d2, (size_t)gw, F.lane);
    for (int m = gw; m < T_; m += NGW) {
        f32x4 v[4]; float s = 0.f;
#pragma unroll
        for (int j = 0; j < 4; ++j) { v[j] = vn[j]; if (d1) v[j] = add_bf4(v[j], an[j]); if (d2) v[j] = add_bf4(v[j], bn[j]); }
        if (m + NGW < T_) load_row(vn, an, bn, x, d1, d2, (size_t)(m + NGW), F.lane);
#pragma unroll
        for (int j = 0; j < 4; ++j) s += (v[j].x * v[j].x + v[j].y * v[j].y) + (v[j].z * v[j].z + v[j].w * v[j].w);
        const float r = 1.0f / sqrtf(wave_sum(s) * (1.0f / D_) + 1e-6f);
        if (xout) { f32x4* xo = (f32x4*)(xout + (size_t)m * D_) + F.lane;
#pragma unroll
            for (int j = 0; j < 4; ++j) xo[64 * j] = v[j]; }
        u32x2* o8 = (u32x2*)(out + (size_t)m * D_) + F.lane;
#pragma unroll
        for (int j = 0; j < 4; ++j) { u32x2 w; w.x = pk2(v[j].x * r * gv[j].x, v[j].y * r * gv[j].y); w.y = pk2(v[j].z * r * gv[j].z, v[j].w * r * gv[j].w); o8[64 * j] = w; }
        unsigned* q8 = (unsigned*)(out8 + (size_t)m * 2048) + F.lane;
#pragma unroll
        for (int j = 0; j < 4; ++j) q8[64 * j] = pk4_fp8(v[j].x * r * gv[j].x, v[j].y * r * gv[j].y, v[j].z * r * gv[j].z, v[j].w * r * gv[j].w);
    }
}
__device__ __forceinline__ void final_norm(Frame& F, const float* x, const bf16_t* d1, const bf16_t* d2, float* outp, const float* g) {
    const int gw = F.vcu * 8 + F.wave, NGW = F.G * 8;
    f32x4 gv[4];
#pragma unroll
    for (int j = 0; j < 4; ++j) gv[j] = ((const f32x4*)g)[F.lane + 64 * j];
    f32x4 vn[4]; u32x2 an[4], bn[4];
    if (gw < T_) load_row(vn, an, bn, x, d1, d2, (size_t)gw, F.lane);
    for (int m = gw; m < T_; m += NGW) {
        f32x4 v[4]; float s = 0.f;
#pragma unroll
        for (int j = 0; j < 4; ++j) { v[j] = add_bf4(add_bf4(vn[j], an[j]), bn[j]); }
        if (m + NGW < T_) load_row(vn, an, bn, x, d1, d2, (size_t)(m + NGW), F.lane);
#pragma unroll
        for (int j = 0; j < 4; ++j) s += (v[j].x * v[j].x + v[j].y * v[j].y) + (v[j].z * v[j].z + v[j].w * v[j].w);
        const float r = 1.0f / sqrtf(wave_sum(s) * (1.0f / D_) + 1e-6f);
        f32x4* xo = (f32x4*)(outp + (size_t)m * D_) + F.lane;
#pragma unroll
        for (int j = 0; j < 4; ++j) xo[64 * j] = v[j] * r * gv[j];
    }
}
__device__ __forceinline__ void norm2_route(Frame& F, const float* x, const bf16_t* d1, const float* g, bf16_t* out, const bf16_t* wrt, const float* bg, const float* be,
                                            unsigned* cnt, int* list, float* tokw) {
    constexpr int YLD = 1032;
    LAS bf16_t* yh = (LAS bf16_t*)F.lds; LAS bf16_t* yl = yh + 16 * YLD;
    LAS float* part = (LAS float*)(F.lds + 2 * 16 * YLD * 2);
    LAS float* lgt = part + 8 * 512;
    const int lane = F.lane, w = F.wave;
    bf16x8 bh[2][4], bl[2][4];
#pragma unroll
    for (int cb = 0; cb < 2; ++cb)
#pragma unroll
        for (int ks = 0; ks < 4; ++ks) { const size_t o = (size_t)(cb * 16 + (lane & 15)) * 1024 + 128 * w + 32 * ks + 8 * (lane >> 4);
            bh[cb][ks] = *(const bf16x8*)(wrt + o); bl[cb][ks] = *(const bf16x8*)(wrt + 32 * 1024 + o); }
    f32x4 gv[4];
#pragma unroll
    for (int j = 0; j < 4; ++j) gv[j] = ((const f32x4*)g)[lane + 64 * j];
    const int nblk = T_ / 16;
    f32x4 vn[2][4]; u32x2 an[2][4], bn_[4];
    { const int blk0 = F.vcu; if (blk0 < nblk) { load_row(vn[0], an[0], bn_, x, d1, nullptr, (size_t)blk0 * 16 + 2 * w, lane); load_row(vn[1], an[1], bn_, x, d1, nullptr, (size_t)blk0 * 16 + 2 * w + 1, lane); } }
    for (int blk = F.vcu; blk < nblk; blk += F.G) {
#pragma unroll
        for (int rr = 0; rr < 2; ++rr) {
            const int rl = 2 * w + rr; const size_t m = (size_t)blk * 16 + rl;
            f32x4 v[4]; float s = 0.f;
#pragma unroll
            for (int j = 0; j < 4; ++j) { v[j] = add_bf4(vn[rr][j], an[rr][j]); s += (v[j].x * v[j].x + v[j].y * v[j].y) + (v[j].z * v[j].z + v[j].w * v[j].w); }
            const float r = 1.0f / sqrtf(wave_sum(s) * (1.0f / D_) + 1e-6f);
            u32x2* o8 = (u32x2*)(out + m * D_) + lane;
#pragma unroll
            for (int j = 0; j < 4; ++j) { v[j] = v[j] * r * gv[j];
                const unsigned h0 = f2bf(v[j].x), h1 = f2bf(v[j].y), h2 = f2bf(v[j].z), h3 = f2bf(v[j].w);
                u32x2 hw; hw.x = h0 | (h1 << 16); hw.y = h2 | (h3 << 16); o8[64 * j] = hw;
                u32x2 lw; lw.x = pk2(v[j].x - bf2f((unsigned short)h0), v[j].y - bf2f((unsigned short)h1)); lw.y = pk2(v[j].z - bf2f((unsigned short)h2), v[j].w - bf2f((unsigned short)h3));
                *(LAS u32x2*)(yh + rl * YLD + 4 * lane + 256 * j) = hw; *(LAS u32x2*)(yl + rl * YLD + 4 * lane + 256 * j) = lw; }
        }
        { const int nb = blk + F.G; if (nb < nblk) { load_row(vn[0], an[0], bn_, x, d1, nullptr, (size_t)nb * 16 + 2 * w, lane); load_row(vn[1], an[1], bn_, x, d1, nullptr, (size_t)nb * 16 + 2 * w + 1, lane); } }
        __syncthreads();
        f32x4 acc0 = (f32x4){0.f, 0.f, 0.f, 0.f}, acc1 = acc0;
#pragma unroll
        for (int ks = 0; ks < 4; ++ks) {
            const int ko = (lane & 15) * YLD + 128 * w + 32 * ks + 8 * (lane >> 4);
            const bf16x8 ah = *(const LAS bf16x8*)(yh + ko), al = *(const LAS bf16x8*)(yl + ko);
            acc0 = __builtin_amdgcn_mfma_f32_16x16x32_bf16(ah, bh[0][ks], acc0, 0, 0, 0); acc0 = __builtin_amdgcn_mfma_f32_16x16x32_bf16(ah, bl[0][ks], acc0, 0, 0, 0); acc0 = __builtin_amdgcn_mfma_f32_16x16x32_bf16(al, bh[0][ks], acc0, 0, 0, 0);
            acc1 = __builtin_amdgcn_mfma_f32_16x16x32_bf16(ah, bh[1][ks], acc1, 0, 0, 0); acc1 = __builtin_amdgcn_mfma_f32_16x16x32_bf16(ah, bl[1][ks], acc1, 0, 0, 0); acc1 = __builtin_amdgcn_mfma_f32_16x16x32_bf16(al, bh[1][ks], acc1, 0, 0, 0);
        }
#pragma unroll
        for (int i = 0; i < 4; ++i) { part[w * 512 + (4 * (lane >> 4) + i) * 32 + (lane & 15)] = acc0[i]; part[w * 512 + (4 * (lane >> 4) + i) * 32 + 16 + (lane & 15)] = acc1[i]; }
        __syncthreads();
        { const int t = F.tid; float sacc = 0.f;
#pragma unroll
            for (int q = 0; q < 8; ++q) sacc += part[q * 512 + t];
            const int c = t & 31; lgt[t] = sacc + ((c < 4) ? bg[c & 3] : ((c < 20) ? be[(c - 4) & 15] : 0.f)); }
        __syncthreads();
        if (F.tid < 16) {
            const int rl = F.tid; const size_t m = (size_t)blk * 16 + rl;
            const f32x4 lgg = *(const LAS f32x4*)(lgt + rl * 32), le0 = *(const LAS f32x4*)(lgt + rl * 32 + 4), le1 = *(const LAS f32x4*)(lgt + rl * 32 + 8), le2 = *(const LAS f32x4*)(lgt + rl * 32 + 12), le3 = *(const LAS f32x4*)(lgt + rl * 32 + 16);
            int gi = 0; float mg = lgg[0];
#pragma unroll
            for (int c = 1; c < 4; ++c) if (lgg[c] > mg) { mg = lgg[c]; gi = c; }
            float sg = 0.f;
#pragma unroll
            for (int c = 0; c < 4; ++c) sg += expf(lgg[c] - mg);
            const float gp = 1.0f / sg;
            const f32x4 l4 = (gi == 0) ? le0 : ((gi == 1) ? le1 : ((gi == 2) ? le2 : le3));
            int a1 = 0; float va = l4[0];
#pragma unroll
            for (int c = 1; c < 4; ++c) if (l4[c] > va) { va = l4[c]; a1 = c; }
            int b1 = -1; float vb = 0.f;
#pragma unroll
            for (int c = 0; c < 4; ++c) if (c != a1 && (b1 < 0 || l4[c] > vb)) { vb = l4[c]; b1 = c; }
            const float eb = expf(vb - va), w_hi = gp / (1.0f + eb), w_lo = gp * eb / (1.0f + eb);
            const int ea = a1 < b1 ? a1 : b1, ebx = a1 < b1 ? b1 : a1;
            const int pidx = (ea == 0) ? (ebx - 1) : (ea == 1 ? ebx + 1 : 5);
            const float wa = (a1 < b1) ? w_hi : w_lo, wb = (a1 < b1) ? w_lo : w_hi;
            const int bucket = gi * 6 + pidx;
            const unsigned pos = __hip_atomic_fetch_add(cnt + bucket * 64, 1u, RLX_AGENT);
            list[(size_t)bucket * T_ + pos] = (int)m; tokw[m * 2] = wa; tokw[m * 2 + 1] = wb;
        }
    }
    __syncthreads();
}
__device__ __forceinline__ float logsig(float x) { return fminf(x, 0.f) - log1pf(expf(-fabsf(x))); }
template <int CTRL> __device__ __forceinline__ float dppf(float v) { return __builtin_bit_cast(float, __builtin_amdgcn_update_dpp(0, __builtin_bit_cast(int, v), CTRL, 0xf, 0xf, true)); }
__device__ __forceinline__ float sumsq8(u32x4 v) {
    const float a0 = __builtin_bit_cast(float, v.x << 16), a1 = __builtin_bit_cast(float, v.x & 0xffff0000u), a2 = __builtin_bit_cast(float, v.y << 16), a3 = __builtin_bit_cast(float, v.y & 0xffff0000u);
    const float a4 = __builtin_bit_cast(float, v.z << 16), a5 = __builtin_bit_cast(float, v.z & 0xffff0000u), a6 = __builtin_bit_cast(float, v.w << 16), a7 = __builtin_bit_cast(float, v.w & 0xffff0000u);
    return (a0 * a0 + a1 * a1) + (a2 * a2 + a3 * a3) + (a4 * a4 + a5 * a5) + (a6 * a6 + a7 * a7); }
__device__ __forceinline__ float sum8lanes(float s) { s += dppf<0xB1>(s); s += dppf<0x4E>(s); s += dppf<0x141>(s); return s; }
__device__ __forceinline__ void knorm_commit(Frame& F, float mx, gu32* dst) {
#pragma unroll
    for (int o = 8; o < 64; o <<= 1) mx = fmaxf(mx, __shfl_xor(mx, o));
    if (F.lane == 0) __hip_atomic_fetch_max(dst, __float_as_uint(sqrtf(mx)), RLX_AGENT);
}
__device__ __forceinline__ void knorm_max(Frame& F, const bf16_t* P, int b, int col, gu32* dst) {
    float mx = 0.f; const int rg = F.lane >> 3, ch = F.lane & 7;
#pragma unroll 16
    for (int i = 0; i < 64; ++i) { const u32x4 v = *(const u32x4*)(P + (size_t)(b * S_ + (F.wave * 64 + i) * 8 + rg) * PP + col + ch * 8);
        mx = fmaxf(mx, sum8lanes(sumsq8(v))); }
    knorm_commit(F, mx, dst);
}
__device__ __forceinline__ void fox_cumsum_unit(Frame& F, const bf16_t* P, float* FB, int b, int h) {
    LAS float* tot = (LAS float*)F.lds;
    float v[8]; float run = 0.f;
#pragma unroll
    for (int i = 0; i < 8; ++i) { const int t = F.tid * 8 + i; run += logsig(bf2f(P[(size_t)(b * S_ + t) * PP + PC_FF + h])); v[i] = run; }
    float sc = run;
#pragma unroll
    for (int o = 1; o < 64; o <<= 1) { const float u = __shfl_up(sc, o); if (F.lane >= o) sc += u; }
    if (F.lane == 63) tot[F.wave] = sc;
    __syncthreads();
    float base = sc - run;
    for (int w = 0; w < F.wave; ++w) base += tot[w];
#pragma unroll
    for (int i = 0; i < 8; ++i) FB[(size_t)(b * 6 + h) * S_ + F.tid * 8 + i] = -(base + v[i]) * LOG2E;
    __syncthreads();
}
__device__ __forceinline__ void kmean_unit(Frame& F, const bf16_t* P, float* KMEAN, int b, int h, gu32* dst) {
    float mx = 0.f;
    for (int blk = F.wave * 2; blk < F.wave * 2 + 2; ++blk) {
        const int rg = F.lane >> 3, ch = F.lane & 7; float s8[8];
#pragma unroll
        for (int k = 0; k < 8; ++k) s8[k] = 0.f;
#pragma unroll 16
        for (int i = 0; i < 32; ++i) { const u32x4 v = *(const u32x4*)(P + (size_t)(b * S_ + blk * 256 + i * 8 + rg) * PP + PC_MK + h * 64 + ch * 8);
            mx = fmaxf(mx, sum8lanes(sumsq8(v)));
            s8[0] += __builtin_bit_cast(float, v.x << 16); s8[1] += __builtin_bit_cast(float, v.x & 0xffff0000u); s8[2] += __builtin_bit_cast(float, v.y << 16); s8[3] += __builtin_bit_cast(float, v.y & 0xffff0000u);
            s8[4] += __builtin_bit_cast(float, v.z << 16); s8[5] += __builtin_bit_cast(float, v.z & 0xffff0000u); s8[6] += __builtin_bit_cast(float, v.w << 16); s8[7] += __builtin_bit_cast(float, v.w & 0xffff0000u); }
#pragma unroll
        for (int k = 0; k < 8; ++k) { s8[k] += __shfl_xor(s8[k], 8); s8[k] += __shfl_xor(s8[k], 16); s8[k] += __shfl_xor(s8[k], 32); }
        if (rg == 0) { float* kp = KMEAN + ((size_t)(b * 6 + h) * 16 + blk) * 64 + ch * 8;
            *(f32x4*)kp = (f32x4){s8[0], s8[1], s8[2], s8[3]} * (1.0f / 256.0f); *(f32x4*)(kp + 4) = (f32x4){s8[4], s8[5], s8[6], s8[7]} * (1.0f / 256.0f); }
    }
    knorm_commit(F, mx, dst);
}
__device__ __forceinline__ void cmp_unit(Frame& F, const bf16_t* P, const bf16_t* WC1, const float* BC1P, const float* B1, const float* W2, bf16_t* KCMP, int b, int which, int ntile) {
    const int lane = F.lane, r32 = lane & 31, hi = lane >> 5, wid = F.wave;
    {
        const unsigned lbase = (unsigned)(uintptr_t)F.lds; const int rl = lane >> 3, ch = lane & 7;
        for (int g = wid; g < 66; g += 8) { const int row0 = g * 8; int row = ntile * 512 + row0 + rl; row = row < S_ ? row : S_ - 1;
            att::glds16(P + (size_t)(b * S_ + row) * PP + (which ? PC_VC : PC_KC) + ch * 8, (unsigned)__builtin_amdgcn_readfirstlane(lbase + row0 * 128 + (row0 >> 4) * 16)); }
    }
    float bias = B1[wid * 32 + r32];
#pragma unroll
    for (int kc = 0; kc < 8; ++kc) bias += BC1P[kc * 256 + wid * 32 + r32];
    asm volatile("s_waitcnt vmcnt(0)" ::: "memory");
    __syncthreads();
    f32x4 w2r[8];
#pragma unroll
    for (int i = 0; i < 8; ++i) w2r[i] = ((const f32x4*)W2)[F.tid + 512 * i];
    const LAS char* ap = (const LAS char*)F.lds + r32 * 2064 + hi * 16;
    const bf16_t* bp = WC1 + (size_t)(wid * 32 + r32) * 16 + hi * 8;
    f32x16 acc = f32x16{};
#pragma unroll 16
    for (int kk = 0; kk < 128; ++kk) {
        const bf16x8 a = *(const LAS bf16x8*)(ap + kk * 32 + (kk >> 6) * 16);
        const bf16x8 bb = *(const bf16x8*)(bp + (size_t)kk * 4096);
        acc = __builtin_amdgcn_mfma_f32_32x32x16_bf16(a, bb, acc, 0, 0, 0);
    }
    LAS float* w2s = (LAS float*)F.lds;
    LAS float* hs = (LAS float*)(F.lds + 69632);
#pragma unroll
    for (int r = 0; r < 16; ++r) { const float a = acc[r] + bias; const float z = 0.7978845608028654f * (a + 0.044715f * a * a * a);
        hs[att::crow(r, hi) * 260 + wid * 32 + r32] = a * fast_sigmoid(2.0f * z); }
    __syncthreads();
#pragma unroll
    for (int i = 0; i < 8; ++i) ((LAS f32x4*)w2s)[F.tid + 512 * i] = w2r[i];
    __syncthreads();
    const int nl = F.tid >> 4, d4 = (F.tid & 15) * 4;
    f32x4 o = (f32x4){0.f, 0.f, 0.f, 0.f};
#pragma unroll 16
    for (int hd = 0; hd < 256; ++hd) { const f32x4 w = *(const LAS f32x4*)(w2s + hd * 64 + d4); o += hs[nl * 260 + hd] * w; }
    const int no = ntile * 32 + nl;
    u32x2 w2; w2.x = (no < 255) ? pk2(o[0], o[1]) : 0u; w2.y = (no < 255) ? pk2(o[2], o[3]) : 0u;
    *(u32x2*)(KCMP + ((size_t)(b * 2 + which) * 256 + no) * 64 + d4) = w2;
    __syncthreads();
}

struct Args { const float* in[21]; float* out; unsigned char* ws; int ph_lo, ph_hi; };
constexpr int NPH = 19;


__device__ __forceinline__ LAS unsigned char* opaque_lds(LAS unsigned char* p) { unsigned v = (unsigned)(uintptr_t)p; asm volatile("" : "+s"(v)); return (LAS unsigned char*)(uintptr_t)v; }
#ifndef PROBE_DUP
#define PROBE_DUP -1
#endif
#define NREP(k) ((PROBE_DUP == (k)) ? 2 : 1)
#define IN(k) (lo <= (k) && (k) < hi)
#define SEAM(k) do { if (IN(k) && IN((k) + 1)) { XcdBarrier bar_; bar_.bar = (unsigned*)((gu32*)(args.ws + WS_CTL) + CW_BAR); bar_.x = xb_xcc_id(); bar_.st = (volatile LAS unsigned*)((LAS unsigned char*)lds + MISC_OFF) + 8; xcd_barrier(bar_); } } while (0)
#define PHASE_ENTRY() const int t_ = opaque_tid(); F.tid = t_; F.lane = t_ & 63; F.wave = __builtin_amdgcn_readfirstlane(t_ >> 6); F.lds = opaque_lds((LAS unsigned char*)lds); \
    unsigned zofs_; asm volatile("s_mov_b32 %0, 0" : "=s"(zofs_)); \
    unsigned char* ws = args.ws + zofs_; F.ws = ws; F.ctl = (gu32*)(ws + WS_CTL); \
    bf16_t* H = (bf16_t*)(ws + WS_H); bf16_t* P = (bf16_t*)(ws + WS_P); bf16_t* O = (bf16_t*)(ws + WS_O); (void)H; (void)P; (void)O
template <int l>
__device__ __forceinline__ void layer_body(Frame& F, const Args& args, const int lo, const int hi) {
    extern __shared__ __attribute__((aligned(16))) unsigned char lds[];
    const float* const* in = args.in; float* X = args.out;
    const int p0 = l * 9;
        const float* xin = (l == 0) ? in[0] : X;
        if (IN(p0 + 0)) {
            PHASE_ENTRY();
            for (int rep = 0; rep < NREP(0); ++rep) {
            if (l == 0) { convert_weights(F, in); }
            norm_rows(F, (l == 0) ? in[0] : in[0], (l == 0) ? nullptr : (const bf16_t*)(ws + WS_D1), (l == 0) ? nullptr : (const bf16_t*)(ws + WS_D2), (l == 0) ? nullptr : X, in[1] + l * D_, H, ws + WS_H8);
            }
        }
        SEAM(p0 + 0);
        if (IN(p0 + 1)) {
            PHASE_ENTRY();
            for (int rep = 0; rep < NREP(1); ++rep) {
            PolInProj pol; pol.A = (const char*)H; pol.B = (const char*)(ws + WS_WIN) + (size_t)l * NWIN * D_ * 2; pol.lda2 = 2048; pol.ldb2 = 2048; pol.kA = 128; pol.nt = 16;
            pol.ord.init(T_, PP, F.G, (int)blockIdx.x); pol.P = P; pol.bias = (const float*)(ws + WS_BIAS) + l * NWIN;
            pg8::gemm_stream(F.lds, pol);
            }
        }
        SEAM(p0 + 1);
        if (IN(p0 + 2)) {
            PHASE_ENTRY();
            for (int rep = 0; rep < NREP(2); ++rep) {
            for (int u = F.vcu; u < 224; u += F.G) {
                if (u < 128) { const int b = u >> 4, which = (u >> 3) & 1, nt = u & 7;
                    cmp_unit(F, P, (const bf16_t*)(ws + WS_WC1) + ((size_t)l * 2 + which) * 256 * 2048, (const float*)(ws + WS_BC1P) + (size_t)(l * 2 + which) * 8 * 256, in[7] + (l * 2 + which) * 256,
                             in[8] + ((size_t)l * 2 + which) * 256 * 64, (bf16_t*)(ws + WS_KCMP), b, which, nt); }
                else if (u < 176) { const int k = u - 128; fox_cumsum_unit(F, P, (float*)(ws + WS_FB), k / 6, k % 6); knorm_max(F, P, k / 6, PC_FK + (k % 6) * 64, F.ctl + CW_KN + l * 128 + k); }
                else { const int k = u - 176; kmean_unit(F, P, (float*)(ws + WS_KMEAN), k / 6, k % 6, F.ctl + CW_KN + l * 128 + 48 + k); }
            }
            }
        }
        SEAM(p0 + 2);
        if (IN(p0 + 3)) {
            PHASE_ENTRY();
            for (int rep = 0; rep < NREP(3); ++rep) {
            LAS char* shm = (LAS char*)F.lds;
            for (;;) {
                if (F.tid == 0) F.MISC[0] = __hip_atomic_fetch_add(F.ctl + CW_Q + (l * 2 + rep) * 64, 1u, RLX_AGENT);
                __syncthreads();
                const int u = (int)F.MISC[0];
                __syncthreads();
                if (u >= 2048) break;
                const int s = 15 - (u >> 7), k = u & 127;
#ifdef PROBE_ATT_MASK
                if (rep == 1 && !((PROBE_ATT_MASK >> (k < 48 ? 0 : (k < 96 ? 1 : 2))) & 1)) continue;
#endif
                if (k < 48) att::fox_unit(shm, P, (const float*)(ws + WS_FB), O, k / 6, k % 6, s, __uint_as_float(__hip_atomic_load(F.ctl + CW_KN + l * 128 + k, RLX_AGENT)));
                else if (k < 96) att::moba_unit(shm, P, (const float*)(ws + WS_KMEAN), O, (k - 48) / 6, (k - 48) % 6, s, __uint_as_float(__hip_atomic_load(F.ctl + CW_KN + l * 128 + k, RLX_AGENT)));
                else { const int j = k - 96; att::nsa_unit(shm, P, (const bf16_t*)(ws + WS_KCMP), O, j >> 2, 4 * s + (j & 3)); }
            }
            }
        }
        SEAM(p0 + 3);
        if (IN(p0 + 4)) {
            PHASE_ENTRY();
            for (int rep = 0; rep < NREP(4); ++rep) {
            PolMerge pol; pol.O = (const char*)O; pol.H8 = (const char*)(ws + WS_H8); pol.WBR = (const char*)(ws + WS_WBR) + (size_t)l * D_ * D_ * 2;
            pol.WG8 = (const char*)(ws + WS_WG8) + (size_t)l * 3072 * 2048; pol.lda2 = 2048; pol.ldb2 = 2048; pol.kA = 128; pol.vcu = F.vcu; pol.G = F.G;
            pol.merged = (bf16_t*)(ws + WS_MERGED); pol.biasg = (const float*)(ws + WS_BIAS) + l * NWIN + 3072;
            pol.ys = (char*)(ws + WS_YSCR) + (size_t)blockIdx.x * 131072; pol.ps = (char*)(ws + WS_PSCR) + (size_t)blockIdx.x * 131072; pol.zero = (const char*)(ws + WS_CTL + 256 * 1024);
            pg8::gemm_stream(F.lds, pol);
            }
        }
        SEAM(p0 + 4);
        if (IN(p0 + 5)) {
            PHASE_ENTRY();
            for (int rep = 0; rep < NREP(5); ++rep) {
            PolOutProj pol; pol.A = (const char*)(ws + WS_MERGED); pol.B = (const char*)(ws + WS_WOUT) + (size_t)l * D_ * D_ * 2; pol.lda2 = 2048; pol.ldb2 = 2048; pol.kA = 128; pol.nt = 16;
            pol.ord.init(T_, D_, F.G, (int)blockIdx.x); pol.d1 = (bf16_t*)(ws + WS_D1);
            pg8::gemm_stream(F.lds, pol);
            }
        }
        SEAM(p0 + 5);
        if (IN(p0 + 6)) {
            PHASE_ENTRY();
            for (int rep = 0; rep < NREP(6); ++rep) {
            norm2_route(F, xin, (const bf16_t*)(ws + WS_D1), in[2] + l * D_, H, (const bf16_t*)(ws + WS_WRT) + (size_t)l * 2 * 32 * 1024, in[15] + l * 4, in[17] + l * 16, (unsigned*)(F.ctl + CW_CNT + (l + 2 * rep) * 24 * 64), (int*)(ws + WS_LIST + rep * 8 * MiB), (float*)(ws + WS_TOKW + rep * 20 * MiB));
            }
        }
        SEAM(p0 + 6);
        if (IN(p0 + 7)) {
            PHASE_ENTRY();
            for (int rep = 0; rep < NREP(7); ++rep) {
            if (F.tid < 24) F.MISC[32 + F.tid] = __hip_atomic_load(F.ctl + CW_CNT + (l * 24 + F.tid) * 64, RLX_AGENT);
            __syncthreads();
            PolMoeUp pol; pol.H = (const char*)H; pol.WGU = (const char*)(ws + WS_WGU) + (size_t)l * 16 * 512 * D_ * 2; pol.lda2 = 2048; pol.ldb2 = 2048; pol.kA = 128; pol.c = (int)blockIdx.x; pol.G = F.G;
            pol.cnt = (const LAS unsigned*)(F.lds + MISC_OFF) + 32; pol.list = (const int*)(ws + WS_LIST); pol.tokw = (const float*)(ws + WS_TOKW); pol.hid = (bf16_t*)(ws + WS_HID);
            pg8::gemm_stream(F.lds, pol);
            }
        }
        SEAM(p0 + 7);
        if (IN(p0 + 8)) {
            PHASE_ENTRY();
            for (int rep = 0; rep < NREP(8); ++rep) {
            if (F.tid < 24) F.MISC[32 + F.tid] = __hip_atomic_load(F.ctl + CW_CNT + (l * 24 + F.tid) * 64, RLX_AGENT);
            __syncthreads();
            PolMoeDown pol; pol.HID = (const char*)(ws + WS_HID); pol.WD = (const char*)(ws + WS_WD) + (size_t)l * 16 * D_ * 256 * 2; pol.lda2 = 1024; pol.ldb2 = 512; pol.kA = 128; pol.c = (int)blockIdx.x; pol.G = F.G;
            pol.cnt = (const LAS unsigned*)(F.lds + MISC_OFF) + 32; pol.list = (const int*)(ws + WS_LIST); pol.d2 = (bf16_t*)(ws + WS_D2);
            pg8::gemm_stream(F.lds, pol);
            }
        }
        SEAM(p0 + 8);
    }
__global__ void __launch_bounds__(512, 2) mega(Args args) {
    extern __shared__ __attribute__((aligned(16))) unsigned char lds[];
    Frame F;
    F.lds = (LAS unsigned char*)lds; F.MISC = (volatile LAS unsigned*)(F.lds + MISC_OFF);
    F.tid = threadIdx.x; F.lane = F.tid & 63; F.wave = __builtin_amdgcn_readfirstlane(F.tid >> 6);
    F.G = gridDim.x; { const int bx = blockIdx.x; F.vcu = (F.G % 8 == 0) ? (bx % 8) * (F.G / 8) + bx / 8 : bx; }
    F.ws = args.ws; F.ctl = (gu32*)(args.ws + WS_CTL);
    for (int u = F.tid; u < (LDS_BYTES - MISC_OFF) / 4; u += 512) ((LAS unsigned*)(F.lds + MISC_OFF))[u] = 0u;
    __syncthreads();
    if (F.lane == 0) F.MISC[64 + hw_slot()] = (unsigned)F.wave;
    __syncthreads();
    const int lo = args.ph_lo, hi = args.ph_hi;
    if (hi - lo > 1) (void)xcd_barrier_post((unsigned*)(F.ctl + CW_BAR), F.MISC + 8);
    const float* const* in = args.in;
    float* X = args.out;
    layer_body<0>(F, args, lo, hi);
    layer_body<1>(F, args, lo, hi);
    if (IN(18)) { PHASE_ENTRY(); final_norm(F, X, (const bf16_t*)(ws + WS_D1), (const bf16_t*)(ws + WS_D2), X, in[3]); }
#undef IN
#undef SEAM
}

#ifndef MK_PER_PHASE
#define MK_PER_PHASE 0
#endif
extern "C" void kernel_launch(void* const* d_in, const int* in_sizes, int n_in, void* d_out, int out_size, void* d_ws, size_t ws_size, hipStream_t stream) {
    static int grid = 0;
    if (grid == 0) {
        if (n_in != 21 || out_size != T_ * D_ || ws_size < WS_END2) { fprintf(stderr, "kernel_launch: unexpected shapes (n_in %d out %d ws %zu)\n", n_in, out_size, ws_size); grid = -1; return; }
        int dev = 0, cus = 0;
        if (hipGetDevice(&dev) != hipSuccess || hipDeviceGetAttribute(&cus, hipDeviceAttributeMultiprocessorCount, dev) != hipSuccess) { grid = -1; return; }
        if (hipFuncSetAttribute((const void*)mega, hipFuncAttributeMaxDynamicSharedMemorySize, LDS_BYTES) != hipSuccess) { fprintf(stderr, "kernel_launch: hipFuncSetAttribute failed\n"); grid = -1; return; }
        int per_cu = 0;
        if (hipOccupancyMaxActiveBlocksPerMultiprocessor(&per_cu, (const void*)mega, 512, LDS_BYTES) != hipSuccess || per_cu < 1) fprintf(stderr, "kernel_launch: occupancy query says %d\n", per_cu);
        (void)hipGetLastError();
        grid = cus;
    }
    if (grid < 0) return;
    (void)hipMemsetAsync((char*)d_ws + WS_CTL, 0, CTL_ZERO_BYTES, stream);
    Args a{};
    for (int i = 0; i < 21; ++i) a.in[i] = (const float*)d_in[i];
    a.out = (float*)d_out; a.ws = (unsigned char*)d_ws;
#if MK_PER_PHASE
    for (int p = 0; p < NPH; ++p) { a.ph_lo = p; a.ph_hi = p + 1; hipLaunchKernelGGL(mega, dim3(grid), dim3(512), LDS_BYTES, stream, a); }
#else
    a.ph_lo = 0; a.ph_hi = NPH;
    hipLaunchKernelGGL(mega, dim3(grid), dim3(512), LDS_BYTES, stream, a);
#endif
}
```

```cpp
#include <hip/hip_runtime.h>
#include <stdint.h>
#include <math.h>
#include <stdio.h>

#define LAS __attribute__((address_space(3)))
#define GAS __attribute__((address_space(1)))
typedef unsigned short bf16_t;
typedef short bf16x8 __attribute__((ext_vector_type(8)));
typedef short s16x4 __attribute__((ext_vector_type(4)));
typedef float f32x2 __attribute__((ext_vector_type(2)));
typedef float f32x4 __attribute__((ext_vector_type(4)));
typedef float f32x16 __attribute__((ext_vector_type(16)));
typedef unsigned u32x2 __attribute__((ext_vector_type(2)));
typedef unsigned u32x4 __attribute__((ext_vector_type(4)));
typedef GAS unsigned gu32;

constexpr int NB = 8, S_ = 4096, T_ = NB * S_, D_ = 1024, PP = 3072, INC = 6034, NWIN = 6144;
constexpr int PC_FQ = 0, PC_FK = 384, PC_FV = 768, PC_NQ = 1152, PC_KC = 1408, PC_VC = 1472, PC_KS = 1536, PC_VS = 1600, PC_KW = 1664, PC_VW = 1728,
              PC_MQ = 1792, PC_MK = 2176, PC_MV = 2560, PC_FF = 2944, PC_NG = 2950;
constexpr float LOG2E = 1.4426950408889634f;
constexpr float C2 = 0.125f * LOG2E;
constexpr float THR = 6.0f;

constexpr size_t MiB = 1u << 20;
constexpr size_t WS_CTL = 0, CTL_ZERO_BYTES = 1 * MiB;
constexpr size_t WS_WIN = 2 * MiB;
constexpr size_t WS_WBR = 26 * MiB;
constexpr size_t WS_WOUT = 30 * MiB;
constexpr size_t WS_WGU = 34 * MiB;
constexpr size_t WS_WD = 66 * MiB;
constexpr size_t WS_WC1 = 82 * MiB;
constexpr size_t WS_BIAS = 86 * MiB;
constexpr size_t WS_WRT = 87 * MiB + 512 * 1024;
constexpr size_t WS_BC1P = 87 * MiB;
constexpr size_t WS_W2T = 87 * MiB + 768 * 1024;
constexpr size_t WS_H = 88 * MiB;
constexpr size_t WS_P = 152 * MiB;
constexpr size_t WS_O = 344 * MiB;
constexpr size_t WS_FB = 408 * MiB;
constexpr size_t WS_KCMP = 409 * MiB;
constexpr size_t WS_KMEAN = 410 * MiB;
constexpr size_t WS_TOKW = 411 * MiB;
constexpr size_t WS_LIST = 412 * MiB;
constexpr size_t WS_MERGED = WS_P;
constexpr size_t WS_YSCR = WS_P + 64 * MiB;
constexpr size_t WS_PSCR = WS_P + 96 * MiB;
constexpr size_t WS_HID = WS_P + 160 * MiB;
constexpr size_t WS_D1 = WS_P + 64 * MiB;
constexpr size_t WS_D2 = WS_P;
constexpr size_t WS_END = 416 * MiB;
constexpr size_t WS_H8 = 416 * MiB;
constexpr size_t WS_WG8 = 480 * MiB;
constexpr size_t WS_END2 = 492 * MiB;
constexpr int CW_TMO = 0, CW_BAR = 4096, CW_Q = 8192, CW_CNT = 8448, CW_KN = 16384;
constexpr size_t CTL_KMEAN = 512 * 1024;

constexpr int LDS_BYTES = 147456;
constexpr int MISC_OFF = 146944;
constexpr int SLOTB = 8192, NSLOT = 4, L_K = 0, L_V = NSLOT * SLOTB, L_WSF = 2 * NSLOT * SLOTB, L_OST = 0  , L_AUX = L_WSF + 4096;
constexpr int L_IMP = L_AUX, IMP_LD = 260, L_SELM = L_IMP + 64 * IMP_LD * 4, L_UNION = L_SELM + 1024, L_VOTE = L_UNION + 64;
static_assert(L_VOTE + 256 <= MISC_OFF, "lds");

#define RLX_AGENT __ATOMIC_RELAXED, __HIP_MEMORY_SCOPE_AGENT
__device__ __forceinline__ unsigned f2bf(float f) { unsigned u = __builtin_bit_cast(unsigned, f); return (u + 0x7fffu + ((u >> 16) & 1u)) >> 16; }
__device__ __forceinline__ unsigned pk2(float lo, float hi) { return f2bf(lo) | (f2bf(hi) << 16); }
__device__ __forceinline__ float bf2f(unsigned short v) { return __builtin_bit_cast(float, (unsigned)v << 16); }
__device__ __forceinline__ unsigned cvt_pk_bf16(float lo, float hi) { unsigned r; asm volatile("v_cvt_pk_bf16_f32 %0, %1, %2" : "=v"(r) : "v"(lo), "v"(hi)); return r; }
__device__ __forceinline__ unsigned hw_slot() { return (unsigned)__builtin_amdgcn_s_getreg((5 << 11) | (0 << 6) | 4) & 63u; }
__device__ __forceinline__ int opaque_tid() { extern __shared__ __attribute__((aligned(16))) unsigned char lds_ot[];
    const unsigned w = ((volatile LAS unsigned*)((LAS unsigned char*)lds_ot + MISC_OFF))[64 + hw_slot()];
    int t = (int)(w * 64u + __builtin_amdgcn_mbcnt_hi(~0u, __builtin_amdgcn_mbcnt_lo(~0u, 0u))); asm volatile("" : "+v"(t)); return t; }
__device__ __forceinline__ float fast_sigmoid(float x) { return __builtin_amdgcn_rcpf(1.0f + __builtin_amdgcn_exp2f(-x * LOG2E)); }

#define XB_TMO      128
#define XB_XCNT(j)  (256  + 64 * (j))
#define XB_XSUB(j)  (1280 + 64 * (j))
#define XB_XGEN(j)  (2304 + 64 * (j))
#define XB_TOP      3328
#define XB_TOPGEN   3392
#define XCD_BAR_WORDS 3456
#define XB_SPIN_CAP (1u << 20)
__device__ __forceinline__ unsigned xb_ld(unsigned* p)              { return __hip_atomic_load(p, __ATOMIC_RELAXED, __HIP_MEMORY_SCOPE_AGENT); }
__device__ __forceinline__ unsigned xb_add(unsigned* p, unsigned v) { return __hip_atomic_fetch_add(p, v, __ATOMIC_RELAXED, __HIP_MEMORY_SCOPE_AGENT); }
__device__ __forceinline__ unsigned xb_xcc_id() { return (unsigned)__builtin_amdgcn_s_getreg((3 << 11) | 20) & 0xFu; }
#define XB_SPIN(cond, bar) do { unsigned _sp = 0; while (cond) { __builtin_amdgcn_s_sleep(1); \
    if ((++_sp & 255u) == 0u) { if (xb_ld(&(bar)[XB_TMO])) break; if (_sp > XB_SPIN_CAP) { atomicAdd(&(bar)[XB_TMO], 1u); break; } } } } while (0)
struct XcdBarrier { unsigned* bar; unsigned x; volatile LAS unsigned* st; };
__device__ __forceinline__ XcdBarrier xcd_barrier_post(unsigned* bar, volatile LAS unsigned* st) {
    XcdBarrier b; b.bar = bar; b.x = xb_xcc_id(); b.st = st;
    if (threadIdx.x == 0) (void)xb_add(&bar[XB_XCNT(b.x)], 1u);
    return b;
}
__device__ __forceinline__ void xcd_barrier_complete(unsigned* bar, unsigned x, unsigned& nloc, unsigned& nx) {
    const unsigned G = gridDim.x * gridDim.y * gridDim.z;
    unsigned sum, cnt, mine, sp = 0u;
    for (;;) {
        sum = 0u; cnt = 0u; mine = 0u;
#pragma unroll
        for (unsigned j = 0; j < 16; ++j) { const unsigned c = xb_ld(&bar[XB_XCNT(j)]); sum += c; cnt += (c > 0u) ? 1u : 0u; mine = (j == x) ? c : mine; }
        if (sum == G) break;
        __builtin_amdgcn_s_sleep(1);
        if ((++sp & 255u) == 0u) { if (xb_ld(&bar[XB_TMO])) break; if (sp > XB_SPIN_CAP) { atomicAdd(&bar[XB_TMO], 1u); break; } }
    }
    nloc = mine > 0u ? mine : 1u; nx = cnt > 0u ? cnt : 1u;
}
__device__ __forceinline__ void xcd_barrier(const XcdBarrier& b) {
    asm volatile("s_waitcnt vmcnt(0)" ::: "memory");
    __syncthreads();
    if (opaque_tid() == 0) {
        unsigned* bar = b.bar;
        __builtin_amdgcn_s_waitcnt(0);
        unsigned nloc = b.st[0], nx = b.st[1];
        if (nloc == 0u) { xcd_barrier_complete(bar, b.x, nloc, nx); b.st[0] = nloc; b.st[1] = nx; }
        const unsigned old = xb_add(&bar[XB_XSUB(b.x)], 1u);
        const unsigned gen = old / nloc;
        if (old + 1u == (gen + 1u) * nloc) {
            __builtin_amdgcn_fence(__ATOMIC_RELEASE, "agent");
            asm volatile("s_waitcnt vmcnt(0)" ::: "memory");
            const unsigned og = xb_add(&bar[XB_TOP], 1u);
            const unsigned tg = og / nx;
            if (og + 1u == (tg + 1u) * nx) xb_add(&bar[XB_TOPGEN], 1u);
            else XB_SPIN(xb_ld(&bar[XB_TOPGEN]) == tg, bar);
            __builtin_amdgcn_fence(__ATOMIC_ACQUIRE, "agent");
            xb_add(&bar[XB_XGEN(b.x)], 1u);
            asm volatile("s_waitcnt vmcnt(0)" ::: "memory");
        } else {
            XB_SPIN(xb_ld(&bar[XB_XGEN(b.x)]) == gen, bar);
            __builtin_amdgcn_fence(__ATOMIC_ACQUIRE, "agent");
            asm volatile("s_waitcnt vmcnt(0)" ::: "memory");
        }
    }
    __syncthreads();
}

namespace pg8 {
constexpr int BM = 256, BK = 64, HALF = 128, HTB = HALF * BK * 2, STAGE_BYTES = 8 * HTB, NXCD = 8, WGM = 8;
__host__ __device__ __forceinline__ int lds_byte(int r, int c) { const int st = (r >> 4) * 2 + (c >> 5), rr = r & 15, cc = c & 31, ob = rr * 64 + cc * 2; return st * 1024 + (ob ^ (((ob >> 9) & 1) << 5)); }
__host__ __device__ __forceinline__ void stage_rc(int b, int& R, int& C) { const int st = b / 1024, sb = b % 1024, swz = sb ^ (((sb >> 9) & 1) << 5); R = (st >> 1) * 16 + swz / 64; C = (st & 1) * 32 + (swz % 64) / 2; }
__host__ __device__ __forceinline__ int perm32(int rho) { const int n = rho >> 4, i = rho & 15; return 8 * (i >> 2) + 4 * n + (i & 3); }

struct Seg { const char* A; const char* B; const char* B2; int nt, ntb, epi, pm, pn, aux, f8; };
typedef f32x4 Acc[2][2][4][2];
typedef int v8i __attribute__((ext_vector_type(8)));

struct TileOrder {
    int nM, nN, nwg, G, c;
    __device__ void init(int M, int N, int G_, int c_) { nM = M / BM; nN = N / BM; nwg = nM * nN; G = G_; c = c_; }
    __device__ bool tile(int i, int& pm, int& pn) const {
        const long L = (long)i * G + c; if (L >= nwg) return false;
        int wgid = (int)L; { const int q = nwg / NXCD, r = nwg % NXCD, xcd = wgid % NXCD, off = wgid / NXCD; wgid = (xcd < r ? xcd * (q + 1) : r * (q + 1) + (xcd - r) * q) + off; }
        const int nig = WGM * nN, gid = wgid / nig, fm = gid * WGM, gsz = (nM - fm) < WGM ? (nM - fm) : WGM;
        pm = fm + ((wgid % nig) % gsz); pn = (wgid % nig) / gsz; return true;
    }
};

template <class Pol>
__device__ __forceinline__ void gemm_stream(LAS unsigned char* lds, const Pol& S) {
    constexpr bool GA = Pol::GATHER; constexpr int F8M = Pol::FP8;
    const int tid = opaque_tid(), wid = __builtin_amdgcn_readfirstlane(tid >> 6), lane = tid & 63, wr = wid >> 2, wc = wid & 3, fr = lane & 15, fq = lane >> 4;
    int Rr[2]; unsigned voffA[2], voffB[2];
#pragma unroll
    for (int i = 0; i < 2; ++i) { int R, C; stage_rc(tid * 16 + i * 8192, R, C); Rr[i] = R; voffA[i] = GA ? (unsigned)(C * 2) : (unsigned)(R * S.lda2 + C * 2); const int Rb = (R & ~31) + perm32(R & 31); voffB[i] = (unsigned)(Rb * S.ldb2 + C * 2); }
    const unsigned hstepB = (unsigned)(HALF * S.ldb2), hstepA = (unsigned)(HALF * S.lda2);
    const size_t kA = (size_t)S.kA;
    const unsigned ldsw = (unsigned)wid * 1024u;
    const int aoff = lds_byte(wr * 64 + fr, fq * 8), boff = lds_byte(wc * 32 + fr, fq * 8);
    const int sw8 = (fr * 64 + (fq & 1) * 32) ^ ((fr >> 3) << 5);
    const int aoff8 = (wr * 8 + (fq >> 1)) * 1024 + sw8, boff8 = (wc * 4 + (fq >> 1)) * 1024 + sw8;
#define PG8_SA(b, h) (((b) * 2 + (h)) * HTB)
#define PG8_SB(b, h) ((4 + (b) * 2 + (h)) * HTB)
#define PG8_STAGE_A(bufoff, gbase, tsel, h) do { _Pragma("unroll") for (int _i = 0; _i < 2; ++_i) \
        __builtin_amdgcn_global_load_lds((const unsigned*)((gbase) + (GA ? (tab[(tsel) * 256 + (h) * HALF + Rr[_i]] + voffA[_i]) : ((h) * hstepA + voffA[_i]))), (LAS unsigned*)(lds + (bufoff) + ldsw + _i * 8192), 16, 0, 0); } while (0)
#define PG8_STAGE_B(bufoff, gbase, h) do { _Pragma("unroll") for (int _i = 0; _i < 2; ++_i) \
        __builtin_amdgcn_global_load_lds((const unsigned*)((gbase) + (h) * hstepB + voffB[_i]), (LAS unsigned*)(lds + (bufoff) + ldsw + _i * 8192), 16, 0, 0); } while (0)
#define PG8_LDA(dst, b, h) do { _Pragma("unroll") for (int m = 0; m < 4; ++m) _Pragma("unroll") for (int k = 0; k < 2; ++k) dst[m][k] = *(const LAS bf16x8*)(lds + PG8_SA(b, h) + aoff + m * 2048 + k * 1024); } while (0)
#define PG8_LDB(dst, b, h) do { _Pragma("unroll") for (int n = 0; n < 2; ++n) _Pragma("unroll") for (int k = 0; k < 2; ++k) dst[n][k] = *(const LAS bf16x8*)(lds + PG8_SB(b, h) + boff + n * 2048 + k * 1024); } while (0)
#define PG8_MMA(ai, bj, At, Bt) do { __builtin_amdgcn_s_setprio(1); _Pragma("unroll") for (int m = 0; m < 4; ++m) _Pragma("unroll") for (int n = 0; n < 2; ++n) _Pragma("unroll") for (int k = 0; k < 2; ++k) \
        acc[ai][bj][m][n] = __builtin_amdgcn_mfma_f32_16x16x32_bf16(Bt[n][k], At[m][k], acc[ai][bj][m][n], 0, 0, 0); __builtin_amdgcn_s_setprio(0); } while (0)
#define PG8_LDA8(dst, b, h) do { _Pragma("unroll") for (int m = 0; m < 4; ++m) { const u32x4 lo_ = *(const LAS u32x4*)(lds + PG8_SA(b, h) + aoff8 + m * 2048), hi_ = *(const LAS u32x4*)(lds + PG8_SA(b, h) + aoff8 + m * 2048 + 16); dst[m] = (v8i){(int)lo_.x, (int)lo_.y, (int)lo_.z, (int)lo_.w, (int)hi_.x, (int)hi_.y, (int)hi_.z, (int)hi_.w}; } } while (0)
#define PG8_LDB8(dst, b, h) do { _Pragma("unroll") for (int n = 0; n < 2; ++n) { const u32x4 lo_ = *(const LAS u32x4*)(lds + PG8_SB(b, h) + boff8 + n * 2048), hi_ = *(const LAS u32x4*)(lds + PG8_SB(b, h) + boff8 + n * 2048 + 16); dst[n] = (v8i){(int)lo_.x, (int)lo_.y, (int)lo_.z, (int)lo_.w, (int)hi_.x, (int)hi_.y, (int)hi_.z, (int)hi_.w}; } } while (0)
#define PG8_MMA8(ai, bj, At, Bt) do { __builtin_amdgcn_s_setprio(1); _Pragma("unroll") for (int m = 0; m < 4; ++m) _Pragma("unroll") for (int n = 0; n < 2; ++n) \
        asm volatile("v_mfma_scale_f32_16x16x128_f8f6f4 %0, %1, %2, %0, %3, %3 op_sel_hi:[0,0,0]" : "+v"(acc[ai][bj][m][n]) : "v"(Bt[n]), "v"(At[m]), "v"(sc8)); __builtin_amdgcn_s_setprio(0); } while (0)
#define PG8_WAIT_V(n) asm volatile("s_waitcnt vmcnt(" #n ")" ::: "memory")
#define PG8_WAIT_L(n) asm volatile("s_waitcnt lgkmcnt(" #n ")" ::: "memory")
#define PG8_BAR __builtin_amdgcn_s_barrier()
#define PG8_SCHED __builtin_amdgcn_sched_barrier(0)
#define PG8_ZERO_ACC() do { _Pragma("unroll") for (int a = 0; a < 2; ++a) _Pragma("unroll") for (int b = 0; b < 2; ++b) _Pragma("unroll") for (int m = 0; m < 4; ++m) _Pragma("unroll") for (int n = 0; n < 2; ++n) acc[a][b][m][n] = (f32x4){0.f, 0.f, 0.f, 0.f}; } while (0)
    Seg cur, nxt; int ui = 0;
    if (!S.next(0, cur)) return;
    const LAS unsigned* tab = (const LAS unsigned*)(lds + STAGE_BYTES);
    int par = 0;
    if (GA) { if (tid < 256) ((LAS unsigned*)(lds + STAGE_BYTES))[tid] = S.arow(cur, tid); asm volatile("s_waitcnt lgkmcnt(0)" ::: "memory"); PG8_BAR; }
    Acc acc; PG8_ZERO_ACC();
    bf16x8 At[4][2], B0[2][2], B1[2][2]; v8i Et[4], E0[2], E1[2]; const int sc8 = 0x7f7f7f7f;
    {
        const char* cA = cur.A + S.arow0(cur); const char* cB = cur.B;
        PG8_STAGE_B(PG8_SB(0, 0), cB, 0); PG8_STAGE_B(PG8_SB(0, 1), cB, 1); PG8_STAGE_A(PG8_SA(0, 0), cA, par, 0); PG8_STAGE_A(PG8_SA(0, 1), cA, par, 1);
        if (wr == 1) PG8_BAR;
        PG8_WAIT_V(2); PG8_BAR;
        PG8_STAGE_B(PG8_SB(1, 0), cB + 128, 0); PG8_STAGE_A(PG8_SA(1, 0), cA + kA, par, 0); PG8_STAGE_B(PG8_SB(1, 1), cB + 128, 1);
        PG8_WAIT_V(6); PG8_BAR;
    }
    for (;;) {
        const bool has_next = S.next(ui + 1, nxt);
        if (!has_next) nxt = cur;
        const char* cA = cur.A + S.arow0(cur); const char* cB = cur.B; const char* nA = nxt.A + S.arow0(nxt); const char* nB = nxt.B;
        const int nt = cur.nt;
        if (GA) { if (has_next && tid < 256) ((LAS unsigned*)(lds + STAGE_BYTES))[(par ^ 1) * 256 + tid] = S.arow(nxt, tid); }
        const bool use8 = (F8M == 2) && (cur.f8 != 0);
        if (!use8) {
        for (int t = 0; t < nt; t += 2) {
            const bool last = (t == nt - 2);
            const char* a1 = cA + (size_t)(t + 1) * kA;
            const char* a2 = last ? nA : cA + (size_t)(t + 2) * kA; const char* a3 = a2 + kA;
            const char* b2 = last ? nB : ((t + 2 < cur.ntb) ? cB + (size_t)(t + 2) * 128 : cur.B2 + (size_t)(t + 2 - cur.ntb) * 128);
            const char* b3 = last ? ((1 < nxt.ntb) ? nB + 128 : nxt.B2 + (size_t)(1 - nxt.ntb) * 128) : ((t + 3 < cur.ntb) ? cB + (size_t)(t + 3) * 128 : cur.B2 + (size_t)(t + 3 - cur.ntb) * 128);
            const int o2 = (last && has_next) ? (par ^ 1) : par;
            PG8_LDB(B0, 0, 0); PG8_LDB(B1, 0, 1); PG8_SCHED; PG8_LDA(At, 0, 0); PG8_STAGE_A(PG8_SA(1, 1), a1, par, 1);
            PG8_WAIT_V(8); PG8_WAIT_L(0); PG8_BAR; PG8_MMA(0, 0, At, B0); PG8_MMA(0, 1, At, B1); PG8_BAR; PG8_SCHED;
            PG8_LDA(At, 0, 1); PG8_STAGE_B(PG8_SB(0, 0), b2, 0); PG8_STAGE_B(PG8_SB(0, 1), b2, 1); PG8_STAGE_A(PG8_SA(0, 0), a2, o2, 0);
            PG8_WAIT_V(8); PG8_WAIT_L(0); PG8_BAR; PG8_MMA(1, 0, At, B0); PG8_MMA(1, 1, At, B1); PG8_BAR; PG8_SCHED;
            PG8_LDB(B0, 1, 0); PG8_LDB(B1, 1, 1); PG8_SCHED; PG8_LDA(At, 1, 0); PG8_STAGE_A(PG8_SA(0, 1), a2, o2, 1);
            PG8_WAIT_V(8); PG8_WAIT_L(0); PG8_BAR; PG8_MMA(0, 0, At, B0); PG8_MMA(0, 1, At, B1); PG8_BAR; PG8_SCHED;
            PG8_LDA(At, 1, 1); PG8_STAGE_B(PG8_SB(1, 0), b3, 0); PG8_STAGE_B(PG8_SB(1, 1), b3, 1); PG8_STAGE_A(PG8_SA(1, 0), a3, o2, 0);
            PG8_WAIT_V(8); PG8_WAIT_L(0); PG8_BAR; PG8_MMA(1, 0, At, B0); PG8_MMA(1, 1, At, B1); PG8_BAR; PG8_SCHED;
        }
        } else {
        for (int t = 0; t < nt; t += 2) {
            const bool last = (t == nt - 2);
            const char* a1 = cA + (size_t)(t + 1) * kA;
            const char* a2 = last ? nA : cA + (size_t)(t + 2) * kA; const char* a3 = a2 + kA;
            const char* b2 = last ? nB : ((t + 2 < cur.ntb) ? cB + (size_t)(t + 2) * 128 : cur.B2 + (size_t)(t + 2 - cur.ntb) * 128);
            const char* b3 = last ? ((1 < nxt.ntb) ? nB + 128 : nxt.B2 + (size_t)(1 - nxt.ntb) * 128) : ((t + 3 < cur.ntb) ? cB + (size_t)(t + 3) * 128 : cur.B2 + (size_t)(t + 3 - cur.ntb) * 128);
            const int o2 = (last && has_next) ? (par ^ 1) : par;
            PG8_LDB8(E0, 0, 0); PG8_LDB8(E1, 0, 1); PG8_SCHED; PG8_LDA8(Et, 0, 0); PG8_STAGE_A(PG8_SA(1, 1), a1, par, 1);
            PG8_WAIT_V(8); PG8_WAIT_L(0); PG8_BAR; PG8_MMA8(0, 0, Et, E0); PG8_MMA8(0, 1, Et, E1); PG8_BAR; PG8_SCHED;
            PG8_LDA8(Et, 0, 1); PG8_STAGE_B(PG8_SB(0, 0), b2, 0); PG8_STAGE_B(PG8_SB(0, 1), b2, 1); PG8_STAGE_A(PG8_SA(0, 0), a2, o2, 0);
            PG8_WAIT_V(8); PG8_WAIT_L(0); PG8_BAR; PG8_MMA8(1, 0, Et, E0); PG8_MMA8(1, 1, Et, E1); PG8_BAR; PG8_SCHED;
            PG8_LDB8(E0, 1, 0); PG8_LDB8(E1, 1, 1); PG8_SCHED; PG8_LDA8(Et, 1, 0); PG8_STAGE_A(PG8_SA(0, 1), a2, o2, 1);
            PG8_WAIT_V(8); PG8_WAIT_L(0); PG8_BAR; PG8_MMA8(0, 0, Et, E0); PG8_MMA8(0, 1, Et, E1); PG8_BAR; PG8_SCHED;
            PG8_LDA8(Et, 1, 1); PG8_STAGE_B(PG8_SB(1, 0), b3, 0); PG8_STAGE_B(PG8_SB(1, 1), b3, 1); PG8_STAGE_A(PG8_SA(1, 0), a3, o2, 0);
            PG8_WAIT_V(8); PG8_WAIT_L(0); PG8_BAR; PG8_MMA8(1, 0, Et, E0); PG8_MMA8(1, 1, Et, E1); PG8_BAR; PG8_SCHED;
        }
        }
        const int did_epi = cur.epi;
        if (did_epi) { if (wr == 0) PG8_BAR; S.epilogue(acc, cur, wr, wc, fr, fq); }
        if (!has_next) break;
        if (did_epi) PG8_ZERO_ACC();
        cur = nxt; ++ui;
        par ^= 1;
        if (did_epi) { if (wr == 1) PG8_BAR; }
    }
    PG8_WAIT_V(0);
    PG8_BAR;
#undef PG8_SA
#undef PG8_SB
#undef PG8_STAGE_A
#undef PG8_STAGE_B
#undef PG8_LDA
#undef PG8_LDA8
#undef PG8_LDB8
#undef PG8_MMA8
#undef PG8_LDB
#undef PG8_MMA
#undef PG8_WAIT_V
#undef PG8_WAIT_L
#undef PG8_BAR
#undef PG8_SCHED
#undef PG8_ZERO_ACC
}
}

using pg8::Seg; using pg8::Acc;
#define EPI_ROWCOL() const int row0 = wr * 64 + fr, col0 = wc * 32 + 8 * fq
template <int CTRL> __device__ __forceinline__ float dppf(float v) { return __builtin_bit_cast(float, __builtin_amdgcn_update_dpp(0, __builtin_bit_cast(int, v), CTRL, 0xf, 0xf, true)); }

struct PolInProj {
    static constexpr bool GATHER = false; static constexpr int FP8 = 0;
    const char* A; const char* B; int lda2, ldb2, kA, nt; pg8::TileOrder ord;
    bf16_t* P; const float* bias; gu32* kn; float* kmz;
    __device__ __forceinline__ bool next(int i, Seg& s) const { int pm, pn; if (!ord.tile(i, pm, pn)) return false; s.A = A; s.B = B + (size_t)pn * 256 * ldb2; s.B2 = s.B; s.nt = nt; s.ntb = nt; s.epi = 1; s.pm = pm; s.pn = pn; s.aux = 0; s.f8 = 0; return true; }
    __device__ __forceinline__ unsigned arow(const Seg&, int) const { return 0u; }
    __device__ __forceinline__ size_t arow0(const Seg& s) const { return (size_t)s.pm * 256 * lda2; }
    __device__ __forceinline__ void epilogue(Acc& acc, const Seg& s, int wr, int wc, int fr, int fq) const {
        EPI_ROWCOL();
        f32x4 bv[2][2];
#pragma unroll
        for (int bj = 0; bj < 2; ++bj)
#pragma unroll
            for (int n = 0; n < 2; ++n) bv[bj][n] = *(const f32x4*)(bias + s.pn * 256 + col0 + bj * 128 + 4 * n);
#pragma unroll
        for (int ai = 0; ai < 2; ++ai)
#pragma unroll
            for (int m = 0; m < 4; ++m) {
                bf16_t* rowp = P + (size_t)(s.pm * 256 + row0 + ai * 128 + m * 16) * PP + s.pn * 256 + col0;
#pragma unroll
                for (int bj = 0; bj < 2; ++bj) { const f32x4 v0 = acc[ai][bj][m][0] + bv[bj][0], v1 = acc[ai][bj][m][1] + bv[bj][1];
                    u32x4 w; w.x = cvt_pk_bf16(v0[0], v0[1]); w.y = cvt_pk_bf16(v0[2], v0[3]); w.z = cvt_pk_bf16(v1[0], v1[1]); w.w = cvt_pk_bf16(v1[2], v1[3]);
                    *(u32x4*)(rowp + bj * 128) = w; }
            }
#pragma unroll
        for (int bj = 0; bj < 2; ++bj) {
            const int cbase = s.pn * 256 + bj * 128 + wc * 32;
            const bool isf = (unsigned)(cbase - PC_FK) < 384u, ism = (unsigned)(cbase - PC_MK) < 384u;
            if (isf || ism) {
                const int hh = (cbase - (isf ? PC_FK : PC_MK)) >> 6, half = (cbase >> 5) & 1, b = s.pm >> 4;
                float mx = 0.f; f32x4 c0 = (f32x4){0.f, 0.f, 0.f, 0.f}, c1 = c0;
#pragma unroll
                for (int ai = 0; ai < 2; ++ai)
#pragma unroll
                    for (int m = 0; m < 4; ++m) { const f32x4 v0 = acc[ai][bj][m][0] + bv[bj][0], v1 = acc[ai][bj][m][1] + bv[bj][1];
                        float ss = ((v0[0] * v0[0] + v0[1] * v0[1]) + (v0[2] * v0[2] + v0[3] * v0[3])) + ((v1[0] * v1[0] + v1[1] * v1[1]) + (v1[2] * v1[2] + v1[3] * v1[3]));
                        ss += __shfl_xor(ss, 16); ss += __shfl_xor(ss, 32);
                        mx = fmaxf(mx, ss); c0 += v0; c1 += v1; }
                mx = fmaxf(mx, dppf<0xB1>(mx)); mx = fmaxf(mx, dppf<0x4E>(mx)); mx = fmaxf(mx, dppf<0x141>(mx)); mx = fmaxf(mx, dppf<0x140>(mx));
                if ((fr | fq) == 0) __hip_atomic_fetch_max(kn + ((isf ? 0 : 48) + b * 6 + hh) * 2 + half, __float_as_uint(mx * 1.02f), RLX_AGENT);
                if (ism) {
#pragma unroll
                    for (int e = 0; e < 4; ++e) { float a = c0[e], c = c1[e];
                        a += dppf<0xB1>(a); a += dppf<0x4E>(a); a += dppf<0x141>(a); a += dppf<0x140>(a);
                        c += dppf<0xB1>(c); c += dppf<0x4E>(c); c += dppf<0x141>(c); c += dppf<0x140>(c);
                        c0[e] = a; c1[e] = c; }
                    if (fr == 0) { float* kp = kmz + ((size_t)(b * 6 + hh) * 16 + (s.pm & 15)) * 64 + half * 32 + fq * 8;
#pragma unroll
                        for (int e = 0; e < 4; ++e) { __hip_atomic_fetch_add(kp + e, c0[e], RLX_AGENT); __hip_atomic_fetch_add(kp + 4 + e, c1[e], RLX_AGENT); } }
                }
            }
        }
    }
};
struct PolOutProj {
    static constexpr bool GATHER = false; static constexpr int FP8 = 0;
    const char* A; const char* B; int lda2, ldb2, kA, nt; pg8::TileOrder ord;
    bf16_t* d1;
    __device__ __forceinline__ bool next(int i, Seg& s) const { int pm, pn; if (!ord.tile(i, pm, pn)) return false; s.A = A; s.B = B + (size_t)pn * 256 * ldb2; s.B2 = s.B; s.nt = nt; s.ntb = nt; s.epi = 1; s.pm = pm; s.pn = pn; s.aux = 0; s.f8 = 0; return true; }
    __device__ __forceinline__ unsigned arow(const Seg&, int) const { return 0u; }
    __device__ __forceinline__ size_t arow0(const Seg& s) const { return (size_t)s.pm * 256 * lda2; }
    __device__ __forceinline__ void epilogue(Acc& acc, const Seg& s, int wr, int wc, int fr, int fq) const {
        EPI_ROWCOL();
#pragma unroll
        for (int ai = 0; ai < 2; ++ai)
#pragma unroll
            for (int m = 0; m < 4; ++m) {
                bf16_t* rowp = d1 + (size_t)(s.pm * 256 + row0 + ai * 128 + m * 16) * D_ + s.pn * 256 + col0;
#pragma unroll
                for (int bj = 0; bj < 2; ++bj) { const f32x4 v0 = acc[ai][bj][m][0], v1 = acc[ai][bj][m][1];
                    u32x4 w; w.x = cvt_pk_bf16(v0[0], v0[1]); w.y = cvt_pk_bf16(v0[2], v0[3]); w.z = cvt_pk_bf16(v1[0], v1[1]); w.w = cvt_pk_bf16(v1[2], v1[3]);
                    *(u32x4*)(rowp + bj * 128) = w; }
            }
    }
};
struct PolMerge {
    static constexpr bool GATHER = false; static constexpr int FP8 = 2;
    const char* O; const char* H8; const char* WBR; const char* WG8;
    int lda2, ldb2, kA; int vcu, G;
    bf16_t* merged; const float* biasg; char* ys; char* ps; const char* zero;
    __device__ __forceinline__ bool next(int i, Seg& s) const {
        const int combo = vcu + G * (i / 6), j = i % 6; if (combo >= 512) return false;
        const int pm = combo >> 2, c = combo & 3, br = j >> 1;
        const int kofs = (br == 0) ? 0 : (br == 1 ? 384 : 640);
        if (!(j & 1)) { s.A = O + kofs * 2; s.B = WBR + (size_t)(c * 256) * 2048 + kofs * 2; s.nt = (br == 1) ? 4 : 6; s.f8 = 0; }
        else { s.A = H8; s.B = WG8 + (size_t)(br * 1024 + c * 256) * 2048; s.nt = 8; s.f8 = 1; }
        s.B2 = s.B; s.ntb = s.nt; s.epi = 1; s.pm = pm; s.pn = c; s.aux = j; return true;
    }
    __device__ __forceinline__ unsigned arow(const Seg&, int) const { return 0u; }
    __device__ __forceinline__ size_t arow0(const Seg& s) const { return (size_t)s.pm * 256 * 2048; }
    __device__ __forceinline__ void epilogue(Acc& acc, const Seg& s, int wr, int wc, int fr, int fq) const {
        EPI_ROWCOL(); const int j = s.aux, br = j >> 1; const unsigned tofs0 = (unsigned)((((wr << 2) | wc) << 6) | (fq << 4) | fr) * 16u;
        if (!(j & 1)) {
#pragma unroll
            for (int e = 0; e < 16; ++e) { const int ai = e >> 3, bj = (e >> 2) & 1, m = e & 3; const f32x4 v0 = acc[ai][bj][m][0], v1 = acc[ai][bj][m][1]; unsigned tofs = tofs0; asm volatile("" : "+v"(tofs));
                u32x4 w; w.x = cvt_pk_bf16(v0[0], v0[1]); w.y = cvt_pk_bf16(v0[2], v0[3]); w.z = cvt_pk_bf16(v1[0], v1[1]); w.w = cvt_pk_bf16(v1[2], v1[3]);
                *(u32x4*)((ys + e * 8192) + tofs) = w; }
            return;
        }
        constexpr int DEPTH = 4;
        f32x4 b0[2], b1[2];
#pragma unroll
        for (int bj = 0; bj < 2; ++bj) { b0[bj] = *(const f32x4*)(biasg + br * 1024 + s.pn * 256 + col0 + bj * 128); b1[bj] = *(const f32x4*)(biasg + br * 1024 + s.pn * 256 + col0 + bj * 128 + 4); }
        const char* pin = (br > 0) ? ps : zero;
        char* pout = (br < 2) ? ps : (char*)(merged + (size_t)s.pm * 256 * D_ + s.pn * 256);
        const unsigned mofs0 = (unsigned)(row0 * D_ + col0) * 2u;
        u32x4 yq[DEPTH], pq[DEPTH];
#pragma unroll
        for (int e = 0; e < DEPTH; ++e) { unsigned tofs = tofs0; asm volatile("" : "+v"(tofs)); yq[e] = *(const u32x4*)((ys + e * 8192) + tofs); pq[e] = *(const u32x4*)((pin + e * 8192) + tofs); }
#pragma unroll
        for (int e = 0; e < 16; ++e) {
            const int ai = e >> 3, bj = (e >> 2) & 1, m = e & 3;
            const u32x4 yw = yq[e % DEPTH], pw = pq[e % DEPTH];
            asm volatile("" ::: "memory");
            if (e + DEPTH < 16) { unsigned tofs = tofs0; asm volatile("" : "+v"(tofs)); yq[e % DEPTH] = *(const u32x4*)((ys + (e + DEPTH) * 8192) + tofs); pq[e % DEPTH] = *(const u32x4*)((pin + (e + DEPTH) * 8192) + tofs); }
            asm volatile("" ::: "memory");
            const f32x4 g0 = acc[ai][bj][m][0] * 0.015625f + b0[bj], g1 = acc[ai][bj][m][1] * 0.015625f + b1[bj];
            float z[8];
            z[0] = fast_sigmoid(g0[0]) * __builtin_bit_cast(float, yw.x << 16) + __builtin_bit_cast(float, pw.x << 16); z[1] = fast_sigmoid(g0[1]) * __builtin_bit_cast(float, yw.x & 0xffff0000u) + __builtin_bit_cast(float, pw.x & 0xffff0000u);
            z[2] = fast_sigmoid(g0[2]) * __builtin_bit_cast(float, yw.y << 16) + __builtin_bit_cast(float, pw.y << 16); z[3] = fast_sigmoid(g0[3]) * __builtin_bit_cast(float, yw.y & 0xffff0000u) + __builtin_bit_cast(float, pw.y & 0xffff0000u);
            z[4] = fast_sigmoid(g1[0]) * __builtin_bit_cast(float, yw.z << 16) + __builtin_bit_cast(float, pw.z << 16); z[5] = fast_sigmoid(g1[1]) * __builtin_bit_cast(float, yw.z & 0xffff0000u) + __builtin_bit_cast(float, pw.z & 0xffff0000u);
            z[6] = fast_sigmoid(g1[2]) * __builtin_bit_cast(float, yw.w << 16) + __builtin_bit_cast(float, pw.w << 16); z[7] = fast_sigmoid(g1[3]) * __builtin_bit_cast(float, yw.w & 0xffff0000u) + __builtin_bit_cast(float, pw.w & 0xffff0000u);
            u32x4 w; w.x = cvt_pk_bf16(z[0], z[1]); w.y = cvt_pk_bf16(z[2], z[3]); w.z = cvt_pk_bf16(z[4], z[5]); w.w = cvt_pk_bf16(z[6], z[7]);
            unsigned so = (br < 2) ? (tofs0 + (unsigned)(e * 8192)) : (mofs0 + (unsigned)((ai * 128 + m * 16) * D_ + bj * 128) * 2u); asm volatile("" : "+v"(so));
            *(u32x4*)(pout + so) = w;
        }
    }
};
__device__ __forceinline__ bool moe_find(const LAS unsigned* cnt, int rt, int& bucket, int& local, int& count) {
    int accn = 0;
    for (int b = 0; b < 24; ++b) { const int c = (int)cnt[b]; const int n = (c + 255) >> 8; if (rt < accn + n) { bucket = b; local = rt - accn; count = c; return true; } accn += n; }
    return false;
}
__device__ __forceinline__ void pair_of(int pidx, int& a, int& b) { a = (pidx < 3) ? 0 : (pidx < 5 ? 1 : 2); b = (pidx < 3) ? pidx + 1 : (pidx < 5 ? pidx - 1 : 3); }
struct PolMoeUp {
    static constexpr bool GATHER = true; static constexpr int FP8 = 0;
    __device__ __forceinline__ size_t arow0(const Seg&) const { return 0; }
    const char* H; const char* WGU; int lda2, ldb2, kA; int c, G;
    const LAS unsigned* cnt; const int* list; const float* tokw; bf16_t* hid;
    __device__ __forceinline__ bool next(int i, Seg& s) const {
        const int u = i * G + c, rt = u >> 2, pn = u & 3; int bucket, local, count; if (!moe_find(cnt, rt, bucket, local, count)) return false;
        int a, b; pair_of(bucket % 6, a, b); const int e = (bucket / 6) * 4 + (pn < 2 ? a : b);
        s.A = H; s.B = WGU + ((size_t)e * 512 + (pn & 1) * 256) * 2048; s.B2 = s.B; s.nt = 16; s.ntb = 16; s.epi = 1; s.pm = bucket | (local << 8); s.pn = pn; s.aux = count; s.f8 = 0; return true;
    }
    __device__ __forceinline__ unsigned arow(const Seg& s, int r) const { int idx = (s.pm >> 8) * 256 + r; idx = idx < s.aux ? idx : s.aux - 1; return (unsigned)list[(size_t)(s.pm & 255) * T_ + idx] * 2048u; }
    __device__ __forceinline__ void epilogue(Acc& acc, const Seg& s, int wr, int wc, int fr, int fq) const {
        EPI_ROWCOL(); const int bucket = s.pm & 255, local = s.pm >> 8, slot = s.pn >> 1;
        int tok[8]; float w[8];
#pragma unroll
        for (int e = 0; e < 8; ++e) { const int idx = local * 256 + row0 + (e >> 2) * 128 + (e & 3) * 16; tok[e] = list[(size_t)bucket * T_ + (idx < s.aux ? idx : s.aux - 1)]; }
#pragma unroll
        for (int e = 0; e < 8; ++e) w[e] = tokw[tok[e] * 2 + slot];
#pragma unroll
        for (int e = 0; e < 8; ++e) { const int ai = e >> 2, m = e & 3; const bool valid = (local * 256 + row0 + ai * 128 + m * 16) < s.aux;
            float hv[8];
#pragma unroll
            for (int n = 0; n < 2; ++n)
#pragma unroll
                for (int k = 0; k < 4; ++k) { const float g = acc[ai][0][m][n][k], u = acc[ai][1][m][n][k]; hv[n * 4 + k] = g * fast_sigmoid(g) * u * w[e]; }
            u32x4 o; o.x = cvt_pk_bf16(hv[0], hv[1]); o.y = cvt_pk_bf16(hv[2], hv[3]); o.z = cvt_pk_bf16(hv[4], hv[5]); o.w = cvt_pk_bf16(hv[6], hv[7]);
            if (valid) *(u32x4*)(hid + (size_t)tok[e] * 512 + slot * 256 + (s.pn & 1) * 128 + col0) = o;
        }
    }
};
struct PolMoeDown {
    static constexpr bool GATHER = true; static constexpr int FP8 = 0;
    __device__ __forceinline__ size_t arow0(const Seg&) const { return 0; }
    const char* HID; const char* WD; int lda2, ldb2, kA; int c, G;
    const LAS unsigned* cnt; const int* list; bf16_t* d2;
    __device__ __forceinline__ bool next(int i, Seg& s) const {
        const int u = i * G + c, rt = u >> 2, pn = u & 3; int bucket, local, count; if (!moe_find(cnt, rt, bucket, local, count)) return false;
        int a, b; pair_of(bucket % 6, a, b); const int g4 = (bucket / 6) * 4;
        s.A = HID; s.B = WD + ((size_t)(g4 + a) * 1024 + pn * 256) * 512; s.B2 = WD + ((size_t)(g4 + b) * 1024 + pn * 256) * 512; s.nt = 8; s.ntb = 4; s.epi = 1; s.pm = bucket | (local << 8); s.pn = pn; s.aux = count; s.f8 = 0; return true;
    }
    __device__ __forceinline__ unsigned arow(const Seg& s, int r) const { int idx = (s.pm >> 8) * 256 + r; idx = idx < s.aux ? idx : s.aux - 1; return (unsigned)list[(size_t)(s.pm & 255) * T_ + idx] * 1024u; }
    __device__ __forceinline__ void epilogue(Acc& acc, const Seg& s, int wr, int wc, int fr, int fq) const {
        EPI_ROWCOL(); const int bucket = s.pm & 255, local = s.pm >> 8;
        int tok[8];
#pragma unroll
        for (int e = 0; e < 8; ++e) { const int idx = local * 256 + row0 + (e >> 2) * 128 + (e & 3) * 16; tok[e] = list[(size_t)bucket * T_ + (idx < s.aux ? idx : s.aux - 1)]; }
#pragma unroll
        for (int e = 0; e < 8; ++e) { const int ai = e >> 2, m = e & 3; const bool valid = (local * 256 + row0 + ai * 128 + m * 16) < s.aux;
            bf16_t* dp = d2 + (size_t)tok[e] * D_ + s.pn * 256 + col0;
#pragma unroll
            for (int bj = 0; bj < 2; ++bj) { const f32x4 v0 = acc[ai][bj][m][0], v1 = acc[ai][bj][m][1];
                u32x4 w; w.x = cvt_pk_bf16(v0[0], v0[1]); w.y = cvt_pk_bf16(v0[2], v0[3]); w.z = cvt_pk_bf16(v1[0], v1[1]); w.w = cvt_pk_bf16(v1[2], v1[3]);
                if (valid) *(u32x4*)(dp + bj * 128) = w; }
        }
    }
};

namespace att {
typedef LAS const char* lds_cptr;
typedef short v4i16_t __attribute__((ext_vector_type(4)));
__device__ __forceinline__ int crow(int r, int hi) { return (r & 3) + 8 * (r >> 2) + 4 * hi; }
#define SBAR() __builtin_amdgcn_sched_barrier(0)
__device__ __forceinline__ void glds16(const void* gsrc, unsigned lds_dst) { unsigned keep;
    asm volatile("s_mov_b32 %0, m0\n\ts_mov_b32 m0, %2\n\ts_nop 0\n\tglobal_load_lds_dwordx4 %1, off\n\ts_mov_b32 m0, %0" : "=&s"(keep) : "v"(gsrc), "s"(lds_dst) : "memory"); }
#define WAIT_BAR0() asm volatile("s_waitcnt vmcnt(0) lgkmcnt(0)\n\ts_barrier" ::: "memory")
__device__ __forceinline__ void kload8(bf16x8* kf, lds_cptr kp) {
    kf[0] = *(const LAS bf16x8*)(kp);        kf[1] = *(const LAS bf16x8*)(kp + 512);
    kf[2] = *(const LAS bf16x8*)(kp + 2048); kf[3] = *(const LAS bf16x8*)(kp + 2560);
    kf[4] = *(const LAS bf16x8*)(kp + 4096); kf[5] = *(const LAS bf16x8*)(kp + 4608);
    kf[6] = *(const LAS bf16x8*)(kp + 6144); kf[7] = *(const LAS bf16x8*)(kp + 6656);
}
#define MX3(a, b, c) __builtin_fmaxf(__builtin_fmaxf((a), (b)), (c))
__device__ __forceinline__ float rowmax(const f32x16& p0, const f32x16& p1) {
    float a = MX3(p0[0], p0[1], p1[0]), b = MX3(p0[2], p0[3], p1[1]); a = MX3(a, p1[2], p1[3]);
#pragma unroll
    for (int r = 4; r < 16; r += 4) { a = MX3(a, p0[r], p0[r + 1]); b = MX3(b, p0[r + 2], p0[r + 3]); a = MX3(a, p1[r], p1[r + 1]); b = MX3(b, p1[r + 2], p1[r + 3]); }
    const float m = __builtin_fmaxf(a, b); auto rr = __builtin_amdgcn_permlane32_swap(__float_as_uint(m), __float_as_uint(m), false, false);
    return __builtin_fmaxf(__uint_as_float(rr[0]), __uint_as_float(rr[1]));
}
__device__ __forceinline__ float halfsum(float v) { auto rr = __builtin_amdgcn_permlane32_swap(__float_as_uint(v), __float_as_uint(v), false, false); return __uint_as_float(rr[0]) + __uint_as_float(rr[1]); }
__device__ __forceinline__ s16x4 vtr(lds_cptr p) { return __builtin_bit_cast(s16x4, __builtin_amdgcn_ds_read_tr16_b64_v4i16((LAS v4i16_t*)p)); }
__device__ __forceinline__ void pv(f32x16* o, lds_cptr vp, bf16x8 pa0, bf16x8 pa1, bf16x8 pa2, bf16x8 pa3) {
#pragma unroll
    for (int d0 = 0; d0 < 2; ++d0) { s16x4 lo[4], hi[4];
#pragma unroll
        for (int ks = 0; ks < 4; ++ks) { lo[ks] = vtr(vp + d0 * 4096 + ks * 1024); hi[ks] = vtr(vp + d0 * 4096 + ks * 1024 + 512); }
#define PK(k) (bf16x8){lo[k][0], lo[k][1], lo[k][2], lo[k][3], hi[k][0], hi[k][1], hi[k][2], hi[k][3]}
        o[d0] = __builtin_amdgcn_mfma_f32_32x32x16_bf16(pa0, PK(0), o[d0], 0, 0, 0);
        o[d0] = __builtin_amdgcn_mfma_f32_32x32x16_bf16(pa1, PK(1), o[d0], 0, 0, 0);
        o[d0] = __builtin_amdgcn_mfma_f32_32x32x16_bf16(pa2, PK(2), o[d0], 0, 0, 0);
        o[d0] = __builtin_amdgcn_mfma_f32_32x32x16_bf16(pa3, PK(3), o[d0], 0, 0, 0);
#undef PK
    }
}
typedef float f32x2_t __attribute__((ext_vector_type(2))); typedef __bf16 bf16x2_t __attribute__((ext_vector_type(2)));
__device__ __forceinline__ unsigned cvtpk_s(float lo, float hi) { f32x2_t v = {lo, hi}; bf16x2_t b = __builtin_convertvector(v, bf16x2_t); return __builtin_bit_cast(unsigned, b); }
__device__ __forceinline__ int wave_min_i(int v) {
#pragma unroll
    for (int o = 1; o < 64; o <<= 1) v = min(v, __shfl_xor(v, o));
    return __builtin_amdgcn_readfirstlane(v); }
__device__ __forceinline__ int wave_max_i(int v) {
#pragma unroll
    for (int o = 1; o < 64; o <<= 1) v = max(v, __shfl_xor(v, o));
    return __builtin_amdgcn_readfirstlane(v); }

template <int MODE, bool EXIT>
__device__ __forceinline__ void flash_pass(LAS char* shm, const bf16_t* kbase, const bf16_t* vbase, int pitch, int t_lo, int t_hi, unsigned long long tmask, int tshift, int kref,
                                           const bf16x8* qr, int khi, int klo, float slope2, unsigned long long rmask, float& m, float& l, f32x16* o, float invl, float knmax = 0.f) {
    const int tid = opaque_tid(), lane = tid & 63, r32 = lane & 31, hi = lane >> 5; const int wid = __builtin_amdgcn_readfirstlane(tid >> 6);
    const unsigned lds0 = (unsigned)(uintptr_t)shm;
    const bf16_t* ksrc = kbase + (long)lane * pitch + wid * 8;
    const bf16_t* vsrc = vbase + (long)(16 * (wid & 3) + (lane >> 2)) * pitch + (wid >> 2) * 32 + (lane & 3) * 8;
    const unsigned kdst = lds0 + L_K + wid * 1024, vdst = lds0 + L_V + wid * 1024;
    const lds_cptr kp0 = (lds_cptr)shm + L_K + hi * 1024 + r32 * 16;
    const lds_cptr vp0 = (lds_cptr)shm + L_V + ((lane >> 4) & 1) * 32 + (lane & 3) * 8 + (4 * hi + ((lane & 15) >> 2)) * 64;
    LAS float* wsf = (LAS float*)(shm + L_WSF) + wid * 128;
    const int wmin_khi = wave_min_i(khi), wmax_klo = wave_max_i(klo);
#define ACTIVE(t) (((tmask) >> ((t) >> tshift)) & 1ull)
#define DMA_KV(t, slot) do { glds16(ksrc + (long)(t) * 64 * pitch, (unsigned)__builtin_amdgcn_readfirstlane(kdst + (slot) * SLOTB)); \
                             if (MODE != 2) glds16(vsrc + (long)(t) * 64 * pitch, (unsigned)__builtin_amdgcn_readfirstlane(vdst + (slot) * SLOTB)); } while (0)
    int t = t_hi - 1; while (t >= t_lo && !ACTIVE(t)) --t;
    if (t < t_lo) return;
    float qb = 0.f, mt = -INFINITY; LAS unsigned* votes = (LAS unsigned*)(shm + L_VOTE);
    if (EXIT) {
        float ss = 0.f;
#pragma unroll
        for (int d0 = 0; d0 < 4; ++d0)
#pragma unroll
            for (int e = 0; e < 8; ++e) { const float v = bf2f((unsigned short)qr[d0][e]); ss += v * v; }
        qb = sqrtf(halfsum(ss)) * knmax * 1.01f;
        if (tid < 64) votes[tid] = 0u;
    }
    int slot = 0;
    int tn = t - 1; while (tn >= t_lo && !ACTIVE(tn)) --tn;
    int tnn = tn - 1; while (tnn >= t_lo && !ACTIVE(tnn)) --tnn;
    constexpr int NDMA = (MODE != 2) ? 2 : 1;
    DMA_KV(t, 0);
    if (tn >= t_lo) DMA_KV(tn, 1);
    if (tnn >= t_lo) DMA_KV(tnn, 2);
    if (tnn >= t_lo) { if (NDMA == 2) asm volatile("s_waitcnt vmcnt(2) lgkmcnt(0)\n\ts_barrier" ::: "memory"); else asm volatile("s_waitcnt vmcnt(1) lgkmcnt(0)\n\ts_barrier" ::: "memory"); }
    else WAIT_BAR0();
    constexpr bool KE = EXIT;
    bf16x8 kf[8]; if (KE) kload8(kf, kp0);
    for (;;) {
        int tnnn = tnn - 1; while (tnnn >= t_lo && !ACTIVE(tnnn)) --tnnn;
        const int slot1 = (slot + 1) & 3, slot3 = (slot + 3) & 3;
        if (tnn >= t_lo && tnnn >= t_lo) DMA_KV(tnnn, slot3);
        if (!KE) kload8(kf, kp0 + slot * SLOTB);
        f32x16 p0, p1;
        if (MODE == 1) { const LAS float* fb = (const LAS float*)(shm + L_AUX) + 64 * t + 4 * hi;
#pragma unroll
            for (int g = 0; g < 4; ++g) { const f32x4 a_ = *(const LAS f32x4*)(fb + 8 * g), b_ = *(const LAS f32x4*)(fb + 32 + 8 * g);
#pragma unroll
                for (int k = 0; k < 4; ++k) { p0[4 * g + k] = a_[k] - m; p1[4 * g + k] = b_[k] - m; } }
        } else { const bool rowok = (rmask >> (t >> tshift)) & 1ull;
            const float base = rowok ? (slope2 * (float)(64 * t + 4 * hi - kref) - m) : -INFINITY, base1 = base + 32.f * slope2;
#pragma unroll
            for (int r = 0; r < 16; ++r) { const float cr = (float)((r & 3) + 8 * (r >> 2)); p0[r] = __builtin_fmaf(slope2, cr, base); p1[r] = __builtin_fmaf(slope2, cr, base1); } }
#pragma unroll
        for (int d0 = 0; d0 < 4; ++d0) { p0 = __builtin_amdgcn_mfma_f32_32x32x16_bf16(kf[2 * d0], qr[d0], p0, 0, 0, 0); p1 = __builtin_amdgcn_mfma_f32_32x32x16_bf16(kf[2 * d0 + 1], qr[d0], p1, 0, 0, 0); }
        if (KE) { if (tn >= t_lo) kload8(kf, kp0 + slot1 * SLOTB); }
        if (64 * t + 63 > wmin_khi || 64 * t < wmax_klo) {
            const int kb = 64 * t + 4 * hi;
#pragma unroll
            for (int r = 0; r < 16; ++r) { const int kv = kb + (r & 3) + 8 * (r >> 2); if (kv > khi || kv < klo) p0[r] = -INFINITY; if (kv + 32 > khi || kv + 32 < klo) p1[r] = -INFINITY; }
        }
        if (MODE == 2) {
            LAS float* imp = (LAS float*)(shm + L_IMP) + (wid * 8 + (r32 >> 2)) * IMP_LD + 64 * t + 4 * hi;
#pragma unroll
            for (int r = 0; r < 16; ++r) {
                float a = __builtin_amdgcn_exp2f(p0[r]) * invl, b = __builtin_amdgcn_exp2f(p1[r]) * invl;
                a += __shfl_xor(a, 1); a += __shfl_xor(a, 2); b += __shfl_xor(b, 1); b += __shfl_xor(b, 2);
                if ((r32 & 3) == 0) { imp[(r & 3) + 8 * (r >> 2)] = a; imp[32 + (r & 3) + 8 * (r >> 2)] = b; }
            }
        } else {
            const float rm = rowmax(p0, p1);
            if (EXIT) mt = __builtin_fmaxf(mt, rm + m);
            if (__any(rm > THR)) {
                const float dl = __builtin_fmaxf(rm, 0.f); m += dl;
#pragma unroll
                for (int r = 0; r < 16; ++r) { p0[r] -= dl; p1[r] -= dl; }
                const float f = __builtin_amdgcn_exp2f(-dl); l *= f;
                if (hi == 0) wsf[r32] = f;
                asm volatile("s_waitcnt lgkmcnt(0)" ::: "memory");
#pragma unroll
                for (int r = 0; r < 16; ++r) { const float fr_ = wsf[crow(r, hi)]; o[0][r] *= fr_; o[1][r] *= fr_; }
            }
            const lds_cptr vp = vp0 + slot * SLOTB;
            s16x4 vlo[4][2], vhi[4][2];
#pragma unroll
            for (int ks = 0; ks < 4; ++ks)
#pragma unroll
                for (int d0 = 0; d0 < 2; ++d0) { vlo[ks][d0] = vtr(vp + d0 * 4096 + ks * 1024); vhi[ks][d0] = vtr(vp + d0 * 4096 + ks * 1024 + 512); }
            float sacc = 0.f;
#pragma unroll
            for (int ks = 0; ks < 4; ++ks) {
                float e[8];
#pragma unroll
                for (int i = 0; i < 8; ++i) { e[i] = __builtin_amdgcn_exp2f((ks < 2) ? p0[(ks & 1) * 8 + i] : p1[(ks & 1) * 8 + i]); sacc += e[i]; }
                const u32x4 pw = (u32x4){cvtpk_s(e[0], e[1]), cvtpk_s(e[2], e[3]), cvtpk_s(e[4], e[5]), cvtpk_s(e[6], e[7])};
                const bf16x8 pa = __builtin_bit_cast(bf16x8, pw);
#pragma unroll
                for (int d0 = 0; d0 < 2; ++d0) { const bf16x8 vf = (bf16x8){vlo[ks][d0][0], vlo[ks][d0][1], vlo[ks][d0][2], vlo[ks][d0][3], vhi[ks][d0][0], vhi[ks][d0][1], vhi[ks][d0][2], vhi[ks][d0][3]};
                    o[d0] = __builtin_amdgcn_mfma_f32_32x32x16_bf16(pa, vf, o[d0], 0, 0, 0); }
            }
            l += sacc;
        }
        if (tn < t_lo) { WAIT_BAR0(); break; }
        if (EXIT) {
            const float bmax = (MODE == 1) ? ((const LAS float*)(shm + L_AUX))[64 * tn + 63] : slope2 * (float)(64 * tn + 63 - kref);
            const bool rowdone = (khi < 0) || (klo > 64 * tn + 63) || ((rmask & ((2ull << (tn >> tshift)) - 1ull)) == 0ull);
            const bool sat = rowdone || (qb + bmax < mt - 50.f);
            if (__all(sat) && lane == 0) __hip_atomic_fetch_add(&votes[tn], 1u, __ATOMIC_RELAXED, __HIP_MEMORY_SCOPE_WORKGROUP);
        }
        if (tnn >= t_lo && tnnn >= t_lo) { if (NDMA == 2) asm volatile("s_waitcnt vmcnt(2) lgkmcnt(0)\n\ts_barrier" ::: "memory"); else asm volatile("s_waitcnt vmcnt(1) lgkmcnt(0)\n\ts_barrier" ::: "memory"); }
        else WAIT_BAR0();
        if (EXIT) { if (votes[tn] == 8u) { WAIT_BAR0(); break; } }
        t = tn; tn = tnn; tnn = tnnn; slot = slot1;
    }
#undef ACTIVE
#undef DMA_KV
}
__device__ __forceinline__ float inv_l(float l) { const float lt = halfsum(l); return lt > 0.f ? 1.0f / lt : 0.f; }
__device__ __forceinline__ void scale_rows(LAS char* shm, f32x16* o, float fac, f32x16* dst, bool accumulate) {
    const int tid_ = opaque_tid(), lane = tid_ & 63, r32 = lane & 31, hi = lane >> 5; const int wid = __builtin_amdgcn_readfirstlane(tid_ >> 6);
    LAS float* wsf = (LAS float*)(shm + L_WSF) + wid * 128 + 64;
    if (hi == 0) wsf[r32] = fac;
    asm volatile("s_waitcnt lgkmcnt(0)" ::: "memory");
#pragma unroll
    for (int r = 0; r < 16; ++r) { const float f = wsf[crow(r, hi)];
        if (accumulate) { dst[0][r] += o[0][r] * f; dst[1][r] += o[1][r] * f; } else { dst[0][r] = o[0][r] * f; dst[1][r] = o[1][r] * f; } }
    asm volatile("s_waitcnt lgkmcnt(0)" ::: "memory");
}
template <class RowPtr>
__device__ __forceinline__ void store_o(LAS char* shm, const f32x16* o, const RowPtr& rowptr) {
    const int tid_ = opaque_tid(), lane = tid_ & 63, r32 = lane & 31, hi = lane >> 5; const int wid = __builtin_amdgcn_readfirstlane(tid_ >> 6);
    LAS bf16_t* stg = (LAS bf16_t*)(shm + L_OST) + wid * 2048;
#pragma unroll
    for (int r = 0; r < 16; ++r) { const int orow = crow(r, hi);
#pragma unroll
        for (int d0 = 0; d0 < 2; ++d0) stg[orow * 64 + d0 * 32 + r32] = (bf16_t)f2bf(o[d0][r]); }
    asm volatile("s_waitcnt lgkmcnt(0)" ::: "memory");
#pragma unroll
    for (int i = 0; i < 4; ++i) { const int row = i * 8 + (lane >> 3), ch = lane & 7; const u32x4 v = *(const LAS u32x4*)(stg + row * 64 + ch * 8); *(u32x4*)(rowptr(row) + ch * 8) = v; }
    asm volatile("s_waitcnt lgkmcnt(0)" ::: "memory");
}
__device__ __forceinline__ void load_q(bf16x8* qr, const bf16_t* qrow, int hi) {
#pragma unroll
    for (int d0 = 0; d0 < 4; ++d0) qr[d0] = *(const bf16x8*)(qrow + d0 * 16 + hi * 8);
}

__device__ __forceinline__ void fox_unit(LAS char* shm, const bf16_t* P, const float* FB, bf16_t* O, int b, int h, int qb, float knmax) {
    const int tid = opaque_tid(), lane = tid & 63, r32 = lane & 31, hi = lane >> 5; const int wid = __builtin_amdgcn_readfirstlane(tid >> 6);
    const int q0 = qb * 256, qpos = q0 + wid * 32 + r32;
    const float* fbs = FB + (size_t)(b * 6 + h) * S_; const float ref = fbs[q0];
    LAS float* fbl = (LAS float*)(shm + L_AUX);
    for (int i = tid; i < q0 + 256; i += 512) fbl[i] = fbs[i] - ref;
    bf16x8 qr[4]; load_q(qr, P + (size_t)(b * S_ + qpos) * PP + PC_FQ + h * 64, hi);
    float m = 0.f, l = 0.f; f32x16 o[2]; o[0] = f32x16{}; o[1] = f32x16{};
    flash_pass<1, true>(shm, P + (size_t)(b * S_) * PP + PC_FK + h * 64, P + (size_t)(b * S_) * PP + PC_FV + h * 64, PP, 0, 4 * (qb + 1), ~0ull, 0, 0, qr, qpos, -(1 << 30), 0.f, ~0ull, m, l, o, 0.f, knmax);
    scale_rows(shm, o, inv_l(l), o, false);
    bf16_t* obase = O + (size_t)(b * S_ + q0 + wid * 32) * D_ + h * 64;
    store_o(shm, o, [&](int row) { return obase + (size_t)row * D_; });
}
__device__ __forceinline__ void moba_unit(LAS char* shm, const bf16_t* P, const float* KMEAN, bf16_t* O, int b, int h, int qb, float knmax) {
    const int tid = opaque_tid(), lane = tid & 63, r32 = lane & 31, hi = lane >> 5; const int wid = __builtin_amdgcn_readfirstlane(tid >> 6);
    const int q0 = qb * 256, cur = qb;
    LAS unsigned* mb = (LAS unsigned*)(shm + L_SELM);
    LAS unsigned* un = (LAS unsigned*)(shm + L_UNION);
    LAS float* kml = (LAS float*)(shm + L_AUX);
    if (tid == 0) un[0] = 0u;
    if (tid < 256) ((LAS f32x4*)kml)[tid] = ((const f32x4*)(KMEAN + (size_t)(b * 6 + h) * 16 * 64))[tid];
    __syncthreads();
    {
        const int qi = tid & 255, hf = tid >> 8;
        const bf16_t* qrow = P + (size_t)(b * S_ + q0 + qi) * PP + PC_MQ + h * 64;
        float q[64];
#pragma unroll
        for (int c = 0; c < 8; ++c) { const u32x4 v = *(const u32x4*)(qrow + c * 8);
            q[c * 8 + 0] = __builtin_bit_cast(float, v.x << 16); q[c * 8 + 1] = __builtin_bit_cast(float, v.x & 0xffff0000u); q[c * 8 + 2] = __builtin_bit_cast(float, v.y << 16); q[c * 8 + 3] = __builtin_bit_cast(float, v.y & 0xffff0000u);
            q[c * 8 + 4] = __builtin_bit_cast(float, v.z << 16); q[c * 8 + 5] = __builtin_bit_cast(float, v.z & 0xffff0000u); q[c * 8 + 6] = __builtin_bit_cast(float, v.w << 16); q[c * 8 + 7] = __builtin_bit_cast(float, v.w & 0xffff0000u); }
        int s0 = -1, s1 = -1, s2 = -1; float g0 = -INFINITY, g1 = -INFINITY, g2 = -INFINITY;
        for (int n = hf; n < cur; n += 2) {
            float g = 0.f;
#pragma unroll
            for (int d4 = 0; d4 < 16; ++d4) { const f32x4 kv = *(const LAS f32x4*)(kml + n * 64 + d4 * 4); g += (q[d4 * 4] * kv.x + q[d4 * 4 + 1] * kv.y) + (q[d4 * 4 + 2] * kv.z + q[d4 * 4 + 3] * kv.w); }
            if (g > g0) { s2 = s1; g2 = g1; s1 = s0; g1 = g0; s0 = n; g0 = g; }
            else if (g > g1) { s2 = s1; g2 = g1; s1 = n; g1 = g; }
            else if (g > g2) { s2 = n; g2 = g; }
        }
        LAS float* xg = (LAS float*)(shm + L_AUX + 4096); LAS int* xs = (LAS int*)(shm + L_AUX + 4096 + 3072);
        if (hf == 1) { xg[qi * 3] = g0; xg[qi * 3 + 1] = g1; xg[qi * 3 + 2] = g2; xs[qi * 3] = s0; xs[qi * 3 + 1] = s1; xs[qi * 3 + 2] = s2; }
        __syncthreads();
        if (hf == 0) {
#pragma unroll
            for (int k = 0; k < 3; ++k) { const float g = xg[qi * 3 + k]; const int n = xs[qi * 3 + k];
                if (n >= 0) {
                    if (g > g0 || (g == g0 && n < s0)) { s2 = s1; g2 = g1; s1 = s0; g1 = g0; s0 = n; g0 = g; }
                    else if (g > g1 || (g == g1 && n < s1)) { s2 = s1; g2 = g1; s1 = n; g1 = g; }
                    else if (g > g2 || (g == g2 && n < s2)) { s2 = n; g2 = g; }
                } }
            unsigned mask = 1u << cur;
            if (s0 >= 0) mask |= 1u << s0; if (s1 >= 0) mask |= 1u << s1; if (s2 >= 0) mask |= 1u << s2;
            mb[qi] = mask;
            __hip_atomic_fetch_or(&un[0], mask, __ATOMIC_RELAXED, __HIP_MEMORY_SCOPE_WORKGROUP);
        }
    }
    __syncthreads();
    const unsigned uni = un[0];
    const unsigned long long rmask = mb[wid * 32 + r32];
    const int qpos = q0 + wid * 32 + r32;
    const float slope2 = exp2f(-8.0f * (float)(h + 1) / 6.0f) * LOG2E;
    bf16x8 qr[4]; load_q(qr, P + (size_t)(b * S_ + qpos) * PP + PC_MQ + h * 64, hi);
    float m = 0.f, l = 0.f; f32x16 o[2]; o[0] = f32x16{}; o[1] = f32x16{};
    flash_pass<0, true>(shm, P + (size_t)(b * S_) * PP + PC_MK + h * 64, P + (size_t)(b * S_) * PP + PC_MV + h * 64, PP, 0, 4 * (qb + 1), (unsigned long long)uni, 2, q0, qr, qpos, -(1 << 30), slope2, rmask, m, l, o, 0.f, knmax);
    scale_rows(shm, o, inv_l(l), o, false);
    bf16_t* obase = O + (size_t)(b * S_ + q0 + wid * 32) * D_ + 640 + h * 64;
    store_o(shm, o, [&](int row) { return obase + (size_t)row * D_; });
}
__device__ __forceinline__ void nsa_unit(LAS char* shm, const bf16_t* P, const bf16_t* KCMP, bf16_t* O, int b, int qb) {
    const int tid = opaque_tid(), lane = tid & 63, r32 = lane & 31, hi = lane >> 5; const int wid = __builtin_amdgcn_readfirstlane(tid >> 6);
    const int q0 = qb * 64, ql = wid * 8 + (r32 >> 2), head = r32 & 3, qpos = q0 + ql, cur = qb;
    const float slope2 = exp2f(-2.0f * (float)(head + 1)) * LOG2E;
    const bf16_t* prow = P + (size_t)(b * S_ + qpos) * PP;
    bf16x8 qr[4]; load_q(qr, prow + PC_NQ + head * 64, hi);
    const float gc = fast_sigmoid(bf2f(prow[PC_NG + 0 + head])), gs = fast_sigmoid(bf2f(prow[PC_NG + 4 + head])), gw = fast_sigmoid(bf2f(prow[PC_NG + 8 + head]));
    LAS float* impz = (LAS float*)(shm + L_IMP);
    for (int i = tid; i < 64 * IMP_LD; i += 512) impz[i] = 0.f;
    LAS unsigned long long* selm = (LAS unsigned long long*)(shm + L_SELM);
    LAS unsigned long long* un = (LAS unsigned long long*)(shm + L_UNION);
    if (tid == 0) un[0] = 0ull;
    f32x16 oacc[2]; f32x16 o[2];
    {
        const int nmax = (q0 + 63 - 31) >> 4;
        const int ntile = (q0 + 63 >= 31) ? (nmax >> 6) + 1 : 0;
        const int khi = (qpos >= 31) ? ((qpos - 31) >> 4) : -1;
        const bf16_t* kc = KCMP + (size_t)(b * 2 + 0) * 256 * 64; const bf16_t* vc = KCMP + (size_t)(b * 2 + 1) * 256 * 64;
        float m = 0.f, l = 0.f; o[0] = f32x16{}; o[1] = f32x16{};
        const int kref = q0 >> 4;
        flash_pass<0, false>(shm, kc, vc, 64, 0, ntile, ~0ull, 0, kref, qr, khi, -(1 << 30), slope2 * 16.f, ~0ull, m, l, o, 0.f);
        const float il = inv_l(l);
        scale_rows(shm, o, il * gc, oacc, false);
        float m2 = m, l2 = l;
        flash_pass<2, false>(shm, kc, vc, 64, 0, ntile, ~0ull, 0, kref, qr, khi, -(1 << 30), slope2 * 16.f, ~0ull, m2, l2, o, il);
    }
    __syncthreads();
    for (int qi = 0; qi < 8; ++qi) {
        const int q = wid * 8 + qi, j = lane;
        const LAS float* ip = (const LAS float*)(shm + L_IMP) + q * IMP_LD + 4 * j;
        const float is = ip[0] + 2.f * (ip[1] + ip[2] + ip[3]) + ip[4];
        const bool causal = j <= cur, forced = (j == 0) || (j > cur - 2);
        const float sc = causal ? (forced ? 1e9f : is) : -1e9f;
        bool sel;
        if (cur < 16) sel = causal;
        else {
            int cnt = 0;
#pragma unroll
            for (int jj = 0; jj < 64; ++jj) { const float v = __builtin_bit_cast(float, __builtin_amdgcn_readlane(__builtin_bit_cast(int, sc), jj)); cnt += (v > sc || (v == sc && jj < j)) ? 1 : 0; }
            sel = (cnt < 16) && causal;
        }
        const unsigned long long msk = __ballot(sel);
        if (lane == 0) { selm[q] = msk; __hip_atomic_fetch_or(&un[0], msk, __ATOMIC_RELAXED, __HIP_MEMORY_SCOPE_WORKGROUP); }
    }
    __syncthreads();
    const unsigned long long uni = un[0], rmask = selm[ql];
    {
        float m = 0.f, l = 0.f; o[0] = f32x16{}; o[1] = f32x16{};
        flash_pass<0, false>(shm, P + (size_t)(b * S_) * PP + PC_KS, P + (size_t)(b * S_) * PP + PC_VS, PP, 0, qb + 1, uni, 0, q0, qr, qpos, -(1 << 30), slope2, rmask, m, l, o, 0.f);
        scale_rows(shm, o, inv_l(l) * gs, oacc, true);
    }
    {
        float m = 0.f, l = 0.f; o[0] = f32x16{}; o[1] = f32x16{};
        const int tlo = qb >= 8 ? qb - 8 : 0;
        flash_pass<0, false>(shm, P + (size_t)(b * S_) * PP + PC_KW, P + (size_t)(b * S_) * PP + PC_VW, PP, tlo, qb + 1, ~0ull, 0, q0, qr, qpos, qpos - 511, slope2, ~0ull, m, l, o, 0.f);
        scale_rows(shm, o, inv_l(l) * gw, oacc, true);
    }
    bf16_t* obase = O + (size_t)(b * S_ + q0 + wid * 8) * D_ + 384;
    store_o(shm, oacc, [&](int row) { return obase + (size_t)(row >> 2) * D_ + (row & 3) * 64; });
}
#undef SBAR
}

struct Frame {
    LAS unsigned char* lds; volatile LAS unsigned* MISC; gu32* ctl;
    int tid, lane, wave, vcu, G;
    unsigned char* ws;
};
__device__ __forceinline__ float wave_sum(float v) {
#pragma unroll
    for (int o = 1; o < 64; o <<= 1) v += __shfl_xor(v, o);
    return v;
}
__device__ __forceinline__ unsigned pk4_fp8(float a, float b, float c, float d) { int w = 0; w = __builtin_amdgcn_cvt_pk_fp8_f32(a, b, w, false); w = __builtin_amdgcn_cvt_pk_fp8_f32(c, d, w, true); return (unsigned)w; }
__device__ __forceinline__ int win_dst(int c) {
    if (c < 1152) return c; if (c < 1158) return 2944 + (c - 1152); if (c < 1798) return c - 6; if (c < 1810) return 2950 + (c - 1798); if (c < 2962) return c - 18; return c + 110;
}
__device__ __forceinline__ bool win_isq(int p) { return p < 384 || (p >= PC_NQ && p < PC_NQ + 256) || (p >= PC_MQ && p < PC_MQ + 384); }
__device__ __forceinline__ int rowmap(int kind, int n) { return kind == 1 ? win_dst(n) : (kind == 2 ? ((n >> 7) * 256 + (n & 127)) : (kind == 3 ? ((n >> 7) * 256 + 128 + (n & 127)) : n)); }
__device__ __forceinline__ void tr_item(const float* W, int N, bf16_t* WT, int dld, int dcol, int kind, LAS float* scr, int kb, int nb, int lane) {
    const int k0 = 64 * kb, n0 = 32 * nb;
    const int nn = n0 + (lane & 31);
#pragma unroll
    for (int i = 0; i < 32; ++i) { const int kk = 2 * i + (lane >> 5); scr[kk * 33 + (lane & 31)] = (nn < N) ? W[(size_t)(k0 + kk) * N + nn] : 0.f; }
    asm volatile("s_waitcnt lgkmcnt(0)" ::: "memory");
    const int c = lane & 7;
#pragma unroll
    for (int j = 0; j < 4; ++j) { const int n = (lane >> 3) + 8 * j; const LAS float* s = scr + (8 * c) * 33 + n;
        if (n0 + n < N) {
            const int dr = rowmap(kind, n0 + n); const float sc = (kind == 1 && win_isq(dr)) ? C2 : 1.0f;
            u32x4 o; o.x = pk2(s[0 * 33] * sc, s[1 * 33] * sc); o.y = pk2(s[2 * 33] * sc, s[3 * 33] * sc); o.z = pk2(s[4 * 33] * sc, s[5 * 33] * sc); o.w = pk2(s[6 * 33] * sc, s[7 * 33] * sc);
            bf16_t* dp = (kind == 4) ? WT + ((size_t)((k0 + 8 * c) >> 4) * 256 + dr) * 16 + ((8 * c) & 15) : WT + (size_t)dr * dld + dcol + k0 + 8 * c;
            *(u32x4*)dp = o; } }
    asm volatile("s_waitcnt lgkmcnt(0)" ::: "memory");
}
struct CvtJob { const float* W; int K, N; bf16_t* WT; int dld, dcol, kind; };
__device__ __forceinline__ void convert_weights(Frame& F, const float* const* in) {
    LAS float* scr = (LAS float*)(F.lds + F.wave * 16384);
    const int gw = F.vcu * 8 + F.wave, NGW = F.G * 8;
    unsigned char* ws = F.ws;
    for (int g = gw; g < 2 * 10704; g += NGW) {
        const int l = g / 10704, r = g % 10704; int it; CvtJob J;
        if (r < 3024) { it = r; J.W = in[4] + (size_t)l * D_ * INC; J.K = D_; J.N = INC; J.WT = (bf16_t*)(ws + WS_WIN) + (size_t)l * NWIN * D_; J.dld = D_; J.dcol = 0; J.kind = 1; }
        else if (r < 3536) { const int br = (r < 3216) ? 0 : (r < 3344 ? 1 : 2); it = r - ((br == 0) ? 3024 : (br == 1 ? 3216 : 3344)); const int Kb = (br == 1) ? 256 : 384; const int kofs = (br == 0) ? 0 : (br == 1 ? 384 : 640);
            J.W = in[10 + br] + (size_t)l * Kb * D_; J.K = Kb; J.N = D_; J.WT = (bf16_t*)(ws + WS_WBR) + (size_t)l * D_ * D_; J.dld = D_; J.dcol = kofs; J.kind = 0; }
        else if (r < 4048) { it = r - 3536; J.W = in[13] + (size_t)l * D_ * D_; J.K = D_; J.N = D_; J.WT = (bf16_t*)(ws + WS_WOUT) + (size_t)l * D_ * D_; J.dld = D_; J.dcol = 0; J.kind = 0; }
        else if (r < 6096) { const int e = (r - 4048) >> 7; it = (r - 4048) & 127; J.W = in[18] + ((size_t)l * 16 + e) * D_ * 256; J.K = D_; J.N = 256; J.WT = (bf16_t*)(ws + WS_WGU) + ((size_t)l * 16 + e) * 512 * D_; J.dld = D_; J.dcol = 0; J.kind = 2; }
        else if (r < 8144) { const int e = (r - 6096) >> 7; it = (r - 6096) & 127; J.W = in[19] + ((size_t)l * 16 + e) * D_ * 256; J.K = D_; J.N = 256; J.WT = (bf16_t*)(ws + WS_WGU) + ((size_t)l * 16 + e) * 512 * D_; J.dld = D_; J.dcol = 0; J.kind = 3; }
        else if (r < 10192) { const int e = (r - 8144) >> 7; it = (r - 8144) & 127; J.W = in[20] + ((size_t)l * 16 + e) * 256 * D_; J.K = 256; J.N = D_; J.WT = (bf16_t*)(ws + WS_WD) + ((size_t)l * 16 + e) * D_ * 256; J.dld = 256; J.dcol = 0; J.kind = 0; }
        else { const int wh = (r - 10192) >> 8; it = (r - 10192) & 255; J.W = in[6] + ((size_t)l * 2 + wh) * 2048 * 256; J.K = 2048; J.N = 256; J.WT = (bf16_t*)(ws + WS_WC1) + ((size_t)l * 2 + wh) * 256 * 2048; J.dld = 2048; J.dcol = 0; J.kind = 4; }
        const int nnb = (J.N + 31) / 32;
        tr_item(J.W, J.N, J.WT, J.dld, J.dcol, J.kind, scr, it / nnb, it % nnb, F.lane);
    }
    const int gt = F.vcu * 512 + F.tid, NGT = F.G * 512;
    for (int i = gt; i < 2 * NWIN; i += NGT) { const int l = i / NWIN, p = i % NWIN; int c = -1;
        if (p < 1152) c = p; else if (p < 1792) c = p + 6; else if (p < 2944) c = p + 18; else if (p < 2950) c = 1152 + (p - 2944); else if (p < 2962) c = 1798 + (p - 2950); else if (p >= 3072) c = p - 110;
        ((float*)(ws + WS_BIAS))[i] = (c >= 0) ? in[5][l * INC + c] * (win_isq(p) ? C2 : 1.0f) : 0.f; }
    for (int i = gt; i < 2 * 110 * D_; i += NGT) { const int l = i / (110 * D_), r = (i % (110 * D_)) / D_, k = i % D_; ((bf16_t*)(ws + WS_WIN))[((size_t)l * NWIN + 2962 + r) * D_ + k] = 0; }
    for (int i = gt; i < 2 * 32 * 1024; i += NGT) { const int l = i >> 15, c = (i >> 10) & 31, k = i & 1023;
        const float w = (c < 4) ? in[14][((size_t)l * D_ + k) * 4 + c] : ((c < 20) ? in[16][((size_t)l * D_ + k) * 16 + (c - 4)] : 0.f);
        const unsigned hb = f2bf(w); const float lo = w - bf2f((unsigned short)hb);
        bf16_t* wrt = (bf16_t*)(ws + WS_WRT) + (size_t)l * 2 * 32 * 1024; wrt[c * 1024 + k] = (bf16_t)hb; wrt[32 * 1024 + c * 1024 + k] = (bf16_t)f2bf(lo); }
    for (int i = gt; i < 2 * 128 * 3072; i += NGT) { const int l = i / (128 * 3072), r = i % (128 * 3072), kb = r / 3072, n = r % 3072;
        const float* wp = in[4] + ((size_t)l * D_ + kb * 8) * INC + 2962 + n; float w8[8];
#pragma unroll
        for (int k = 0; k < 8; ++k) w8[k] = wp[(size_t)k * INC] * 64.0f;
        u32x2 o; o.x = pk4_fp8(w8[0], w8[1], w8[2], w8[3]); o.y = pk4_fp8(w8[4], w8[5], w8[6], w8[7]);
        *(u32x2*)(ws + WS_WG8 + ((size_t)l * 3072 + n) * 2048 + kb * 8) = o; }
    for (int i = gt; i < 4 * 32 * 64; i += NGT) { const int m = i >> 11, hc = (i >> 6) & 31, d = i & 63;
        const float* wp = in[8] + ((size_t)m * 256 + hc * 8) * 64 + d;
        u32x4 o; o.x = pk2(wp[0], wp[64]); o.y = pk2(wp[128], wp[192]); o.z = pk2(wp[256], wp[320]); o.w = pk2(wp[384], wp[448]);
        *(u32x4*)((bf16_t*)(ws + WS_W2T) + ((size_t)m * 64 + d) * 256 + hc * 8) = o; }
    for (int it = gw; it < 4 * 4 * 8; it += NGW) {
        const int m = it >> 5, hg = (it >> 3) & 3, kc = it & 7, h = hg * 64 + F.lane;
        const float* w1 = in[6] + (size_t)m * 2048 * 256 + h; const float* pos = in[9] + (size_t)m * 2048;
        float a = 0.f;
#pragma unroll 16
        for (int k = kc * 256; k < kc * 256 + 256; ++k) a += pos[k] * w1[(size_t)k * 256];
        ((float*)(ws + WS_BC1P))[(m * 8 + kc) * 256 + h] = a;
    }
}
__device__ __forceinline__ void load_row(f32x4* v, u32x2* a, u32x2* b, const float* x, const bf16_t* d1, const bf16_t* d2, size_t m, int lane) {
    const f32x4* xr = (const f32x4*)(x + m * D_) + lane;
#pragma unroll
    for (int j = 0; j < 4; ++j) v[j] = xr[64 * j];
    if (d1) { const u32x2* p = (const u32x2*)(d1 + m * D_) + lane;
#pragma unroll
        for (int j = 0; j < 4; ++j) a[j] = p[64 * j]; }
    if (d2) { const u32x2* p = (const u32x2*)(d2 + m * D_) + lane;
#pragma unroll
        for (int j = 0; j < 4; ++j) b[j] = p[64 * j]; }
}
__device__ __forceinline__ f32x4 add_bf4(f32x4 v, u32x2 w) { v.x += __builtin_bit_cast(float, w.x << 16); v.y += __builtin_bit_cast(float, w.x & 0xffff0000u); v.z += __builtin_bit_cast(float, w.y << 16); v.w += __builtin_bit_cast(float, w.y & 0xffff0000u); return v; }
__device__ __forceinline__ void norm_rows(Frame& F, const float* x, const bf16_t* d1, const bf16_t* d2, float* xout, const float* g, bf16_t* out, unsigned char* out8) {
    const int gw = F.vcu * 8 + F.wave, NGW = F.G * 8;
    f32x4 gv[4];
#pragma unroll
    for (int j = 0; j < 4; ++j) gv[j] = ((const f32x4*)g)[F.lane + 64 * j];
    f32x4 vn[4]; u32x2 an[4], bn[4];
    if (gw < T_) load_row(vn, an, bn, x, d1, d2, (size_t)gw, F.lane);
    for (int m = gw; m < T_; m += NGW) {
        f32x4 v[4]; float s = 0.f;
#pragma unroll
        for (int j = 0; j < 4; ++j) { v[j] = vn[j]; if (d1) v[j] = add_bf4(v[j], an[j]); if (d2) v[j] = add_bf4(v[j], bn[j]); }
        if (m + NGW < T_) load_row(vn, an, bn, x, d1, d2, (size_t)(m + NGW), F.lane);
#pragma unroll
        for (int j = 0; j < 4; ++j) s += (v[j].x * v[j].x + v[j].y * v[j].y) + (v[j].z * v[j].z + v[j].w * v[j].w);
        const float r = 1.0f / sqrtf(wave_sum(s) * (1.0f / D_) + 1e-6f);
        if (xout) { f32x4* xo = (f32x4*)(xout + (size_t)m * D_) + F.lane;
#pragma unroll
            for (int j = 0; j < 4; ++j) xo[64 * j] = v[j]; }
        u32x2* o8 = (u32x2*)(out + (size_t)m * D_) + F.lane;
#pragma unroll
        for (int j = 0; j < 4; ++j) { u32x2 w; w.x = pk2(v[j].x * r * gv[j].x, v[j].y * r * gv[j].y); w.y = pk2(v[j].z * r * gv[j].z, v[j].w * r * gv[j].w); o8[64 * j] = w; }
        unsigned* q8 = (unsigned*)(out8 + (size_t)m * 2048) + F.lane;
#pragma unroll
        for (int j = 0; j < 4; ++j) q8[64 * j] = pk4_fp8(v[j].x * r * gv[j].x, v[j].y * r * gv[j].y, v[j].z * r * gv[j].z, v[j].w * r * gv[j].w);
    }
}
__device__ __forceinline__ void final_norm(Frame& F, const float* x, const bf16_t* d1, const bf16_t* d2, float* outp, const float* g) {
    const int gw = F.vcu * 8 + F.wave, NGW = F.G * 8;
    f32x4 gv[4];
#pragma unroll
    for (int j = 0; j < 4; ++j) gv[j] = ((const f32x4*)g)[F.lane + 64 * j];
    f32x4 vn[4]; u32x2 an[4], bn[4];
    if (gw < T_) load_row(vn, an, bn, x, d1, d2, (size_t)gw, F.lane);
    for (int m = gw; m < T_; m += NGW) {
        f32x4 v[4]; float s = 0.f;
#pragma unroll
        for (int j = 0; j < 4; ++j) { v[j] = add_bf4(add_bf4(vn[j], an[j]), bn[j]); }
        if (m + NGW < T_) load_row(vn, an, bn, x, d1, d2, (size_t)(m + NGW), F.lane);
#pragma unroll
        for (int j = 0; j < 4; ++j) s += (v[j].x * v[j].x + v[j].y * v[j].y) + (v[j].z * v[j].z + v[j].w * v[j].w);
        const float r = 1.0f / sqrtf(wave_sum(s) * (1.0f / D_) + 1e-6f);
        f32x4* xo = (f32x4*)(outp + (size_t)m * D_) + F.lane;
#pragma unroll
        for (int j = 0; j < 4; ++j) xo[64 * j] = v[j] * r * gv[j];
    }
}
__device__ __forceinline__ void norm2_route(Frame& F, const float* x, const bf16_t* d1, const float* g, bf16_t* out, const bf16_t* wrt, const float* bg, const float* be,
                                            unsigned* cnt, int* list, float* tokw) {
    constexpr int YLD = 1032;
    LAS bf16_t* yh = (LAS bf16_t*)F.lds; LAS bf16_t* yl = yh + 16 * YLD;
    LAS float* part = (LAS float*)(F.lds + 2 * 16 * YLD * 2);
    LAS float* lgt = part + 8 * 512;
    const int lane = F.lane, w = F.wave;
    bf16x8 bh[2][4], bl[2][4];
#pragma unroll
    for (int cb = 0; cb < 2; ++cb)
#pragma unroll
        for (int ks = 0; ks < 4; ++ks) { const size_t o = (size_t)(cb * 16 + (lane & 15)) * 1024 + 128 * w + 32 * ks + 8 * (lane >> 4);
            bh[cb][ks] = *(const bf16x8*)(wrt + o); bl[cb][ks] = *(const bf16x8*)(wrt + 32 * 1024 + o); }
    f32x4 gv[4];
#pragma unroll
    for (int j = 0; j < 4; ++j) gv[j] = ((const f32x4*)g)[lane + 64 * j];
    const int nblk = T_ / 16;
    f32x4 vn[2][4]; u32x2 an[2][4], bn_[4];
    { const int blk0 = F.vcu; if (blk0 < nblk) { load_row(vn[0], an[0], bn_, x, d1, nullptr, (size_t)blk0 * 16 + 2 * w, lane); load_row(vn[1], an[1], bn_, x, d1, nullptr, (size_t)blk0 * 16 + 2 * w + 1, lane); } }
    for (int blk = F.vcu; blk < nblk; blk += F.G) {
#pragma unroll
        for (int rr = 0; rr < 2; ++rr) {
            const int rl = 2 * w + rr; const size_t m = (size_t)blk * 16 + rl;
            f32x4 v[4]; float s = 0.f;
#pragma unroll
            for (int j = 0; j < 4; ++j) { v[j] = add_bf4(vn[rr][j], an[rr][j]); s += (v[j].x * v[j].x + v[j].y * v[j].y) + (v[j].z * v[j].z + v[j].w * v[j].w); }
            const float r = 1.0f / sqrtf(wave_sum(s) * (1.0f / D_) + 1e-6f);
            u32x2* o8 = (u32x2*)(out + m * D_) + lane;
#pragma unroll
            for (int j = 0; j < 4; ++j) { v[j] = v[j] * r * gv[j];
                const unsigned h0 = f2bf(v[j].x), h1 = f2bf(v[j].y), h2 = f2bf(v[j].z), h3 = f2bf(v[j].w);
                u32x2 hw; hw.x = h0 | (h1 << 16); hw.y = h2 | (h3 << 16); o8[64 * j] = hw;
                u32x2 lw; lw.x = pk2(v[j].x - bf2f((unsigned short)h0), v[j].y - bf2f((unsigned short)h1)); lw.y = pk2(v[j].z - bf2f((unsigned short)h2), v[j].w - bf2f((unsigned short)h3));
                *(LAS u32x2*)(yh + rl * YLD + 4 * lane + 256 * j) = hw; *(LAS u32x2*)(yl + rl * YLD + 4 * lane + 256 * j) = lw; }
        }
        { const int nb = blk + F.G; if (nb < nblk) { load_row(vn[0], an[0], bn_, x, d1, nullptr, (size_t)nb * 16 + 2 * w, lane); load_row(vn[1], an[1], bn_, x, d1, nullptr, (size_t)nb * 16 + 2 * w + 1, lane); } }
        __syncthreads();
        f32x4 acc0 = (f32x4){0.f, 0.f, 0.f, 0.f}, acc1 = acc0;
#pragma unroll
        for (int ks = 0; ks < 4; ++ks) {
            const int ko = (lane & 15) * YLD + 128 * w + 32 * ks + 8 * (lane >> 4);
            const bf16x8 ah = *(const LAS bf16x8*)(yh + ko), al = *(const LAS bf16x8*)(yl + ko);
            acc0 = __builtin_amdgcn_mfma_f32_16x16x32_bf16(ah, bh[0][ks], acc0, 0, 0, 0); acc0 = __builtin_amdgcn_mfma_f32_16x16x32_bf16(ah, bl[0][ks], acc0, 0, 0, 0); acc0 = __builtin_amdgcn_mfma_f32_16x16x32_bf16(al, bh[0][ks], acc0, 0, 0, 0);
            acc1 = __builtin_amdgcn_mfma_f32_16x16x32_bf16(ah, bh[1][ks], acc1, 0, 0, 0); acc1 = __builtin_amdgcn_mfma_f32_16x16x32_bf16(ah, bl[1][ks], acc1, 0, 0, 0); acc1 = __builtin_amdgcn_mfma_f32_16x16x32_bf16(al, bh[1][ks], acc1, 0, 0, 0);
        }
#pragma unroll
        for (int i = 0; i < 4; ++i) { part[w * 512 + (4 * (lane >> 4) + i) * 32 + (lane & 15)] = acc0[i]; part[w * 512 + (4 * (lane >> 4) + i) * 32 + 16 + (lane & 15)] = acc1[i]; }
        __syncthreads();
        { const int t = F.tid; float sacc = 0.f;
#pragma unroll
            for (int q = 0; q < 8; ++q) sacc += part[q * 512 + t];
            const int c = t & 31; lgt[t] = sacc + ((c < 4) ? bg[c & 3] : ((c < 20) ? be[(c - 4) & 15] : 0.f)); }
        __syncthreads();
        if (F.tid < 16) {
            const int rl = F.tid; const size_t m = (size_t)blk * 16 + rl;
            const f32x4 lgg = *(const LAS f32x4*)(lgt + rl * 32), le0 = *(const LAS f32x4*)(lgt + rl * 32 + 4), le1 = *(const LAS f32x4*)(lgt + rl * 32 + 8), le2 = *(const LAS f32x4*)(lgt + rl * 32 + 12), le3 = *(const LAS f32x4*)(lgt + rl * 32 + 16);
            int gi = 0; float mg = lgg[0];
#pragma unroll
            for (int c = 1; c < 4; ++c) if (lgg[c] > mg) { mg = lgg[c]; gi = c; }
            float sg = 0.f;
#pragma unroll
            for (int c = 0; c < 4; ++c) sg += expf(lgg[c] - mg);
            const float gp = 1.0f / sg;
            const f32x4 l4 = (gi == 0) ? le0 : ((gi == 1) ? le1 : ((gi == 2) ? le2 : le3));
            int a1 = 0; float va = l4[0];
#pragma unroll
            for (int c = 1; c < 4; ++c) if (l4[c] > va) { va = l4[c]; a1 = c; }
            int b1 = -1; float vb = 0.f;
#pragma unroll
            for (int c = 0; c < 4; ++c) if (c != a1 && (b1 < 0 || l4[c] > vb)) { vb = l4[c]; b1 = c; }
            const float eb = expf(vb - va), w_hi = gp / (1.0f + eb), w_lo = gp * eb / (1.0f + eb);
            const int ea = a1 < b1 ? a1 : b1, ebx = a1 < b1 ? b1 : a1;
            const int pidx = (ea == 0) ? (ebx - 1) : (ea == 1 ? ebx + 1 : 5);
            const float wa = (a1 < b1) ? w_hi : w_lo, wb = (a1 < b1) ? w_lo : w_hi;
            const int bucket = gi * 6 + pidx;
            const unsigned pos = __hip_atomic_fetch_add(cnt + bucket * 64, 1u, RLX_AGENT);
            list[(size_t)bucket * T_ + pos] = (int)m; tokw[m * 2] = wa; tokw[m * 2 + 1] = wb;
        }
    }
    __syncthreads();
}
__device__ __forceinline__ float logsig(float x) { return fminf(x, 0.f) - log1pf(expf(-fabsf(x))); }
__device__ __forceinline__ void fox_cumsum_unit(Frame& F, const bf16_t* P, float* FB, int b, int h) {
    LAS float* tot = (LAS float*)F.lds;
    float v[8]; float run = 0.f;
#pragma unroll
    for (int i = 0; i < 8; ++i) { const int t = F.tid * 8 + i; run += logsig(bf2f(P[(size_t)(b * S_ + t) * PP + PC_FF + h])); v[i] = run; }
    float sc = run;
#pragma unroll
    for (int o = 1; o < 64; o <<= 1) { const float u = __shfl_up(sc, o); if (F.lane >= o) sc += u; }
    if (F.lane == 63) tot[F.wave] = sc;
    __syncthreads();
    float base = sc - run;
    for (int w = 0; w < F.wave; ++w) base += tot[w];
#pragma unroll
    for (int i = 0; i < 8; ++i) FB[(size_t)(b * 6 + h) * S_ + F.tid * 8 + i] = -(base + v[i]) * LOG2E;
    __syncthreads();
}
__device__ __forceinline__ void cmp_unit(Frame& F, const bf16_t* P, const bf16_t* WC1, const float* BC1P, const float* B1, const bf16_t* W2T, bf16_t* KCMP, int b, int which, int ntile) {
    const int lane = F.lane, r32 = lane & 31, hi = lane >> 5, wid = F.wave;
    {
        const unsigned lbase = (unsigned)(uintptr_t)F.lds; const int rl = lane >> 3, ch = lane & 7;
        for (int g = wid; g < 66; g += 8) { const int row0 = g * 8; int row = ntile * 512 + row0 + rl; row = row < S_ ? row : S_ - 1;
            att::glds16(P + (size_t)(b * S_ + row) * PP + (which ? PC_VC : PC_KC) + ch * 8, (unsigned)__builtin_amdgcn_readfirstlane(lbase + row0 * 128 + (row0 >> 4) * 16)); }
    }
    float bias = B1[wid * 32 + r32];
#pragma unroll
    for (int kc = 0; kc < 8; ++kc) bias += BC1P[kc * 256 + wid * 32 + r32];
    const LAS char* ap = (const LAS char*)F.lds + r32 * 2064 + hi * 16;
    const bf16_t* bp = WC1 + (size_t)(wid * 32 + r32) * 16 + hi * 8;
    bf16x8 bb[16];
#define CMP_LD(i, kk) asm volatile("global_load_dwordx4 %0, %1, off" : "=v"(bb[i]) : "v"(bp + (size_t)(kk) * 4096))
#pragma unroll
    for (int i = 0; i < 16; ++i) CMP_LD(i, i);
    asm volatile("s_waitcnt vmcnt(0)" ::: "memory");
    __syncthreads();
    const int nb = wid & 1, kq = wid >> 1;
    bf16x8 b2[4];
#pragma unroll
    for (int s4 = 0; s4 < 4; ++s4) b2[s4] = *(const bf16x8*)(W2T + (size_t)(nb * 32 + r32) * 256 + kq * 64 + s4 * 16 + hi * 8);
    f32x16 acc = f32x16{}, acc1 = f32x16{};
    bf16x8 a_cur = *(const LAS bf16x8*)ap;
#pragma unroll 1
    for (int j = 0; j < 8; ++j) {
        unsigned jo = (unsigned)j; asm volatile("" : "+s"(jo));
#pragma unroll
        for (int i = 0; i < 16; ++i) {
            const unsigned kk = jo * 16 + i, kn = (kk + 1) & 127;
            const bf16x8 a_nxt = *(const LAS bf16x8*)(ap + kn * 32 + (kn >> 6) * 16);
            asm volatile("s_waitcnt vmcnt(15)" : "+v"(bb[i]));
            if (i & 1) { acc1 = __builtin_amdgcn_mfma_f32_32x32x16_bf16(a_cur, bb[i], acc1, 0, 0, 0); asm volatile("" : "+v"(acc1)); }
            else { acc = __builtin_amdgcn_mfma_f32_32x32x16_bf16(a_cur, bb[i], acc, 0, 0, 0); asm volatile("" : "+v"(acc)); }
            CMP_LD(i, (kk + 16) & 127);
            a_cur = a_nxt;
        }
    }
    asm volatile("s_waitcnt vmcnt(0)" ::: "memory");
    acc += acc1;
#undef CMP_LD
    LAS bf16_t* hsb = (LAS bf16_t*)(F.lds + 69632);
    LAS float* pt = (LAS float*)(F.lds + 86528);
#pragma unroll
    for (int r = 0; r < 16; ++r) { const float a = acc[r] + bias; const float z = 0.7978845608028654f * (a + 0.044715f * a * a * a);
        hsb[att::crow(r, hi) * 264 + wid * 32 + r32] = (bf16_t)f2bf(a * fast_sigmoid(2.0f * z)); }
    __syncthreads();
    f32x16 o2 = f32x16{};
#pragma unroll
    for (int s4 = 0; s4 < 4; ++s4) { const bf16x8 a2 = *(const LAS bf16x8*)(hsb + r32 * 264 + kq * 64 + s4 * 16 + hi * 8);
        o2 = __builtin_amdgcn_mfma_f32_32x32x16_bf16(a2, b2[s4], o2, 0, 0, 0); }
#pragma unroll
    for (int r = 0; r < 16; ++r) pt[(kq * 32 + att::crow(r, hi)) * 68 + nb * 32 + r32] = o2[r];
    __syncthreads();
    const int nl = F.tid >> 4, d4 = (F.tid & 15) * 4;
    f32x4 o = *(const LAS f32x4*)(pt + nl * 68 + d4);
#pragma unroll
    for (int q = 1; q < 4; ++q) o += *(const LAS f32x4*)(pt + (q * 32 + nl) * 68 + d4);
    const int no = ntile * 32 + nl;
    u32x2 w2; w2.x = (no < 255) ? pk2(o[0], o[1]) : 0u; w2.y = (no < 255) ? pk2(o[2], o[3]) : 0u;
    *(u32x2*)(KCMP + ((size_t)(b * 2 + which) * 256 + no) * 64 + d4) = w2;
    __syncthreads();
}

struct Args { const float* in[21]; float* out; unsigned char* ws; int ph_lo, ph_hi; };
constexpr int NPH = 19;


__device__ __forceinline__ LAS unsigned char* opaque_lds(LAS unsigned char* p) { unsigned v = (unsigned)(uintptr_t)p; asm volatile("" : "+s"(v)); return (LAS unsigned char*)(uintptr_t)v; }
#ifndef PROBE_DUP
#define PROBE_DUP -1
#endif
#define NREP(k) ((PROBE_DUP == (k)) ? 2 : 1)
#define IN(k) (lo <= (k) && (k) < hi)
#ifndef PROBE_AMP
#define PROBE_AMP -1
#endif
#if PROBE_AMP >= 0
#define AMP_AFTER(k) do { const unsigned long long tn_ = wall_clock64(); volatile LAS unsigned* tp_ = (volatile LAS unsigned*)((LAS unsigned char*)lds + MISC_OFF) + 56; \
    const unsigned long long tp0_ = ((unsigned long long)tp_[1] << 32) | tp_[0]; unsigned long long te_ = tn_; \
    if (PROBE_AMP == 99 || ((k) % 9) == PROBE_AMP) { te_ = tn_ + (tn_ - tp0_); while (wall_clock64() < te_) __builtin_amdgcn_s_sleep(4); } \
    __syncthreads(); if (opaque_tid() == 0) { tp_[0] = (unsigned)te_; tp_[1] = (unsigned)(te_ >> 32); } __syncthreads(); } while (0)
#else
#define AMP_AFTER(k) do { } while (0)
#endif
#define SEAM(k) do { if (IN(k) && IN((k) + 1)) { XcdBarrier bar_; bar_.bar = (unsigned*)((gu32*)(args.ws + WS_CTL) + CW_BAR); bar_.x = xb_xcc_id(); bar_.st = (volatile LAS unsigned*)((LAS unsigned char*)lds + MISC_OFF) + 8; xcd_barrier(bar_); AMP_AFTER(k); } } while (0)
#define PHASE_ENTRY() const int t_ = opaque_tid(); F.tid = t_; F.lane = t_ & 63; F.wave = __builtin_amdgcn_readfirstlane(t_ >> 6); F.lds = opaque_lds((LAS unsigned char*)lds); \
    unsigned zofs_; asm volatile("s_mov_b32 %0, 0" : "=s"(zofs_)); \
    unsigned char* ws = args.ws + zofs_; F.ws = ws; F.ctl = (gu32*)(ws + WS_CTL); \
    bf16_t* H = (bf16_t*)(ws + WS_H); bf16_t* P = (bf16_t*)(ws + WS_P); bf16_t* O = (bf16_t*)(ws + WS_O); (void)H; (void)P; (void)O
template <int l>
__device__ __forceinline__ void layer_body(Frame& F, const Args& args, const int lo, const int hi) {
    extern __shared__ __attribute__((aligned(16))) unsigned char lds[];
    const float* const* in = args.in; float* X = args.out;
    const int p0 = l * 9;
        const float* xin = (l == 0) ? in[0] : X;
        if (IN(p0 + 0)) {
            PHASE_ENTRY();
            for (int rep = 0; rep < NREP(0); ++rep) {
            if (l == 0) { convert_weights(F, in); }
            norm_rows(F, (l == 0) ? in[0] : in[0], (l == 0) ? nullptr : (const bf16_t*)(ws + WS_D1), (l == 0) ? nullptr : (const bf16_t*)(ws + WS_D2), (l == 0) ? nullptr : X, in[1] + l * D_, H, ws + WS_H8);
            }
        }
        SEAM(p0 + 0);
        if (IN(p0 + 1)) {
            PHASE_ENTRY();
            for (int rep = 0; rep < NREP(1); ++rep) {
            PolInProj pol; pol.A = (const char*)H; pol.B = (const char*)(ws + WS_WIN) + (size_t)l * NWIN * D_ * 2; pol.lda2 = 2048; pol.ldb2 = 2048; pol.kA = 128; pol.nt = 16;
            pol.ord.init(T_, PP, F.G, (int)blockIdx.x); pol.P = P; pol.bias = (const float*)(ws + WS_BIAS) + l * NWIN; pol.kn = F.ctl + CW_KN + l * 256; pol.kmz = (float*)(ws + WS_CTL + CTL_KMEAN) + (size_t)l * 8 * 6 * 16 * 64;
            pg8::gemm_stream(F.lds, pol);
            }
        }
        SEAM(p0 + 1);
        if (IN(p0 + 2)) {
            PHASE_ENTRY();
            for (int rep = 0; rep < NREP(2); ++rep) {
            for (int u = F.vcu; u < 176; u += F.G) {
                if (u < 128) { const int b = u >> 4, which = (u >> 3) & 1, nt = u & 7;
                    cmp_unit(F, P, (const bf16_t*)(ws + WS_WC1) + ((size_t)l * 2 + which) * 256 * 2048, (const float*)(ws + WS_BC1P) + (size_t)(l * 2 + which) * 8 * 256, in[7] + (l * 2 + which) * 256,
                             (const bf16_t*)(ws + WS_W2T) + ((size_t)l * 2 + which) * 64 * 256, (bf16_t*)(ws + WS_KCMP), b, which, nt); }
                else { const int k = u - 128; fox_cumsum_unit(F, P, (float*)(ws + WS_FB), k / 6, k % 6); }
            }
            }
        }
        SEAM(p0 + 2);
        if (IN(p0 + 3)) {
            PHASE_ENTRY();
            for (int rep = 0; rep < NREP(3); ++rep) {
            LAS char* shm = (LAS char*)F.lds;
            for (;;) {
                if (F.tid == 0) F.MISC[0] = __hip_atomic_fetch_add(F.ctl + CW_Q + (l * 2 + rep) * 64, 1u, RLX_AGENT);
                __syncthreads();
                const int u = (int)F.MISC[0];
                __syncthreads();
                if (u >= 2048) break;
                const int s = 15 - (u >> 7), k = u & 127;
#ifdef PROBE_ATT_MASK
                if (rep == 1 && !((PROBE_ATT_MASK >> (k < 48 ? 0 : (k < 96 ? 1 : 2))) & 1)) continue;
#endif
                if (k < 48) att::fox_unit(shm, P, (const float*)(ws + WS_FB), O, k / 6, k % 6, s, sqrtf(__uint_as_float(__hip_atomic_load(F.ctl + CW_KN + l * 256 + k * 2, RLX_AGENT)) + __uint_as_float(__hip_atomic_load(F.ctl + CW_KN + l * 256 + k * 2 + 1, RLX_AGENT))));
                else if (k < 96) att::moba_unit(shm, P, (const float*)(ws + WS_CTL + CTL_KMEAN) + (size_t)l * 8 * 6 * 16 * 64, O, (k - 48) / 6, (k - 48) % 6, s, sqrtf(__uint_as_float(__hip_atomic_load(F.ctl + CW_KN + l * 256 + k * 2, RLX_AGENT)) + __uint_as_float(__hip_atomic_load(F.ctl + CW_KN + l * 256 + k * 2 + 1, RLX_AGENT))));
                else { const int j = k - 96; att::nsa_unit(shm, P, (const bf16_t*)(ws + WS_KCMP), O, j >> 2, 4 * s + (j & 3)); }
            }
            }
        }
        SEAM(p0 + 3);
        if (IN(p0 + 4)) {
            PHASE_ENTRY();
            for (int rep = 0; rep < NREP(4); ++rep) {
            PolMerge pol; pol.O = (const char*)O; pol.H8 = (const char*)(ws + WS_H8); pol.WBR = (const char*)(ws + WS_WBR) + (size_t)l * D_ * D_ * 2;
            pol.WG8 = (const char*)(ws + WS_WG8) + (size_t)l * 3072 * 2048; pol.lda2 = 2048; pol.ldb2 = 2048; pol.kA = 128; pol.vcu = F.vcu; pol.G = F.G;
            pol.merged = (bf16_t*)(ws + WS_MERGED); pol.biasg = (const float*)(ws + WS_BIAS) + l * NWIN + 3072;
            pol.ys = (char*)(ws + WS_YSCR) + (size_t)blockIdx.x * 131072; pol.ps = (char*)(ws + WS_PSCR) + (size_t)blockIdx.x * 131072; pol.zero = (const char*)(ws + WS_CTL + 256 * 1024);
            pg8::gemm_stream(F.lds, pol);
            }
        }
        SEAM(p0 + 4);
        if (IN(p0 + 5)) {
            PHASE_ENTRY();
            for (int rep = 0; rep < NREP(5); ++rep) {
            PolOutProj pol; pol.A = (const char*)(ws + WS_MERGED); pol.B = (const char*)(ws + WS_WOUT) + (size_t)l * D_ * D_ * 2; pol.lda2 = 2048; pol.ldb2 = 2048; pol.kA = 128; pol.nt = 16;
            pol.ord.init(T_, D_, F.G, (int)blockIdx.x); pol.d1 = (bf16_t*)(ws + WS_D1);
            pg8::gemm_stream(F.lds, pol);
            }
        }
        SEAM(p0 + 5);
        if (IN(p0 + 6)) {
            PHASE_ENTRY();
            for (int rep = 0; rep < NREP(6); ++rep) {
            norm2_route(F, xin, (const bf16_t*)(ws + WS_D1), in[2] + l * D_, H, (const bf16_t*)(ws + WS_WRT) + (size_t)l * 2 * 32 * 1024, in[15] + l * 4, in[17] + l * 16, (unsigned*)(F.ctl + CW_CNT + (l + 2 * rep) * 24 * 64), (int*)(ws + WS_LIST + rep * 8 * MiB), (float*)(ws + WS_TOKW + rep * 20 * MiB));
            }
        }
        SEAM(p0 + 6);
        if (IN(p0 + 7)) {
            PHASE_ENTRY();
            for (int rep = 0; rep < NREP(7); ++rep) {
            if (F.tid < 24) F.MISC[32 + F.tid] = __hip_atomic_load(F.ctl + CW_CNT + (l * 24 + F.tid) * 64, RLX_AGENT);
            __syncthreads();
            PolMoeUp pol; pol.H = (const char*)H; pol.WGU = (const char*)(ws + WS_WGU) + (size_t)l * 16 * 512 * D_ * 2; pol.lda2 = 2048; pol.ldb2 = 2048; pol.kA = 128; pol.c = (int)blockIdx.x; pol.G = F.G;
            pol.cnt = (const LAS unsigned*)(F.lds + MISC_OFF) + 32; pol.list = (const int*)(ws + WS_LIST); pol.tokw = (const float*)(ws + WS_TOKW); pol.hid = (bf16_t*)(ws + WS_HID);
            pg8::gemm_stream(F.lds, pol);
            }
        }
        SEAM(p0 + 7);
        if (IN(p0 + 8)) {
            PHASE_ENTRY();
            for (int rep = 0; rep < NREP(8); ++rep) {
            if (F.tid < 24) F.MISC[32 + F.tid] = __hip_atomic_load(F.ctl + CW_CNT + (l * 24 + F.tid) * 64, RLX_AGENT);
            __syncthreads();
            PolMoeDown pol; pol.HID = (const char*)(ws + WS_HID); pol.WD = (const char*)(ws + WS_WD) + (size_t)l * 16 * D_ * 256 * 2; pol.lda2 = 1024; pol.ldb2 = 512; pol.kA = 128; pol.c = (int)blockIdx.x; pol.G = F.G;
            pol.cnt = (const LAS unsigned*)(F.lds + MISC_OFF) + 32; pol.list = (const int*)(ws + WS_LIST); pol.d2 = (bf16_t*)(ws + WS_D2);
            pg8::gemm_stream(F.lds, pol);
            }
        }
        SEAM(p0 + 8);
    }
__global__ void __launch_bounds__(512, 2) mega(Args args) {
    extern __shared__ __attribute__((aligned(16))) unsigned char lds[];
    Frame F;
    F.lds = (LAS unsigned char*)lds; F.MISC = (volatile LAS unsigned*)(F.lds + MISC_OFF);
    F.tid = threadIdx.x; F.lane = F.tid & 63; F.wave = __builtin_amdgcn_readfirstlane(F.tid >> 6);
    F.G = gridDim.x; { const int bx = blockIdx.x; F.vcu = (F.G % 8 == 0) ? (bx % 8) * (F.G / 8) + bx / 8 : bx; }
    F.ws = args.ws; F.ctl = (gu32*)(args.ws + WS_CTL);
    for (int u = F.tid; u < (LDS_BYTES - MISC_OFF) / 4; u += 512) ((LAS unsigned*)(F.lds + MISC_OFF))[u] = 0u;
    __syncthreads();
    if (F.lane == 0) F.MISC[64 + hw_slot()] = (unsigned)F.wave;
    __syncthreads();
#if PROBE_AMP >= 0
    if (F.tid == 0) { const unsigned long long t0_ = wall_clock64(); F.MISC[56] = (unsigned)t0_; F.MISC[57] = (unsigned)(t0_ >> 32); }
    __syncthreads();
#endif
    const int lo = args.ph_lo, hi = args.ph_hi;
    if (hi - lo > 1) (void)xcd_barrier_post((unsigned*)(F.ctl + CW_BAR), F.MISC + 8);
    const float* const* in = args.in;
    float* X = args.out;
    layer_body<0>(F, args, lo, hi);
    layer_body<1>(F, args, lo, hi);
    if (IN(18)) { PHASE_ENTRY(); final_norm(F, X, (const bf16_t*)(ws + WS_D1), (const bf16_t*)(ws + WS_D2), X, in[3]); }
#if PROBE_AMP == 18 || PROBE_AMP == 99
    { __syncthreads(); const unsigned long long tn_ = wall_clock64(); const unsigned long long tp0_ = ((unsigned long long)F.MISC[57] << 32) | F.MISC[56]; const unsigned long long te_ = tn_ + (tn_ - tp0_); while (wall_clock64() < te_) __builtin_amdgcn_s_sleep(4); }
#endif
#undef IN
#undef SEAM
}

#ifndef MK_PER_PHASE
#define MK_PER_PHASE 0
#endif
extern "C" void kernel_launch(void* const* d_in, const int* in_sizes, int n_in, void* d_out, int out_size, void* d_ws, size_t ws_size, hipStream_t stream) {
    static int grid = 0;
    if (grid == 0) {
        if (n_in != 21 || out_size != T_ * D_ || ws_size < WS_END2) { fprintf(stderr, "kernel_launch: unexpected shapes (n_in %d out %d ws %zu)\n", n_in, out_size, ws_size); grid = -1; return; }
        int dev = 0, cus = 0;
        if (hipGetDevice(&dev) != hipSuccess || hipDeviceGetAttribute(&cus, hipDeviceAttributeMultiprocessorCount, dev) != hipSuccess) { grid = -1; return; }
        if (hipFuncSetAttribute((const void*)mega, hipFuncAttributeMaxDynamicSharedMemorySize, LDS_BYTES) != hipSuccess) { fprintf(stderr, "kernel_launch: hipFuncSetAttribute failed\n"); grid = -1; return; }
        int per_cu = 0;
        if (hipOccupancyMaxActiveBlocksPerMultiprocessor(&per_cu, (const void*)mega, 512, LDS_BYTES) != hipSuccess || per_cu < 1) fprintf(stderr, "kernel_launch: occupancy query says %d\n", per_cu);
        (void)hipGetLastError();
        grid = cus;
    }
    if (grid < 0) return;
    (void)hipMemsetAsync((char*)d_ws + WS_CTL, 0, CTL_ZERO_BYTES, stream);
    Args a{};
    for (int i = 0; i < 21; ++i) a.in[i] = (const float*)d_in[i];
    a.out = (float*)d_out; a.ws = (unsigned char*)d_ws;
#if MK_PER_PHASE
    for (int p = 0; p < NPH; ++p) { a.ph_lo = p; a.ph_hi = p + 1; hipLaunchKernelGGL(mega, dim3(grid), dim3(512), LDS_BYTES, stream, a); }
#else
    a.ph_lo = 0; a.ph_hi = NPH;
    hipLaunchKernelGGL(mega, dim3(grid), dim3(512), LDS_BYTES, stream, a);
#endif
}
```
